# Optimizing an MI355X kernel written in HIP

```python
import math
import jax, jax.numpy as jnp
from jax import lax
import numpy as np

D_MODEL = 1024
BATCH = 16
SEQ = 256
DEPTH = 4
DEC_BATCH = 4
DEC_SEQ = 1024
PAST_LEN = 512

GRID_W = 64
N_MIXERS = 3
D_FF = 4 * D_MODEL
EPS = 1e-6
S5_GROUP = 16
S5_GROUPS = D_MODEL // S5_GROUP
S5_STATE = 64
S5_DT_MIN = 1e-3
S5_DT_MAX = 1e-1
NA_HEAD_DIM = 64
NA_HEADS = D_MODEL // NA_HEAD_DIM
NA_KH = 8
NA_KW = 16
NA_QCB = 16
NA_KCB = 2 * NA_KW
GQA_HEAD_DIM = 128
GQA_Q_HEADS = D_MODEL // GQA_HEAD_DIM
GQA_KV_HEADS = 2
ROPE_THETA = 10000.0
Q_BLOCK = 128
N_S5 = (DEPTH + 2) // 3
N_NA = (DEPTH + 1) // 3
N_GQA = DEPTH // 3

kernel_name = "hybrid_s5_natten_gqa_diffusion_step"

F32 = jnp.float32


def rms_norm(x, g):
    xf = x.astype(F32)
    y = xf * lax.rsqrt(jnp.mean(xf * xf, axis=-1, keepdims=True) + EPS)
    return (y * g.astype(F32)).astype(x.dtype)


def modulation(cvec, w, b):
    m = jax.nn.silu(cvec) @ w + b
    return [t[:, None, :] for t in jnp.split(m, 6, axis=-1)]


def sqrelu_mlp(h, w1, w2):
    a = jax.nn.relu(h @ w1)
    return (a * a) @ w2


def axial_rope_tables(L, d):
    t = jnp.arange(L)
    row = (t // GRID_W).astype(F32)
    col = (t % GRID_W).astype(F32)
    half = d // 2
    inv = ROPE_THETA ** (-jnp.arange(0, half, 2, dtype=F32) / half)
    ang = jnp.concatenate([row[:, None] * inv, col[:, None] * inv], axis=-1)
    return jnp.cos(ang), jnp.sin(ang)


def apply_rope(x, cos, sin):
    x1, x2 = jnp.split(x.astype(F32), 2, axis=-1)
    c = cos[None, :, None, :]
    s = sin[None, :, None, :]
    return jnp.concatenate([x1 * c - x2 * s, x1 * s + x2 * c], axis=-1).astype(x.dtype)


def blocked_attention(q, k, v):
    B_, Lq, Hq, d = q.shape
    Hkv = k.shape[2]
    rep = Hq // Hkv
    nb = Lq // Q_BLOCK
    qb = q.reshape(B_, nb, Q_BLOCK, Hkv, rep, d).transpose(1, 0, 2, 3, 4, 5)
    scale = d ** -0.5

    def one(qblk):
        s = jnp.einsum('bqgrd,bkgd->bgrqk', qblk, k).astype(F32) * scale
        p = jax.nn.softmax(s, axis=-1).astype(v.dtype)
        return jnp.einsum('bgrqk,bkgd->bqgrd', p, v)

    o = lax.map(one, qb)
    return o.transpose(1, 0, 2, 3, 4, 5).reshape(B_, Lq, Hq, d)


def s5_discretize(lam_re, lam_im, log_dt, b_re, b_im):
    dt = jnp.exp(log_dt)[:, None]
    ar = lam_re * dt
    ai = lam_im * dt
    mag = jnp.exp(ar)
    abr = mag * jnp.cos(ai)
    abi = mag * jnp.sin(ai)
    nr = abr - 1.0
    ni = abi
    den = lam_re * lam_re + lam_im * lam_im
    f_re = (nr * lam_re + ni * lam_im) / den
    f_im = (ni * lam_re - nr * lam_im) / den
    bbr = f_re[..., None] * b_re - f_im[..., None] * b_im
    bbi = f_re[..., None] * b_im + f_im[..., None] * b_re
    return ar, ai, abr, abi, bbr, bbi


def s5_combine(e1, e2):
    a1r, a1i, b1r, b1i = e1
    a2r, a2i, b2r, b2i = e2
    return (a2r * a1r - a2i * a1i,
            a2r * a1i + a2i * a1r,
            a2r * b1r - a2i * b1i + b2r,
            a2r * b1i + a2i * b1r + b2i)


def s5_scan(ug, ar, ai, abr, abi, bbr, bbi, h0r, h0i, reverse):
    L = ug.shape[1]
    bur = jnp.einsum('gpk,blgk->blgp', bbr, ug)
    bui = jnp.einsum('gpk,blgk->blgp', bbi, ug)
    a_re = jnp.broadcast_to(abr, bur.shape)
    a_im = jnp.broadcast_to(abi, bur.shape)
    _, _, hr, hi = lax.associative_scan(s5_combine, (a_re, a_im, bur, bui), reverse=reverse, axis=1)
    if h0r is not None:
        t = jnp.arange(L, dtype=F32)
        n = ((L - t) if reverse else (t + 1.0))[:, None, None]
        mag = jnp.exp(n * ar)
        pr = mag * jnp.cos(n * ai)
        pim = mag * jnp.sin(n * ai)
        hr = hr + pr * h0r[:, None] - pim * h0i[:, None]
        hi = hi + pr * h0i[:, None] + pim * h0r[:, None]
    return hr, hi


def s5_mixer(u, lam_re, lam_im, log_dt, b_re, b_im, c_re, c_im, d_skip, glu_w, glu_b, h0):
    B_, L, _ = u.shape
    uf = u.astype(F32)
    ug = uf.reshape(B_, L, S5_GROUPS, S5_GROUP)
    y = uf * d_skip.astype(F32)
    finals = []
    for dr in range(2):
        ar, ai, abr, abi, bbr, bbi = s5_discretize(lam_re[dr].astype(F32), lam_im[dr].astype(F32),
                                                   log_dt[dr].astype(F32), b_re[dr].astype(F32),
                                                   b_im[dr].astype(F32))
        h0r = None if h0 is None else h0[:, dr, 0].astype(F32)
        h0i = None if h0 is None else h0[:, dr, 1].astype(F32)
        hr, hi = s5_scan(ug, ar, ai, abr, abi, bbr, bbi, h0r, h0i, reverse=(dr == 1))
        yd = (jnp.einsum('gkp,blgp->blgk', c_re[dr].astype(F32), hr)
              - jnp.einsum('gkp,blgp->blgk', c_im[dr].astype(F32), hi))
        y = y + yd.reshape(B_, L, D_MODEL)
        idx = L - 1 if dr == 0 else 0
        finals.append(jnp.stack([hr[:, idx], hi[:, idx]], axis=1))
    z = jax.nn.gelu(y).astype(u.dtype) @ glu_w + glu_b
    za, zg = jnp.split(z, 2, axis=-1)
    return za * jax.nn.sigmoid(zg), jnp.stack(finals, axis=1)


def na_qkv(h, w_qkv, qn, kn):
    B_, L, _ = h.shape
    qkv = (h @ w_qkv).reshape(B_, L, 3, NA_HEADS, NA_HEAD_DIM)
    return rms_norm(qkv[:, :, 0], qn), rms_norm(qkv[:, :, 1], kn), qkv[:, :, 2]


def na_context(h, w_qkv, qn, kn, w_o):
    B_, L, _ = h.shape
    q, k, v = na_qkv(h, w_qkv, qn, kn)
    o = blocked_attention(q, k, v)
    return o.reshape(B_, L, D_MODEL) @ w_o, k, v


def na_latent(h, w_qkv, qn, kn, rpb, w_o, k_ctx, v_ctx):
    B_, L, _ = h.shape
    rows = L // GRID_W
    kh = min(NA_KH, rows)
    ncb = GRID_W // NA_QCB
    H, d = NA_HEADS, NA_HEAD_DIM
    q, k, v = na_qkv(h, w_qkv, qn, kn)
    r = jnp.arange(rows)
    rs = jnp.clip(r - kh // 2, 0, rows - kh)
    ri = rs[:, None] + jnp.arange(kh)
    j = jnp.arange(ncb)
    cb = jnp.clip(j * NA_QCB - NA_KW // 2, 0, GRID_W - NA_KCB)
    ci = cb[:, None] + jnp.arange(NA_KCB)
    rsel = ri[:, None, :, None]
    csel = ci[None, :, None, :]
    kg = k.reshape(B_, rows, GRID_W, H, d)[:, rsel, csel].reshape(B_, rows, ncb, kh * NA_KCB, H, d)
    vg = v.reshape(B_, rows, GRID_W, H, d)[:, rsel, csel].reshape(B_, rows, ncb, kh * NA_KCB, H, d)
    qg = q.reshape(B_, rows, ncb, NA_QCB, H, d)
    scale = d ** -0.5
    s_loc = jnp.einsum('brjqhd,brjkhd->bhrjqk', qg, kg).astype(F32) * scale
    qc = j[:, None] * NA_QCB + jnp.arange(NA_QCB)
    cs = jnp.clip(qc - NA_KW // 2, 0, GRID_W - NA_KW)
    kc = ci[:, None, :]
    col_ok = (kc >= cs[:, :, None]) & (kc < cs[:, :, None] + NA_KW)
    dc = jnp.clip(kc - qc[:, :, None] + NA_KW - 1, 0, 2 * NA_KW - 2)
    drow = ri - r[:, None] + NA_KH - 1
    bias = rpb.astype(F32)[:, drow[:, None, None, :, None], dc[None, :, :, None, :]]
    bias = bias.reshape(H, rows, ncb, NA_QCB, kh * NA_KCB)
    mask = jnp.broadcast_to(col_ok[:, :, None, :], (ncb, NA_QCB, kh, NA_KCB)).reshape(ncb, NA_QCB, kh * NA_KCB)
    s_loc = jnp.where(mask, s_loc + bias, -jnp.inf)
    s_ctx = jnp.einsum('brjqhd,bchd->bhrjqc', qg, k_ctx).astype(F32) * scale
    nloc = kh * NA_KCB
    p = jax.nn.softmax(jnp.concatenate([s_loc, s_ctx], axis=-1), axis=-1).astype(v.dtype)
    o = (jnp.einsum('bhrjqk,brjkhd->brjqhd', p[..., :nloc], vg)
         + jnp.einsum('bhrjqc,bchd->brjqhd', p[..., nloc:], v_ctx))
    return o.reshape(B_, L, D_MODEL) @ w_o


def gqa_qkv(h, w_qkv, qn, kn):
    B_, L, _ = h.shape
    z = h @ w_qkv
    nq = GQA_Q_HEADS * GQA_HEAD_DIM
    nk = GQA_KV_HEADS * GQA_HEAD_DIM
    q = z[..., :nq].reshape(B_, L, GQA_Q_HEADS, GQA_HEAD_DIM)
    k = z[..., nq:nq + nk].reshape(B_, L, GQA_KV_HEADS, GQA_HEAD_DIM)
    v = z[..., nq + nk:].reshape(B_, L, GQA_KV_HEADS, GQA_HEAD_DIM)
    return rms_norm(q, qn), rms_norm(k, kn), v


def gqa_context(h, w_qkv, qn, kn, w_o):
    B_, L, _ = h.shape
    q, k, v = gqa_qkv(h, w_qkv, qn, kn)
    o = blocked_attention(q, k, v)
    return o.reshape(B_, L, D_MODEL) @ w_o, k, v


def gqa_latent(h, w_qkv, qn, kn, w_o, k_ctx, v_ctx):
    B_, L, _ = h.shape
    q, k, v = gqa_qkv(h, w_qkv, qn, kn)
    cos, sin = axial_rope_tables(L, GQA_HEAD_DIM)
    q = apply_rope(q, cos, sin)
    k = apply_rope(k, cos, sin)
    k_all = jnp.concatenate([k, k_ctx.astype(k.dtype)], axis=1)
    v_all = jnp.concatenate([v, v_ctx.astype(v.dtype)], axis=1)
    o = blocked_attention(q, k_all, v_all)
    return o.reshape(B_, L, D_MODEL) @ w_o


def setup_inputs(seed: int = 0) -> dict:
    key = jax.random.key(seed)
    ks = iter(jax.random.split(key, 48))

    def nrm(shape, s):
        return jax.random.normal(next(ks), shape, F32) * s

    G, P, K = S5_GROUPS, S5_STATE, S5_GROUP
    D = D_MODEL
    inp = {}
    inp['x_prompt'] = nrm((BATCH, SEQ, D), 1.0)
    inp['x_sample'] = nrm((DEC_BATCH, DEC_SEQ, D), 1.0)
    inp['state_s5'] = nrm((DEC_BATCH, N_S5, 2, 2, G, P), 0.1)
    inp['cache_na_k'] = nrm((DEC_BATCH, N_NA, PAST_LEN, NA_HEADS, NA_HEAD_DIM), 1.0)
    inp['cache_na_v'] = nrm((DEC_BATCH, N_NA, PAST_LEN, NA_HEADS, NA_HEAD_DIM), 1.0)
    inp['cache_gqa_k'] = nrm((DEC_BATCH, N_GQA, PAST_LEN, GQA_KV_HEADS, GQA_HEAD_DIM), 1.0)
    inp['cache_gqa_v'] = nrm((DEC_BATCH, N_GQA, PAST_LEN, GQA_KV_HEADS, GQA_HEAD_DIM), 1.0)
    inp['c'] = nrm((DEC_BATCH, D), 1.0)
    inp['c_ctx'] = nrm((D,), 1.0)
    inp['norm_g'] = 1.0 + nrm((DEPTH, 2, D), 0.01)
    inp['ada_w'] = nrm((DEPTH, D, 6 * D), D ** -0.5)
    inp['ada_b'] = nrm((DEPTH, 6 * D), 0.02)
    inp['mlp_w1'] = nrm((DEPTH, D, D_FF), D ** -0.5)
    inp['mlp_w2'] = nrm((DEPTH, D_FF, D), D_FF ** -0.5)
    inp['s5_lam_re'] = -0.5 + nrm((N_S5, 2, G, P), 0.01)
    inp['s5_lam_im'] = jnp.broadcast_to(jnp.pi * jnp.arange(P, dtype=F32), (N_S5, 2, G, P))
    inp['s5_log_dt'] = jax.random.uniform(next(ks), (N_S5, 2, G), F32,
                                          minval=math.log(S5_DT_MIN), maxval=math.log(S5_DT_MAX))
    inp['s5_b_re'] = nrm((N_S5, 2, G, P, K), (2.0 * K) ** -0.5)
    inp['s5_b_im'] = nrm((N_S5, 2, G, P, K), (2.0 * K) ** -0.5)
    inp['s5_c_re'] = nrm((N_S5, 2, G, K, P), (2.0 * P) ** -0.5)
    inp['s5_c_im'] = nrm((N_S5, 2, G, K, P), (2.0 * P) ** -0.5)
    inp['s5_d'] = nrm((N_S5, D), 0.5)
    inp['s5_glu_w'] = nrm((N_S5, D, 2 * D), D ** -0.5)
    inp['s5_glu_b'] = nrm((N_S5, 2 * D), 0.02)
    inp['na_w_qkv'] = nrm((N_NA, D, 3 * D), D ** -0.5)
    inp['na_q_norm'] = 1.0 + nrm((N_NA, NA_HEAD_DIM), 0.01)
    inp['na_k_norm'] = 1.0 + nrm((N_NA, NA_HEAD_DIM), 0.01)
    inp['na_rpb'] = nrm((N_NA, NA_HEADS, 2 * NA_KH - 1, 2 * NA_KW - 1), 0.1)
    inp['na_w_o'] = nrm((N_NA, D, D), D ** -0.5)
    inp['gqa_w_qkv'] = nrm((N_GQA, D, (GQA_Q_HEADS + 2 * GQA_KV_HEADS) * GQA_HEAD_DIM), D ** -0.5)
    inp['gqa_q_norm'] = 1.0 + nrm((N_GQA, GQA_HEAD_DIM), 0.01)
    inp['gqa_k_norm'] = 1.0 + nrm((N_GQA, GQA_HEAD_DIM), 0.01)
    inp['gqa_w_o'] = nrm((N_GQA, D, D), D ** -0.5)
    return inp


def reference(x_prompt, x_sample, state_s5, cache_na_k, cache_na_v, cache_gqa_k, cache_gqa_v,
              c, c_ctx, norm_g, ada_w, ada_b, mlp_w1, mlp_w2,
              s5_lam_re, s5_lam_im, s5_log_dt, s5_b_re, s5_b_im, s5_c_re, s5_c_im, s5_d,
              s5_glu_w, s5_glu_b, na_w_qkv, na_q_norm, na_k_norm, na_rpb, na_w_o,
              gqa_w_qkv, gqa_q_norm, gqa_k_norm, gqa_w_o):
    xp = x_prompt
    xs = x_sample
    new_s5, new_na_k, new_na_v, new_gqa_k, new_gqa_v = [], [], [], [], []
    for i in range(DEPTH):
        kind = i % N_MIXERS
        slot = i // N_MIXERS
        p_sh1, p_sc1, p_g1, p_sh2, p_sc2, p_g2 = modulation(c_ctx[None, :], ada_w[i], ada_b[i])
        s_sh1, s_sc1, s_g1, s_sh2, s_sc2, s_g2 = modulation(c, ada_w[i], ada_b[i])
        hp = rms_norm(xp, norm_g[i, 0]) * (1.0 + p_sc1) + p_sh1
        hs = rms_norm(xs, norm_g[i, 0]) * (1.0 + s_sc1) + s_sh1
        if kind == 0:
            s5_args = (s5_lam_re[slot], s5_lam_im[slot], s5_log_dt[slot], s5_b_re[slot], s5_b_im[slot],
                       s5_c_re[slot], s5_c_im[slot], s5_d[slot], s5_glu_w[slot], s5_glu_b[slot])
            yp, st = s5_mixer(hp, *s5_args, None)
            ys, _ = s5_mixer(hs, *s5_args, state_s5[:, slot])
            new_s5.append(st)
        elif kind == 1:
            yp, kc, vc = na_context(hp, na_w_qkv[slot], na_q_norm[slot], na_k_norm[slot], na_w_o[slot])
            ys = na_latent(hs, na_w_qkv[slot], na_q_norm[slot], na_k_norm[slot], na_rpb[slot], na_w_o[slot],
                           cache_na_k[:, slot], cache_na_v[:, slot])
            new_na_k.append(kc)
            new_na_v.append(vc)
        else:
            yp, kc, vc = gqa_context(hp, gqa_w_qkv[slot], gqa_q_norm[slot], gqa_k_norm[slot], gqa_w_o[slot])
            ys = gqa_latent(hs, gqa_w_qkv[slot], gqa_q_norm[slot], gqa_k_norm[slot], gqa_w_o[slot],
                            cache_gqa_k[:, slot], cache_gqa_v[:, slot])
            new_gqa_k.append(kc)
            new_gqa_v.append(vc)
        xp = xp + p_g1 * yp.astype(xp.dtype)
        xs = xs + s_g1 * ys.astype(xs.dtype)
        hp = rms_norm(xp, norm_g[i, 1]) * (1.0 + p_sc2) + p_sh2
        hs = rms_norm(xs, norm_g[i, 1]) * (1.0 + s_sc2) + s_sh2
        xp = xp + p_g2 * sqrelu_mlp(hp, mlp_w1[i], mlp_w2[i])
        xs = xs + s_g2 * sqrelu_mlp(hs, mlp_w1[i], mlp_w2[i])
    return (xp, xs, jnp.stack(new_s5, axis=1), jnp.stack(new_na_k, axis=1), jnp.stack(new_na_v, axis=1),
            jnp.stack(new_gqa_k, axis=1), jnp.stack(new_gqa_v, axis=1))
```

```cpp
#include <hip/hip_runtime.h>
#include <hip/hip_bf16.h>
#include <hip/hip_cooperative_groups.h>
#include <cstdio>
namespace cg = cooperative_groups;

typedef unsigned short bf16_t;
using bf16 = __hip_bfloat16;
using bf16x8 = __attribute__((ext_vector_type(8))) short;
using f32x4 = __attribute__((ext_vector_type(4))) float;
using f32x16 = __attribute__((ext_vector_type(16))) float;

#define B_AUX 0
#ifndef USE_GLDS
#define USE_GLDS 1
#endif
#ifndef N_LAUNCH_MODE
#define N_LAUNCH_MODE 1
#endif

constexpr int NT = 512;
constexpr int D = 1024, NTOK = 8192, DFF = 4096;
constexpr int LDS_BYTES = 131072;
constexpr int NPHASE = 31;

constexpr size_t WS_W1T = 0;
constexpr size_t WS_W2T = WS_W1T + 33554432;
constexpr size_t WS_GLUT = WS_W2T + 33554432;
constexpr size_t WS_NAQKVT = WS_GLUT + 8388608;
constexpr size_t WS_NAOT = WS_NAQKVT + 6291456;
constexpr size_t WS_GQAQKVT = WS_NAOT + 2097152;
constexpr size_t WS_GQAOT = WS_GQAQKVT + 3145728;
constexpr size_t WS_MOD = WS_GQAOT + 2097152;
constexpr size_t WS_S5A = WS_MOD + 491520;
constexpr size_t WS_S5BB = WS_S5A + 131072;
constexpr size_t WS_S5CM = WS_S5BB + 1048576;
constexpr size_t WS_S5E = WS_S5CM + 1048576;
constexpr size_t WS_CKNA = WS_S5E + 8388608;
constexpr size_t WS_CVTNA = WS_CKNA + 4194304;
constexpr size_t WS_CKGQA = WS_CVTNA + 4194304;
constexpr size_t WS_CVTGQA = WS_CKGQA + 1048576;
constexpr size_t WS_HB = WS_CVTGQA + 1048576;
constexpr size_t WS_AO = WS_HB + 16777216;
constexpr size_t WS_QK = WS_AO + 16777216;
constexpr size_t WS_VT = WS_QK + 33554432;
constexpr size_t WS_ACT = WS_VT + 16777216;
constexpr size_t WS_END = WS_ACT + 67108864;

constexpr size_t OUT_YS = 4194304, OUT_S5 = 8388608, OUT_NAK = 8912896, OUT_NAV = 13107200, OUT_GQAK = 17301504, OUT_GQAV = 18350080;

struct Params {
  const float* in[33];
  float* out;
  unsigned char* ws;
  int ph_lo, ph_hi;
};

extern __shared__ __attribute__((aligned(16))) unsigned char smem[];

__device__ __forceinline__ unsigned cvt_pk_bf16(float lo, float hi) {
  unsigned r; asm("v_cvt_pk_bf16_f32 %0, %1, %2" : "=v"(r) : "v"(lo), "v"(hi)); return r;
}
__device__ __forceinline__ bf16_t f2bf(float f) { return (bf16_t)(cvt_pk_bf16(f, 0.f) & 0xffffu); }
__device__ __forceinline__ float bf2f(bf16_t b) { return __uint_as_float(((unsigned)b) << 16); }
__device__ __forceinline__ float bflo(unsigned u) { return __uint_as_float(u << 16); }
__device__ __forceinline__ float bfhi(unsigned u) { return __uint_as_float(u & 0xffff0000u); }
__device__ __forceinline__ int cond_of_row(int row) { return row < 4096 ? 0 : 1 + ((row - 4096) >> 10); }

__device__ __forceinline__ int opaque_tid() { int t = threadIdx.x; asm volatile("" : "+v"(t)); return t; }
#define MFMA_SETTLE() asm volatile("s_nop 15\n\ts_nop 15" ::: "memory")
__device__ __forceinline__ void bu_mfma4(f32x16& c0, f32x16& c1, f32x16& c2, f32x16& c3, bf16x8 a, bf16x8 b0, bf16x8 b1, bf16x8 b2, bf16x8 b3) {
  asm volatile("v_mfma_f32_32x32x16_bf16 %0, %4, %5, 0\n\t"
               "v_mfma_f32_32x32x16_bf16 %1, %4, %6, 0\n\t"
               "v_mfma_f32_32x32x16_bf16 %2, %4, %7, 0\n\t"
               "v_mfma_f32_32x32x16_bf16 %3, %4, %8, 0\n\t"
               "s_nop 15\n\ts_nop 15"
               : "=&v"(c0), "=&v"(c1), "=&v"(c2), "=&v"(c3) : "v"(a), "v"(b0), "v"(b1), "v"(b2), "v"(b3));
}
struct cplx { float re, im; };
__device__ __forceinline__ cplx cmul(cplx a, cplx b) { return {a.re * b.re - a.im * b.im, a.re * b.im + a.im * b.re}; }
__device__ __forceinline__ cplx cfma(cplx a, cplx h, cplx b) {
  cplx r; r.re = fmaf(a.re, h.re, fmaf(-a.im, h.im, b.re)); r.im = fmaf(a.re, h.im, fmaf(a.im, h.re, b.im)); return r;
}

constexpr int BM = 256, BK = 64, NXCD = 8, WGM = 8;

__device__ __forceinline__ int lds_byte(int r, int c) {
  int st = (r >> 4) * 2 + (c >> 5), ob = (r & 15) * 64 + (c & 31) * 2;
  return st * 1024 + (ob ^ (((ob >> 9) & 1) << 5));
}
__device__ __forceinline__ void stage_rc(int b, int& R, int& C) {
  int st = b >> 10, sb = b & 1023, swz = sb ^ (((sb >> 9) & 1) << 5);
  R = (st / 2) * 16 + swz / 64; C = (st % 2) * 32 + (swz % 64) / 2;
}

struct GemmArgs { const bf16_t* A; int lda; const bf16_t* Bt; int ldb; int nM, nN, K; int kmask; };

template <int BN, class Epi>
__device__ __forceinline__ void gemm_phase(const GemmArgs ga, const Epi epi) {
  constexpr int TILE_A = BM * BK * 2, TILE_B = BN * BK * 2, STAGE_B = TILE_A + TILE_B, GLA = TILE_A / 8192, GLB = TILE_B / 8192, NF = BN / 64;
  unsigned char* shm = smem;
  const int tid = opaque_tid(), wid = tid >> 6, lane = tid & 63, wr = wid >> 2, wc = wid & 3, fr = lane & 15, fq = lane >> 4;
  unsigned voA[GLA], voB[GLB];
#pragma unroll
  for (int i = 0; i < GLA; ++i) { int r_, c_; stage_rc(wid * 1024 + i * 8192 + lane * 16, r_, c_); voA[i] = (unsigned)(r_ * ga.lda + c_) * 2u; }
#pragma unroll
  for (int i = 0; i < GLB; ++i) { int r_, c_; stage_rc(wid * 1024 + i * 8192 + lane * 16, r_, c_); voB[i] = (unsigned)(r_ * ga.ldb + c_) * 2u; }
  int offA[8], offB[NF];
#pragma unroll
  for (int m = 0; m < 8; ++m) offA[m] = lds_byte(wr * 128 + m * 16 + fr, fq * 8);
#pragma unroll
  for (int n = 0; n < NF; ++n) offB[n] = TILE_A + lds_byte(wc * (BN / 4) + n * 16 + fr, fq * 8);
  const int nwg = ga.nM * ga.nN, nt = ga.K / BK;
  for (int u = blockIdx.x; u < nwg; u += gridDim.x) {
    int wgid = u;
    { int q = nwg / NXCD, r = nwg % NXCD, xcd = wgid % NXCD, off = wgid / NXCD;
      wgid = (xcd < r ? xcd * (q + 1) : r * (q + 1) + (xcd - r) * q) + off; }
    const int nig = WGM * ga.nN, gid = wgid / nig, fm = gid * WGM, gsz = min(ga.nM - fm, WGM);
    const int pm = fm + ((wgid % nig) % gsz), pn = (wgid % nig) / gsz, brow = pm * BM, bcol = pn * BN;
    const bf16_t* Ab = ga.A + (long)brow * ga.lda;
    const bf16_t* Bb = ga.Bt + (long)bcol * ga.ldb;
#define GLDS_STAGE(buf, kt) do { \
    _Pragma("unroll") for (int i = 0; i < GLA; ++i) \
      __builtin_amdgcn_global_load_lds((const unsigned*)((const char*)(Ab + ((kt) & ga.kmask) * BK) + voA[i]), \
        (__attribute__((address_space(3))) unsigned*)(shm + (buf) * STAGE_B + wid * 1024 + i * 8192), 16, 0, 0); \
    _Pragma("unroll") for (int i = 0; i < GLB; ++i) \
      __builtin_amdgcn_global_load_lds((const unsigned*)((const char*)(Bb + ((kt) & ga.kmask) * BK) + voB[i]), \
        (__attribute__((address_space(3))) unsigned*)(shm + (buf) * STAGE_B + TILE_A + wid * 1024 + i * 8192), 16, 0, B_AUX); } while (0)
    f32x4 acc[8][NF];
#pragma unroll
    for (int m = 0; m < 8; ++m)
#pragma unroll
      for (int n = 0; n < NF; ++n) acc[m][n] = (f32x4){0.f, 0.f, 0.f, 0.f};
#define COMPUTE(cur_) do { const unsigned char* sb = shm + (cur_) * STAGE_B; \
      _Pragma("unroll") for (int ks = 0; ks < 2; ++ks) { \
        bf16x8 At[8], Bf[NF]; \
        _Pragma("unroll") for (int m = 0; m < 8; ++m) At[m] = *(const bf16x8*)(sb + offA[m] + ks * 1024); \
        _Pragma("unroll") for (int n = 0; n < NF; ++n) Bf[n] = *(const bf16x8*)(sb + offB[n] + ks * 1024); \
        _Pragma("unroll") for (int m = 0; m < 8; ++m) \
          _Pragma("unroll") for (int n = 0; n < NF; ++n) acc[m][n] = __builtin_amdgcn_mfma_f32_16x16x32_bf16(Bf[n], At[m], acc[m][n], 0, 0, 0); \
        __builtin_amdgcn_sched_barrier(0); } } while (0)
#if USE_GLDS
    GLDS_STAGE(0, 0);
    asm volatile("s_waitcnt vmcnt(0)" ::: "memory"); __syncthreads();
    for (int t = 0; t < nt; ++t) {
      const int cur = t & 1;
      if (t + 1 < nt) GLDS_STAGE(cur ^ 1, t + 1);
      COMPUTE(cur);
      asm volatile("s_waitcnt vmcnt(0)" ::: "memory"); __syncthreads();
    }
#else
    uint4 sa0, sa1, sa2, sa3, sb0, sb1, sb2, sb3;
    static_assert(GLA == 4 && (GLB == 2 || GLB == 4), "staging shape");
#define GSRC_A(kt, i) (*(const uint4*)((const char*)(Ab + ((kt) & ga.kmask) * BK) + voA[i]))
#define GSRC_B(kt, i) (*(const uint4*)((const char*)(Bb + ((kt) & ga.kmask) * BK) + voB[i]))
#define LDST_A(buf, i) (*(uint4*)(shm + (buf) * STAGE_B + wid * 1024 + (i) * 8192 + lane * 16))
#define LDST_B(buf, i) (*(uint4*)(shm + (buf) * STAGE_B + TILE_A + wid * 1024 + (i) * 8192 + lane * 16))
#define REG_ISSUE(kt) do { sa0 = GSRC_A(kt, 0); sa1 = GSRC_A(kt, 1); sa2 = GSRC_A(kt, 2); sa3 = GSRC_A(kt, 3); \
      sb0 = GSRC_B(kt, 0); sb1 = GSRC_B(kt, 1); if constexpr (GLB == 4) { sb2 = GSRC_B(kt, 2); sb3 = GSRC_B(kt, 3); } } while (0)
#define REG_WRITE(buf) do { LDST_A(buf, 0) = sa0; LDST_A(buf, 1) = sa1; LDST_A(buf, 2) = sa2; LDST_A(buf, 3) = sa3; \
      LDST_B(buf, 0) = sb0; LDST_B(buf, 1) = sb1; if constexpr (GLB == 4) { LDST_B(buf, 2) = sb2; LDST_B(buf, 3) = sb3; } } while (0)
    REG_ISSUE(0); REG_WRITE(0); REG_ISSUE(1); __syncthreads();
    for (int t = 0; t < nt; ++t) {
      const int cur = t & 1;
      if (t + 1 < nt) REG_WRITE(cur ^ 1);
      if (t + 2 < nt) REG_ISSUE(t + 2);
      COMPUTE(cur);
      __syncthreads();
    }
#undef REG_ISSUE
#undef REG_WRITE
#endif
#undef COMPUTE
#undef GLDS_STAGE
    epi(acc, brow + wr * 128 + fr, bcol + wc * (BN / 4) + fq * 4);
  }
  __syncthreads();
}

struct EpiSqRelu {
  bf16_t* O;
  template <int NF> __device__ __forceinline__ void operator()(const f32x4 (&acc)[8][NF], int row0, int col0) const {
#pragma unroll
    for (int m = 0; m < 8; ++m)
#pragma unroll
      for (int n = 0; n < NF; ++n) {
        f32x4 v = acc[m][n];
        float a0 = fmaxf(v[0], 0.f), a1 = fmaxf(v[1], 0.f), a2 = fmaxf(v[2], 0.f), a3 = fmaxf(v[3], 0.f);
        uint2 pk; pk.x = cvt_pk_bf16(a0 * a0, a1 * a1); pk.y = cvt_pk_bf16(a2 * a2, a3 * a3);
        *(uint2*)(O + (size_t)(row0 + 16 * m) * DFF + col0 + 16 * n) = pk;
      }
  }
};
struct EpiResid {
  float* X; const float* gate;
  template <int NF> __device__ __forceinline__ void operator()(const f32x4 (&acc)[8][NF], int row0, int col0) const {
    const float* gp = gate + cond_of_row(row0) * 6144;
#pragma unroll
    for (int n = 0; n < NF; ++n) {
      const f32x4 gv = *(const f32x4*)(gp + col0 + 16 * n);
#pragma unroll
      for (int m = 0; m < 8; ++m) {
        float* xp = X + (size_t)(row0 + 16 * m) * D + col0 + 16 * n;
        f32x4 o = *(f32x4*)xp; o += acc[m][n] * gv; *(f32x4*)xp = o;
      }
    }
  }
};
struct EpiGlu {
  float* X; const float* gate; const float* bias;
  template <int NF> __device__ __forceinline__ void operator()(const f32x4 (&acc)[8][NF], int row0, int col0) const {
    const float* gp = gate + cond_of_row(row0) * 6144;
    const int col = (col0 >> 7) * 64 + ((col0 >> 5) & 3) * 16 + (col0 & 15);
    const f32x4 gv = *(const f32x4*)(gp + col);
    const f32x4 ba = *(const f32x4*)(bias + col), bg = *(const f32x4*)(bias + 1024 + col);
#pragma unroll
    for (int m = 0; m < 8; ++m) {
      float* xp = X + (size_t)(row0 + 16 * m) * D + col;
      f32x4 a = acc[m][0] + ba, g = acc[m][1] + bg;
      f32x4 o = *(f32x4*)xp;
#pragma unroll
      for (int i = 0; i < 4; ++i) { float s = 1.f / (1.f + __expf(-g[i])); o[i] += gv[i] * a[i] * s; }
      *(f32x4*)xp = o;
    }
  }
};
struct EpiQkv {
  bf16_t* QK; int nqk; bf16_t* VT; int C; float* newv;
  template <int NF> __device__ __forceinline__ void operator()(const f32x4 (&acc)[8][NF], int row0, int col0) const {
    if (col0 < nqk) {
#pragma unroll
      for (int m = 0; m < 8; ++m)
#pragma unroll
        for (int n = 0; n < NF; ++n) {
          f32x4 v = acc[m][n];
          uint2 pk; pk.x = cvt_pk_bf16(v[0], v[1]); pk.y = cvt_pk_bf16(v[2], v[3]);
          *(uint2*)(QK + (size_t)(row0 + 16 * m) * nqk + col0 + 16 * n) = pk;
        }
    } else {
      const int vc0 = col0 - nqk;
#pragma unroll
      for (int m = 0; m < 8; ++m) {
        const int row = row0 + 16 * m;
        size_t vbase; int ldv;
        if (row < 4096) { vbase = (size_t)(row >> 8) * C * 256 + (row & 255); ldv = 256; }
        else { const int r2 = row - 4096; vbase = (size_t)4096 * C + (size_t)(r2 >> 10) * C * 1024 + (r2 & 1023); ldv = 1024; }
#pragma unroll
        for (int n = 0; n < NF; ++n) {
          const int col = vc0 + 16 * n;
          f32x4 v = acc[m][n];
#pragma unroll
          for (int i = 0; i < 4; ++i) VT[vbase + (size_t)(col + i) * ldv] = f2bf(v[i]);
          if (row < 4096) *(f32x4*)(newv + (size_t)row * C + col) = v;
        }
      }
    }
  }
};

__device__ void conv_job(const Params& p, int job, const float*& src, bf16_t*& dst, int& K, int& N, int& perm) {
  unsigned char* ws = p.ws; perm = 0;
  if (job < 4) { src = p.in[12] + (size_t)job * 1024 * 4096; dst = (bf16_t*)(ws + WS_W1T) + (size_t)job * 4096 * 1024; K = 1024; N = 4096; }
  else if (job < 8) { int l = job - 4; src = p.in[13] + (size_t)l * 4096 * 1024; dst = (bf16_t*)(ws + WS_W2T) + (size_t)l * 1024 * 4096; K = 4096; N = 1024; }
  else if (job < 10) { int s = job - 8; src = p.in[22] + (size_t)s * 1024 * 2048; dst = (bf16_t*)(ws + WS_GLUT) + (size_t)s * 2048 * 1024; K = 1024; N = 2048; perm = 1; }
  else if (job == 10) { src = p.in[24]; dst = (bf16_t*)(ws + WS_NAQKVT); K = 1024; N = 3072; }
  else if (job == 11) { src = p.in[28]; dst = (bf16_t*)(ws + WS_NAOT); K = 1024; N = 1024; }
  else if (job == 12) { src = p.in[29]; dst = (bf16_t*)(ws + WS_GQAQKVT); K = 1024; N = 1536; }
  else if (job == 13) { src = p.in[32]; dst = (bf16_t*)(ws + WS_GQAOT); K = 1024; N = 1024; }
  else if (job < 18) { int b = job - 14; src = p.in[4] + (size_t)b * 512 * 1024; dst = (bf16_t*)(ws + WS_CVTNA) + (size_t)b * 1024 * 512; K = 512; N = 1024; }
  else { int b = job - 18; src = p.in[6] + (size_t)b * 512 * 256; dst = (bf16_t*)(ws + WS_CVTGQA) + (size_t)b * 256 * 512; K = 512; N = 256; }
}

__device__ void do_transposes(const Params& p, int job_lo, int job_hi);
__device__ void phase_prologue(const Params& p) {
  const int tid = opaque_tid(), G = gridDim.x;
  unsigned char* ws = p.ws;
  float* MOD = (float*)(ws + WS_MOD);
  {
    float* sl = (float*)smem;
    float* red = (float*)smem + 5 * 1024;
    bool have = false;
    for (int it = blockIdx.x; it < 192; it += G) {
      if (!have) {
        for (int i = tid; i < 5 * 1024; i += NT) {
          int c = i >> 10, k = i & 1023;
          float v = (c == 0) ? p.in[8][k] : p.in[7][(c - 1) * 1024 + k];
          sl[i] = v / (1.f + __expf(-v));
        }
        have = true;
      }
      __syncthreads();
      const int layer = it / 48, col0 = (it % 48) * 128;
      const int cg4 = tid & 31, ksl = tid >> 5;
      const float* wp = p.in[10] + (size_t)layer * 1024 * 6144 + col0 + cg4 * 4;
      f32x4 a[5];
      for (int c = 0; c < 5; ++c) a[c] = (f32x4){0.f, 0.f, 0.f, 0.f};
#pragma unroll 8
      for (int kk = 0; kk < 64; ++kk) {
        const int k = ksl * 64 + kk;
        const f32x4 w = *(const f32x4*)(wp + (size_t)k * 6144);
        for (int c = 0; c < 5; ++c) a[c] += w * sl[c * 1024 + k];
      }
      for (int c = 0; c < 5; ++c) *(f32x4*)(red + (ksl * 5 + c) * 128 + cg4 * 4) = a[c];
      __syncthreads();
      for (int o = tid; o < 640; o += NT) {
        const int c = o >> 7, col = o & 127;
        float s = p.in[11][layer * 6144 + col0 + col];
        for (int k2 = 0; k2 < 16; ++k2) s += red[(k2 * 5 + c) * 128 + col];
        MOD[(layer * 5 + c) * 6144 + col0 + col] = s;
      }
      __syncthreads();
    }
    __syncthreads();
  }
  {
    float* S5A = (float*)(ws + WS_S5A);
    bf16_t* BB = (bf16_t*)(ws + WS_S5BB);
    bf16_t* CM = (bf16_t*)(ws + WS_S5CM);
    for (int it = (blockIdx.x + 64) % G; it < 256; it += G) {
      const int sdg = it;
      const int g = it & 63;
      const float dt = expf(p.in[16][sdg]);
      for (int idx = tid; idx < 1024; idx += NT) {
        const int pp = idx >> 4, ch = idx & 15;
        const float lr = p.in[14][sdg * 64 + pp], li = p.in[15][sdg * 64 + pp];
        const float ar = lr * dt, ai = li * dt;
        const float mag = expf(ar), cs = cosf(ai), sn = sinf(ai), sh = sinf(0.5f * ai);
        const float abr = mag * cs, abi = mag * sn;
        const float nr = expm1f(ar) * cs - 2.f * sh * sh, ni = abi;
        const float den = lr * lr + li * li;
        const float fre = (nr * lr + ni * li) / den, fim = (ni * lr - nr * li) / den;
        const float br = p.in[17][(sdg * 64 + pp) * 16 + ch], bi = p.in[18][(sdg * 64 + pp) * 16 + ch];
        const float bbr = fre * br - fim * bi, bbi = fre * bi + fim * br;
        BB[((size_t)sdg * 128 + pp) * 16 + ch] = f2bf(bbr);
        BB[((size_t)sdg * 128 + 64 + pp) * 16 + ch] = f2bf(bbi);
        const float cr = p.in[19][(sdg * 16 + ch) * 64 + pp], ci = p.in[20][(sdg * 16 + ch) * 64 + pp];
        const int q = pp & 31, s2 = (pp >> 5) * 2;
        CM[((size_t)sdg * 16 + ch) * 128 + 4 * q + s2] = f2bf(cr);
        CM[((size_t)sdg * 16 + ch) * 128 + 4 * q + s2 + 1] = f2bf(-ci);
        if (ch == 0) { S5A[(sdg * 64 + pp) * 2] = abr; S5A[(sdg * 64 + pp) * 2 + 1] = abi; }
      }
      (void)g;
    }
  }
  {
    const size_t n1 = 4 * 512 * 1024 / 4, n2 = 4 * 512 * 256 / 4;
    uint2* d1 = (uint2*)(ws + WS_CKNA); uint2* d2 = (uint2*)(ws + WS_CKGQA);
    const f32x4* s1 = (const f32x4*)p.in[3]; const f32x4* s2 = (const f32x4*)p.in[5];
    for (size_t i = (size_t)blockIdx.x * NT + tid; i < n1 + n2; i += (size_t)G * NT) {
      f32x4 v = (i < n1) ? s1[i] : s2[i - n1];
      uint2 pk; pk.x = cvt_pk_bf16(v[0], v[1]); pk.y = cvt_pk_bf16(v[2], v[3]);
      if (i < n1) d1[i] = pk; else d2[i - n1] = pk;
    }
  }
  do_transposes(p, 0, 22);
}

__device__ void do_transposes(const Params& p, int job_lo, int job_hi) {
  const int tid = opaque_tid(), G = gridDim.x;
  {
    bf16_t* T = (bf16_t*)smem;
    int base = 0;
    for (int job = job_lo; job < job_hi; ++job) {
      const float* src; bf16_t* dst; int K, N, perm;
      conv_job(p, job, src, dst, K, N, perm);
      const int tn = N >> 6, ntile = (K >> 6) * tn;
      const int start = (int)(((long)blockIdx.x - (base % G) + G) % G);
      for (int tile = start; tile < ntile; tile += G) {
        const int k0 = (tile / tn) << 6, n0 = (tile % tn) << 6;
        __syncthreads();
        for (int ps = 0; ps < 2; ++ps) {
          const int kr = (tid >> 4) + ps * 32, n4 = tid & 15;
          const f32x4 v = *(const f32x4*)(src + (size_t)(k0 + kr) * N + n0 + n4 * 4);
          for (int i = 0; i < 4; ++i) T[(n4 * 4 + i) * 72 + kr] = f2bf(v[i]);
        }
        __syncthreads();
        { const int n = tid >> 3, kc = tid & 7;
          const uint4 o = *(const uint4*)(T + n * 72 + kc * 8);
          int dr = n0 + n;
          if (perm) { const int isg = dr >= 1024, c1 = dr & 1023, cc = c1 & 127; dr = (c1 >> 6) * 128 + ((c1 >> 4) & 3) * 32 + (c1 & 15) + isg * 16; (void)cc; }
          *(uint4*)(dst + (size_t)dr * K + k0 + kc * 8) = o; }
      }
      base += ntile;
    }
    __syncthreads();
  }
}

__device__ void phase_norm(const Params& p, int layer, int which, bool first) {
  const int tid_ = opaque_tid(); const int lane = tid_ & 63, wave = tid_ >> 6;
  const float* MOD = (const float*)(p.ws + WS_MOD);
  bf16_t* HB = (bf16_t*)(p.ws + WS_HB);
  const float* gw = p.in[9] + (layer * 2 + which) * 1024;
  for (int row = blockIdx.x * 8 + wave; row < NTOK; row += gridDim.x * 8) {
    const float* xr = first ? (row < 4096 ? p.in[0] + (size_t)row * D : p.in[1] + (size_t)(row - 4096) * D) : p.out + (size_t)row * D;
    f32x4 v[4]; float ss = 0.f;
    for (int i = 0; i < 4; ++i) { v[i] = *(const f32x4*)(xr + i * 256 + lane * 4); ss += v[i][0] * v[i][0] + v[i][1] * v[i][1] + v[i][2] * v[i][2] + v[i][3] * v[i][3]; }
    for (int o = 32; o > 0; o >>= 1) ss += __shfl_xor(ss, o);
    const float rstd = rsqrtf(ss * (1.f / 1024.f) + 1e-6f);
    const float* mp = MOD + (layer * 5 + cond_of_row(row)) * 6144 + which * 3072;
    for (int i = 0; i < 4; ++i) {
      const int col = i * 256 + lane * 4;
#ifdef ZERO_X0
      if (first) *(f32x4*)(p.out + (size_t)row * D + col) = (f32x4){0.f, 0.f, 0.f, 0.f};
#else
      if (first) *(f32x4*)(p.out + (size_t)row * D + col) = v[i];
#endif
      const f32x4 gv = *(const f32x4*)(gw + col), sh = *(const f32x4*)(mp + col), sc = *(const f32x4*)(mp + 1024 + col);
      float o[4];
      for (int j = 0; j < 4; ++j) o[j] = v[i][j] * rstd * gv[j] * (1.f + sc[j]) + sh[j];
      uint2 pk; pk.x = cvt_pk_bf16(o[0], o[1]); pk.y = cvt_pk_bf16(o[2], o[3]);
      *(uint2*)(HB + (size_t)row * D + col) = pk;
    }
  }
}

__device__ __forceinline__ int s5_tok(int rho) { return 16 * ((rho >> 2) & 1) + (rho & 3) + 4 * (rho >> 3); }
__device__ __forceinline__ cplx shfl_c(cplx v, int src) { cplx r; r.re = __shfl(v.re, src); r.im = __shfl(v.im, src); return r; }

__device__ void phase_s5_pass1(const Params& p, int slot) {
  const int tid_ = opaque_tid(); const int lane = tid_ & 63, wave = tid_ >> 6, r = lane & 31, H = lane >> 5;
  const bf16_t* HB = (const bf16_t*)(p.ws + WS_HB);
  const float* S5A = (const float*)(p.ws + WS_S5A);
  const bf16_t* BB = (const bf16_t*)(p.ws + WS_S5BB);
  float* E = (float*)(p.ws + WS_S5E);
  const int tokr = s5_tok(r);
  for (int it = blockIdx.x * 8 + wave; it < 128 * 64; it += gridDim.x * 8) {
    const int ck = it >> 6, g = it & 63, tok0 = ck * 64;
    bf16x8 uf[2];
    _Pragma("unroll") for (int tt = 0; tt < 2; ++tt) uf[tt] = *(const bf16x8*)(HB + (size_t)(tok0 + 32 * tt + tokr) * D + g * 16 + 8 * H);
    _Pragma("unroll") for (int dir = 0; dir < 2; ++dir) {
      const int sdg = (slot * 2 + dir) * 64 + g;
      cplx a0 = {S5A[(sdg * 64 + r) * 2], S5A[(sdg * 64 + r) * 2 + 1]};
      cplx a1 = {S5A[(sdg * 64 + r + 32) * 2], S5A[(sdg * 64 + r + 32) * 2 + 1]};
      cplx a0_16 = a0, a1_16 = a1;
      _Pragma("unroll") for (int i = 0; i < 4; ++i) { a0_16 = cmul(a0_16, a0_16); a1_16 = cmul(a1_16, a1_16); }
      const cplx a0_32 = cmul(a0_16, a0_16), a1_32 = cmul(a1_16, a1_16);
      bf16x8 bfr[4];
      _Pragma("unroll") for (int ct = 0; ct < 4; ++ct) bfr[ct] = *(const bf16x8*)(BB + ((size_t)sdg * 128 + 32 * ct + r) * 16 + 8 * H);
      cplx E0 = {0.f, 0.f}, E1 = {0.f, 0.f};
      _Pragma("unroll") for (int t2 = 0; t2 < 2; ++t2) {
        const int tt = dir ? 1 - t2 : t2;
        f32x16 acc[4];
        bu_mfma4(acc[0], acc[1], acc[2], acc[3], uf[tt], bfr[0], bfr[1], bfr[2], bfr[3]);
        cplx e0 = {0.f, 0.f}, e1 = {0.f, 0.f};
        if (dir == 0) {
          _Pragma("unroll") for (int i = 0; i < 16; ++i) { e0 = cfma(a0, e0, (cplx){acc[0][i], acc[2][i]}); e1 = cfma(a1, e1, (cplx){acc[1][i], acc[3][i]}); }
        } else {
          _Pragma("unroll") for (int i = 15; i >= 0; --i) { e0 = cfma(a0, e0, (cplx){acc[0][i], acc[2][i]}); e1 = cfma(a1, e1, (cplx){acc[1][i], acc[3][i]}); }
        }
        const cplx o0 = shfl_c(e0, lane ^ 32), o1 = shfl_c(e1, lane ^ 32);
        const cplx eL0 = H ? o0 : e0, eU0 = H ? e0 : o0, eL1 = H ? o1 : e1, eU1 = H ? e1 : o1;
        cplx t0, t1;
        if (dir == 0) { t0 = cfma(a0_16, eL0, eU0); t1 = cfma(a1_16, eL1, eU1); }
        else { t0 = cfma(a0_16, eU0, eL0); t1 = cfma(a1_16, eU1, eL1); }
        E0 = cfma(a0_32, E0, t0); E1 = cfma(a1_32, E1, t1);
      }
      const int pp = H ? r + 32 : r;
      const cplx Ev = H ? E1 : E0;
      *(float2*)(E + ((size_t)((ck * 64 + g) * 2 + dir) * 64 + pp) * 2) = make_float2(Ev.re, Ev.im);
    }
  }
}

__device__ void phase_s5_pass2(const Params& p, int slot) {
  const int tid_ = opaque_tid(); const int lane = tid_ & 63, wave = tid_ >> 6, r = lane & 31, H = lane >> 5;
  bf16_t* HB = (bf16_t*)(p.ws + WS_HB);
  const float* S5A = (const float*)(p.ws + WS_S5A);
  const bf16_t* BB = (const bf16_t*)(p.ws + WS_S5BB);
  const bf16_t* CM = (const bf16_t*)(p.ws + WS_S5CM);
  const float* E = (const float*)(p.ws + WS_S5E);
  const float* Dsk = p.in[21] + slot * 1024;
  unsigned char* ldsw = smem + wave * 8704;
  const int tokr = s5_tok(r);
  for (int it = blockIdx.x * 8 + wave; it < 128 * 64; it += gridDim.x * 8) {
    const int ck = it >> 6, g = it & 63, tok0 = ck * 64;
    int c, nc, bq; bool sample;
    if (tok0 < 4096) { bq = tok0 >> 8; c = (tok0 >> 6) & 3; nc = 4; sample = false; }
    else { const int t2 = tok0 - 4096; bq = t2 >> 10; c = (t2 >> 6) & 15; nc = 16; sample = true; }
    const int ck0 = ck - c;
    bf16x8 uf[2];
    _Pragma("unroll") for (int tt = 0; tt < 2; ++tt) uf[tt] = *(const bf16x8*)(HB + (size_t)(tok0 + 32 * tt + tokr) * D + g * 16 + 8 * H);
    f32x4 yacc[2][2];
    _Pragma("unroll") for (int a = 0; a < 2; ++a) _Pragma("unroll") for (int b = 0; b < 2; ++b) yacc[a][b] = (f32x4){0.f, 0.f, 0.f, 0.f};
    _Pragma("unroll") for (int dir = 0; dir < 2; ++dir) {
      const int sdg = (slot * 2 + dir) * 64 + g;
      const cplx a0 = {S5A[(sdg * 64 + r) * 2], S5A[(sdg * 64 + r) * 2 + 1]};
      const cplx a1 = {S5A[(sdg * 64 + r + 32) * 2], S5A[(sdg * 64 + r + 32) * 2 + 1]};
      cplx a0_64 = a0, a1_64 = a1;
      _Pragma("unroll") for (int i = 0; i < 6; ++i) { a0_64 = cmul(a0_64, a0_64); a1_64 = cmul(a1_64, a1_64); }
      cplx c0 = {0.f, 0.f}, c1 = {0.f, 0.f};
      if (sample) {
        const float* h0 = p.in[2] + ((size_t)((bq * 2 + slot) * 2 + dir) * 2) * 4096 + g * 64;
        c0.re = h0[r]; c0.im = h0[4096 + r]; c1.re = h0[r + 32]; c1.im = h0[4096 + r + 32];
      }
      if (dir == 0) {
        for (int cc = 0; cc < c; ++cc) {
          const float* ep = E + ((size_t)(((ck0 + cc) * 64 + g) * 2 + 0) * 64) * 2;
          const float2 v0 = *(const float2*)(ep + r * 2), v1 = *(const float2*)(ep + (r + 32) * 2);
          c0 = cfma(a0_64, c0, (cplx){v0.x, v0.y}); c1 = cfma(a1_64, c1, (cplx){v1.x, v1.y});
        }
      } else {
        for (int cc = nc - 1; cc > c; --cc) {
          const float* ep = E + ((size_t)(((ck0 + cc) * 64 + g) * 2 + 1) * 64) * 2;
          const float2 v0 = *(const float2*)(ep + r * 2), v1 = *(const float2*)(ep + (r + 32) * 2);
          c0 = cfma(a0_64, c0, (cplx){v0.x, v0.y}); c1 = cfma(a1_64, c1, (cplx){v1.x, v1.y});
        }
      }
      bf16x8 bfr[4], cfr[4];
      _Pragma("unroll") for (int ct = 0; ct < 4; ++ct) bfr[ct] = *(const bf16x8*)(BB + ((size_t)sdg * 128 + 32 * ct + r) * 16 + 8 * H);
      _Pragma("unroll") for (int ks = 0; ks < 4; ++ks) cfr[ks] = *(const bf16x8*)(CM + ((size_t)sdg * 16 + (lane & 15)) * 128 + 32 * ks + 8 * (lane >> 4));
      _Pragma("unroll") for (int t2 = 0; t2 < 2; ++t2) {
        const int tt = dir ? 1 - t2 : t2;
        f32x16 acc[4];
        bu_mfma4(acc[0], acc[1], acc[2], acc[3], uf[tt], bfr[0], bfr[1], bfr[2], bfr[3]);
        const int firstH = dir;
        cplx h0 = c0, h1 = c1;
        if (H == firstH) {
          if (dir == 0) { _Pragma("unroll") for (int i = 0; i < 16; ++i) { h0 = cfma(a0, h0, (cplx){acc[0][i], acc[2][i]}); h1 = cfma(a1, h1, (cplx){acc[1][i], acc[3][i]});
                            acc[0][i] = h0.re; acc[2][i] = h0.im; acc[1][i] = h1.re; acc[3][i] = h1.im; } }
          else { _Pragma("unroll") for (int i = 15; i >= 0; --i) { h0 = cfma(a0, h0, (cplx){acc[0][i], acc[2][i]}); h1 = cfma(a1, h1, (cplx){acc[1][i], acc[3][i]});
                            acc[0][i] = h0.re; acc[2][i] = h0.im; acc[1][i] = h1.re; acc[3][i] = h1.im; } }
        }
        h0 = shfl_c(h0, r + 32 * firstH); h1 = shfl_c(h1, r + 32 * firstH);
        if (H != firstH) {
          if (dir == 0) { _Pragma("unroll") for (int i = 0; i < 16; ++i) { h0 = cfma(a0, h0, (cplx){acc[0][i], acc[2][i]}); h1 = cfma(a1, h1, (cplx){acc[1][i], acc[3][i]});
                            acc[0][i] = h0.re; acc[2][i] = h0.im; acc[1][i] = h1.re; acc[3][i] = h1.im; } }
          else { _Pragma("unroll") for (int i = 15; i >= 0; --i) { h0 = cfma(a0, h0, (cplx){acc[0][i], acc[2][i]}); h1 = cfma(a1, h1, (cplx){acc[1][i], acc[3][i]});
                            acc[0][i] = h0.re; acc[2][i] = h0.im; acc[1][i] = h1.re; acc[3][i] = h1.im; } }
        }
        if (!sample && t2 == 1 && ((dir == 0 && c == nc - 1) || (dir == 1 && c == 0)) && H != firstH) {
          float* so = p.out + OUT_S5 + ((size_t)((bq * 2 + slot) * 2 + dir) * 2) * 4096 + g * 64;
          so[r] = h0.re; so[4096 + r] = h0.im; so[r + 32] = h1.re; so[4096 + r + 32] = h1.im;
        }
        c0 = shfl_c(h0, r + 32 * (1 - firstH)); c1 = shfl_c(h1, r + 32 * (1 - firstH));
        _Pragma("unroll") for (int i = 0; i < 16; ++i) {
          uint2 pk; pk.x = cvt_pk_bf16(acc[0][i], acc[2][i]); pk.y = cvt_pk_bf16(acc[1][i], acc[3][i]);
          *(uint2*)(ldsw + (16 * H + i) * 272 + 8 * r) = pk;
        }
        asm volatile("s_waitcnt lgkmcnt(0)" ::: "memory");
        _Pragma("unroll") for (int rt = 0; rt < 2; ++rt) _Pragma("unroll") for (int ks = 0; ks < 4; ++ks) {
          const bf16x8 af = *(const bf16x8*)(ldsw + (16 * rt + (lane & 15)) * 272 + (32 * ks + 8 * (lane >> 4)) * 2);
          yacc[tt][rt] = __builtin_amdgcn_mfma_f32_16x16x32_bf16(af, cfr[ks], yacc[tt][rt], 0, 0, 0);
        }
        asm volatile("s_waitcnt lgkmcnt(0)" ::: "memory");
      }
    }
    asm volatile("s_nop 15" : "+v"(yacc[0][0]), "+v"(yacc[0][1]), "+v"(yacc[1][0]), "+v"(yacc[1][1]));
    const int ch = lane & 15, col = g * 16 + ch;
    const float dsk = Dsk[col];
    _Pragma("unroll") for (int tt = 0; tt < 2; ++tt) _Pragma("unroll") for (int rt = 0; rt < 2; ++rt) _Pragma("unroll") for (int j = 0; j < 4; ++j) {
      const int token = tok0 + 32 * tt + 16 * rt + 4 * (lane >> 4) + j;
      bf16_t* hp = HB + (size_t)token * D + col;
      const float u = bf2f(*hp);
      const float y = yacc[tt][rt][j] + u * dsk;
      const float z = 0.7978845608028654f * (y + 0.044715f * y * y * y);
      const float th = 1.f - 2.f / (__expf(2.f * z) + 1.f);
      *hp = f2bf(0.5f * y * (1.f + th));
    }
  }
}

constexpr float LOG2E = 1.4426950408889634f;

__device__ void phase_post_na(const Params& p) {
  const int tid_ = opaque_tid(); const int lane = tid_ & 63, wave = tid_ >> 6;
  bf16_t* QK = (bf16_t*)(p.ws + WS_QK);
  const float* qn = p.in[25]; const float* kn = p.in[26];
  const float qs = 0.125f * LOG2E;
  const int d0 = (lane & 3) * 16;
  for (int row = blockIdx.x * 8 + wave; row < NTOK; row += gridDim.x * 8) {
    _Pragma("unroll") for (int part = 0; part < 2; ++part) {
      bf16_t* ptr = QK + (size_t)row * 2048 + part * 1024 + lane * 16;
      uint4 a = *(uint4*)ptr, b = *(uint4*)(ptr + 8);
      unsigned w[8] = {a.x, a.y, a.z, a.w, b.x, b.y, b.z, b.w};
      float v[16]; float ss = 0.f;
      _Pragma("unroll") for (int i = 0; i < 8; ++i) { v[2 * i] = bflo(w[i]); v[2 * i + 1] = bfhi(w[i]); }
      _Pragma("unroll") for (int i = 0; i < 16; ++i) ss += v[i] * v[i];
      ss += __shfl_xor(ss, 1); ss += __shfl_xor(ss, 2);
      const float rstd = rsqrtf(ss * (1.f / 64.f) + 1e-6f);
      const float* nw = part ? kn : qn;
      const float sc = part ? 1.f : qs;
      float o[16];
      _Pragma("unroll") for (int i = 0; i < 16; ++i) o[i] = v[i] * rstd * nw[d0 + i];
      if (part == 1 && row < 4096) {
        float* op = p.out + OUT_NAK + (size_t)row * 1024 + lane * 16;
        _Pragma("unroll") for (int i = 0; i < 4; ++i) *(f32x4*)(op + 4 * i) = (f32x4){o[4 * i], o[4 * i + 1], o[4 * i + 2], o[4 * i + 3]};
      }
      _Pragma("unroll") for (int i = 0; i < 8; ++i) w[i] = cvt_pk_bf16(o[2 * i] * sc, o[2 * i + 1] * sc);
      *(uint4*)ptr = make_uint4(w[0], w[1], w[2], w[3]); *(uint4*)(ptr + 8) = make_uint4(w[4], w[5], w[6], w[7]);
    }
  }
}

__device__ void phase_post_gqa(const Params& p) {
  const int tid_ = opaque_tid(); const int lane = tid_ & 63, wave = tid_ >> 6;
  bf16_t* QK = (bf16_t*)(p.ws + WS_QK);
  const float* qn = p.in[30]; const float* kn = p.in[31];
  const float qs = 0.08838834764831845f * LOG2E;
  for (int row = blockIdx.x * 8 + wave; row < NTOK; row += gridDim.x * 8) {
    const bool sample = row >= 4096;
    const int t = (row - 4096) & 1023;
    const float prow = (float)(t >> 6), pcol = (float)(t & 63);
    {
      const int i0 = (lane & 7) * 8;
      bf16_t* ptr = QK + (size_t)row * 1280 + (lane >> 3) * 128 + i0;
      uint4 a = *(uint4*)ptr, b = *(uint4*)(ptr + 64);
      unsigned wa[4] = {a.x, a.y, a.z, a.w}, wb[4] = {b.x, b.y, b.z, b.w};
      float x1[8], x2[8]; float ss = 0.f;
      _Pragma("unroll") for (int i = 0; i < 4; ++i) { x1[2 * i] = bflo(wa[i]); x1[2 * i + 1] = bfhi(wa[i]); x2[2 * i] = bflo(wb[i]); x2[2 * i + 1] = bfhi(wb[i]); }
      _Pragma("unroll") for (int i = 0; i < 8; ++i) ss += x1[i] * x1[i] + x2[i] * x2[i];
      ss += __shfl_xor(ss, 1); ss += __shfl_xor(ss, 2); ss += __shfl_xor(ss, 4);
      const float rstd = rsqrtf(ss * (1.f / 128.f) + 1e-6f);
      _Pragma("unroll") for (int i = 0; i < 8; ++i) { x1[i] *= rstd * qn[i0 + i]; x2[i] *= rstd * qn[64 + i0 + i]; }
      if (sample) {
        _Pragma("unroll") for (int i = 0; i < 8; ++i) {
          const int pi = i0 + i;
          const float inv = exp2f(-(float)(pi & 31) * (13.287712379549449f / 32.f));
          const float ang = (pi < 32 ? prow : pcol) * inv;
          const float cs = cosf(ang), sn = sinf(ang);
          const float y1 = x1[i] * cs - x2[i] * sn, y2 = x1[i] * sn + x2[i] * cs;
          x1[i] = y1; x2[i] = y2;
        }
      }
      _Pragma("unroll") for (int i = 0; i < 4; ++i) { wa[i] = cvt_pk_bf16(x1[2 * i] * qs, x1[2 * i + 1] * qs); wb[i] = cvt_pk_bf16(x2[2 * i] * qs, x2[2 * i + 1] * qs); }
      *(uint4*)ptr = make_uint4(wa[0], wa[1], wa[2], wa[3]); *(uint4*)(ptr + 64) = make_uint4(wb[0], wb[1], wb[2], wb[3]);
    }
    {
      const int i0 = (lane & 31) * 2;
      bf16_t* ptr = QK + (size_t)row * 1280 + 1024 + (lane >> 5) * 128 + i0;
      unsigned wa = *(unsigned*)ptr, wb = *(unsigned*)(ptr + 64);
      float x1[2] = {bflo(wa), bfhi(wa)}, x2[2] = {bflo(wb), bfhi(wb)};
      float ss = x1[0] * x1[0] + x1[1] * x1[1] + x2[0] * x2[0] + x2[1] * x2[1];
      _Pragma("unroll") for (int o = 1; o < 32; o <<= 1) ss += __shfl_xor(ss, o);
      const float rstd = rsqrtf(ss * (1.f / 128.f) + 1e-6f);
      _Pragma("unroll") for (int i = 0; i < 2; ++i) { x1[i] *= rstd * kn[i0 + i]; x2[i] *= rstd * kn[64 + i0 + i]; }
      if (!sample) {
        float* op = p.out + OUT_GQAK + (size_t)row * 256 + (lane >> 5) * 128 + i0;
        *(float2*)op = make_float2(x1[0], x1[1]); *(float2*)(op + 64) = make_float2(x2[0], x2[1]);
      } else {
        _Pragma("unroll") for (int i = 0; i < 2; ++i) {
          const int pi = i0 + i;
          const float inv = exp2f(-(float)(pi & 31) * (13.287712379549449f / 32.f));
          const float ang = (pi < 32 ? prow : pcol) * inv;
          const float cs = cosf(ang), sn = sinf(ang);
          const float y1 = x1[i] * cs - x2[i] * sn, y2 = x1[i] * sn + x2[i] * cs;
          x1[i] = y1; x2[i] = y2;
        }
      }
      *(unsigned*)ptr = cvt_pk_bf16(x1[0], x1[1]); *(unsigned*)(ptr + 64) = cvt_pk_bf16(x2[0], x2[1]);
    }
  }
}

template <int DH, bool NAL>
__device__ __forceinline__ void attn_wave(const bf16_t* Q, int ldq,
                                          const bf16_t* K0, int ldk0, const bf16_t* V0, int ldv0, int n0,
                                          const bf16_t* K1, int ldk1, const bf16_t* V1, int ldv1, int n1,
                                          bf16_t* O, int ldo, const float* rpb_h, int rr, int rs, int qc0) {
  constexpr int KS = DH / 32, DT = DH / 16;
  const int lane = opaque_tid() & 63, fr = lane & 15, g = lane >> 4;
  bf16x8 qf[2][KS];
  _Pragma("unroll") for (int qg = 0; qg < 2; ++qg) _Pragma("unroll") for (int ks = 0; ks < KS; ++ks) qf[qg][ks] = *(const bf16x8*)(Q + (size_t)(qg * 16 + fr) * ldq + ks * 32 + 8 * g);
  f32x4 o[2][DT];
  _Pragma("unroll") for (int qg = 0; qg < 2; ++qg) _Pragma("unroll") for (int dt = 0; dt < DT; ++dt) o[qg][dt] = (f32x4){0.f, 0.f, 0.f, 0.f};
  float lsum[2] = {0.f, 0.f};
  const int krow_in = 8 * (fr >> 2) + (fr & 3);
  const int nch = (n0 + n1) >> 5;
  for (int c = 0; c < nch; ++c) {
    const bool s1 = (c * 32 >= n0);
    const int kc = s1 ? c * 32 - n0 : c * 32;
    const bf16_t* K = s1 ? K1 : K0; const int ldk = s1 ? ldk1 : ldk0;
    const bf16_t* V = s1 ? V1 : V0; const int ldv = s1 ? ldv1 : ldv0;
    bf16x8 kf[2][KS], vf[DT];
    _Pragma("unroll") for (int t = 0; t < 2; ++t) _Pragma("unroll") for (int ks = 0; ks < KS; ++ks) kf[t][ks] = *(const bf16x8*)(K + (size_t)(kc + krow_in + 4 * t) * ldk + ks * 32 + 8 * g);
    _Pragma("unroll") for (int dt = 0; dt < DT; ++dt) vf[dt] = *(const bf16x8*)(V + (size_t)(16 * dt + fr) * ldv + kc + 8 * g);
    f32x4 s[2][2];
    _Pragma("unroll") for (int qg = 0; qg < 2; ++qg) _Pragma("unroll") for (int t = 0; t < 2; ++t) {
      s[qg][t] = (f32x4){0.f, 0.f, 0.f, 0.f};
      _Pragma("unroll") for (int ks = 0; ks < KS; ++ks) s[qg][t] = __builtin_amdgcn_mfma_f32_16x16x32_bf16(kf[t][ks], qf[qg][ks], s[qg][t], 0, 0, 0);
    }
    asm volatile("s_nop 15" : "+v"(s[0][0]), "+v"(s[0][1]), "+v"(s[1][0]), "+v"(s[1][1]));
    bf16x8 pf[2];
    _Pragma("unroll") for (int qg = 0; qg < 2; ++qg) {
      float pv[8];
      _Pragma("unroll") for (int i = 0; i < 8; ++i) {
        float sv = s[qg][i >> 2][i & 3];
        if (NAL && !s1) {
          const int krow = rs + (kc >> 6), kcol = (kc & 63) + 8 * g + i;
          const int qc = qc0 + qg * 16 + fr;
          const int cs = min(max(qc - 8, 0), 48);
          const bool valid = (kcol >= cs) && (kcol < cs + 16);
          const int bi = valid ? (krow - rr + 7) * 31 + (kcol - qc + 15) : 0;
          const float bias = rpb_h[bi];
          pv[i] = valid ? __builtin_amdgcn_exp2f(sv + bias * LOG2E) : 0.f;
        } else {
          pv[i] = __builtin_amdgcn_exp2f(sv);
        }
        lsum[qg] += pv[i];
      }
      union { bf16x8 v; unsigned u[4]; } pk;
      _Pragma("unroll") for (int i = 0; i < 4; ++i) pk.u[i] = cvt_pk_bf16(pv[2 * i], pv[2 * i + 1]);
      pf[qg] = pk.v;
    }
    _Pragma("unroll") for (int qg = 0; qg < 2; ++qg) _Pragma("unroll") for (int dt = 0; dt < DT; ++dt)
      o[qg][dt] = __builtin_amdgcn_mfma_f32_16x16x32_bf16(vf[dt], pf[qg], o[qg][dt], 0, 0, 0);
  }
  _Pragma("unroll") for (int qg = 0; qg < 2; ++qg) _Pragma("unroll") for (int dt = 0; dt < DT; ++dt) asm volatile("s_nop 7" : "+v"(o[qg][dt]));
  _Pragma("unroll") for (int qg = 0; qg < 2; ++qg) {
    float l = lsum[qg];
    l += __shfl_xor(l, 16); l += __shfl_xor(l, 32);
    const float inv = 1.f / l;
    _Pragma("unroll") for (int dt = 0; dt < DT; ++dt) {
      uint2 pk; pk.x = cvt_pk_bf16(o[qg][dt][0] * inv, o[qg][dt][1] * inv); pk.y = cvt_pk_bf16(o[qg][dt][2] * inv, o[qg][dt][3] * inv);
      *(uint2*)(O + (size_t)(qg * 16 + fr) * ldo + 16 * dt + 4 * g) = pk;
    }
  }
}

__device__ void phase_attn_na(const Params& p) {
  const int wave = opaque_tid() >> 6;
  const bf16_t* QK = (const bf16_t*)(p.ws + WS_QK);
  const bf16_t* VT = (const bf16_t*)(p.ws + WS_VT);
  const bf16_t* CK = (const bf16_t*)(p.ws + WS_CKNA);
  const bf16_t* CVT = (const bf16_t*)(p.ws + WS_CVTNA);
  bf16_t* AO = (bf16_t*)(p.ws + WS_AO);
  for (int gw = blockIdx.x * 8 + wave; gw < 4096; gw += gridDim.x * 8) {
    if (gw < 2048) {
      const int wq = gw & 1, r = (gw >> 1) & 15, h = (gw >> 5) & 15, b = gw >> 9;
      const int rs = min(max(r - 4, 0), 8);
      const int tokq = 4096 + b * 1024 + r * 64 + wq * 32;
      const int tokk = 4096 + b * 1024 + rs * 64;
      attn_wave<64, true>(QK + (size_t)tokq * 2048 + h * 64, 2048,
                          QK + (size_t)tokk * 2048 + 1024 + h * 64, 2048,
                          VT + (size_t)4096 * 1024 + ((size_t)b * 1024 + h * 64) * 1024 + rs * 64, 1024, 512,
                          CK + (size_t)b * 512 * 1024 + h * 64, 1024,
                          CVT + ((size_t)b * 1024 + h * 64) * 512, 512, 512,
                          AO + (size_t)tokq * 1024 + h * 64, 1024,
                          p.in[27] + h * 15 * 31, r, rs, wq * 32);
    } else {
      const int id = gw - 2048, qb = id & 7, h = (id >> 3) & 15, b = id >> 7;
      const int tokq = b * 256 + qb * 32;
      attn_wave<64, false>(QK + (size_t)tokq * 2048 + h * 64, 2048,
                           QK + (size_t)(b * 256) * 2048 + 1024 + h * 64, 2048,
                           VT + ((size_t)b * 1024 + h * 64) * 256, 256, 256,
                           nullptr, 0, nullptr, 0, 0,
                           AO + (size_t)tokq * 1024 + h * 64, 1024, nullptr, 0, 0, 0);
    }
  }
}

__device__ void phase_attn_gqa(const Params& p) {
  const int wave = opaque_tid() >> 6;
  const bf16_t* QK = (const bf16_t*)(p.ws + WS_QK);
  const bf16_t* VT = (const bf16_t*)(p.ws + WS_VT);
  const bf16_t* CK = (const bf16_t*)(p.ws + WS_CKGQA);
  const bf16_t* CVT = (const bf16_t*)(p.ws + WS_CVTGQA);
  bf16_t* AO = (bf16_t*)(p.ws + WS_AO);
  const int nb4 = (int)gridDim.x * 4;
  if (wave < 4) {
    for (int id = blockIdx.x * 4 + wave; id < 1024; id += nb4) {
      const int qb = id & 31, hq = (id >> 5) & 7, b = id >> 8, hk = hq >> 2;
      const int tokq = 4096 + b * 1024 + qb * 32;
      attn_wave<128, false>(QK + (size_t)tokq * 1280 + hq * 128, 1280,
                            QK + (size_t)(4096 + b * 1024) * 1280 + 1024 + hk * 128, 1280,
                            VT + (size_t)4096 * 256 + ((size_t)b * 256 + hk * 128) * 1024, 1024, 1024,
                            CK + (size_t)b * 512 * 256 + hk * 128, 256,
                            CVT + ((size_t)b * 256 + hk * 128) * 512, 512, 512,
                            AO + (size_t)tokq * 1024 + hq * 128, 1024, nullptr, 0, 0, 0);
    }
  } else {
    for (int id = blockIdx.x * 4 + (wave - 4); id < 1024; id += nb4) {
      const int qb = id & 7, hq = (id >> 3) & 7, b = id >> 6, hk = hq >> 2;
      const int tokq = b * 256 + qb * 32;
      attn_wave<128, false>(QK + (size_t)tokq * 1280 + hq * 128, 1280,
                            QK + (size_t)(b * 256) * 1280 + 1024 + hk * 128, 1280,
                            VT + ((size_t)b * 256 + hk * 128) * 256, 256, 256,
                            nullptr, 0, nullptr, 0, 0,
                            AO + (size_t)tokq * 1024 + hq * 128, 1024, nullptr, 0, 0, 0);
    }
  }
}

__device__ void phase_fake_mlp1(const Params& p) {
  const int tid = opaque_tid();
  const uint4* HB = (const uint4*)(p.ws + WS_HB);
  uint4* ACT = (uint4*)(p.ws + WS_ACT);
  for (size_t i = (size_t)blockIdx.x * NT + tid; i < (size_t)NTOK * DFF / 8; i += (size_t)gridDim.x * NT) {
    const size_t row = i >> 9, c8 = i & 511;
    uint4 v = HB[row * 128 + (c8 & 127)];
    unsigned w[4] = {v.x, v.y, v.z, v.w};
    for (int j = 0; j < 4; ++j) { float a = bflo(w[j]), b = bfhi(w[j]); w[j] = cvt_pk_bf16(a * a, b * b); }
    ACT[i] = make_uint4(w[0], w[1], w[2], w[3]);
  }
}
__global__ void __launch_bounds__(NT) fwd_megakernel(Params p) {
  cg::grid_group grid = cg::this_grid();
  unsigned char* ws = p.ws;
  const float* MOD = (const float*)(ws + WS_MOD);
  bf16_t* HB = (bf16_t*)(ws + WS_HB);
  bf16_t* AO = (bf16_t*)(ws + WS_AO);
  bf16_t* QK = (bf16_t*)(ws + WS_QK);
  bf16_t* VT = (bf16_t*)(ws + WS_VT);
  bf16_t* ACT = (bf16_t*)(ws + WS_ACT);
  int ph = 0;
#ifdef CHK_INPUT
  { float* chk = (float*)(ws + WS_END);
    const int t = opaque_tid();
    const float* sp = p.in[CHK_INPUT];
    const size_t per = (size_t)CHK_COUNT / gridDim.x;
    float s = 0.f;
    for (size_t i = t; i < per; i += NT) { float v = sp[(size_t)blockIdx.x * per + i]; s += v * (1.f + (float)(i & 15)); }
    float* red = (float*)smem; red[t] = s; __syncthreads();
    if (t == 0) { float a = 0.f; for (int i = 0; i < NT; ++i) a += red[i]; chk[blockIdx.x] = a; }
    __syncthreads(); }
#endif
#ifdef START_DELAY_TICKS
  { const unsigned long long t0 = __builtin_amdgcn_s_memrealtime(); while (__builtin_amdgcn_s_memrealtime() - t0 < START_DELAY_TICKS) __builtin_amdgcn_s_sleep(8); }
#endif
  if (p.ph_hi - p.ph_lo > 1) grid.sync();
#ifndef EN_GEMM
#define EN_GEMM 15
#endif
#ifndef EN_ATTN
#define EN_ATTN 1
#endif
#ifndef EN_S5
#define EN_S5 1
#endif
#ifndef EN_MISC
#define EN_MISC 1
#endif
#define RUN(body) do { if (p.ph_lo <= ph && ph < p.ph_hi) { body; if (ph + 1 < p.ph_hi) grid.sync(); } ++ph; } while (0)

  RUN(if (EN_MISC) phase_prologue(p));
  for (int layer = 0; layer < 4; ++layer) {
    const int kind = layer % 3, slot = layer / 3;
    RUN(if (EN_MISC) phase_norm(p, layer, 0, layer == 0));
    if (kind == 0) {
      RUN(if (EN_S5) phase_s5_pass1(p, slot));
      RUN(if (EN_S5) phase_s5_pass2(p, slot));
      { GemmArgs ga{HB, D, (const bf16_t*)(ws + WS_GLUT) + (size_t)slot * 2048 * 1024, D, 32, 16, 1024, 0xffff};
        EpiGlu e{p.out, MOD + layer * 5 * 6144 + 2 * 1024, p.in[23] + slot * 2048};
        RUN(if (EN_GEMM & 1) gemm_phase<128>(ga, e)); }
    } else if (kind == 1) {
      { GemmArgs ga{HB, D, (const bf16_t*)(ws + WS_NAQKVT), D, 32, 24, 1024, 0xffff};
        EpiQkv e{QK, 2048, VT, 1024, p.out + OUT_NAV};
        RUN(if (EN_GEMM & 2) gemm_phase<128>(ga, e)); }
      RUN(if (EN_MISC) phase_post_na(p));
      RUN(if (EN_ATTN) phase_attn_na(p));
      { GemmArgs ga{AO, D, (const bf16_t*)(ws + WS_NAOT), D, 32, 8, 1024, 0xffff};
        EpiResid e{p.out, MOD + layer * 5 * 6144 + 2 * 1024};
        RUN(if (EN_GEMM & 4) gemm_phase<128>(ga, e)); }
    } else {
      { GemmArgs ga{HB, D, (const bf16_t*)(ws + WS_GQAQKVT), D, 32, 12, 1024, 0xffff};
        EpiQkv e{QK, 1280, VT, 256, p.out + OUT_GQAV};
        RUN(if (EN_GEMM & 2) gemm_phase<128>(ga, e)); }
      RUN(if (EN_MISC) phase_post_gqa(p));
      RUN(if (EN_ATTN) phase_attn_gqa(p));
      { GemmArgs ga{AO, D, (const bf16_t*)(ws + WS_GQAOT), D, 32, 8, 1024, 0xffff};
        EpiResid e{p.out, MOD + layer * 5 * 6144 + 2 * 1024};
        RUN(if (EN_GEMM & 4) gemm_phase<128>(ga, e)); }
    }
    RUN(if (EN_MISC) phase_norm(p, layer, 1, false));
    { GemmArgs ga{HB, D, (const bf16_t*)(ws + WS_W1T) + (size_t)layer * 4096 * 1024, D, 32, 32, 1024, 0xffff};
      EpiSqRelu e{ACT};
      RUN(if (EN_GEMM & 8) gemm_phase<128>(ga, e)); }
    { GemmArgs ga{ACT, DFF, (const bf16_t*)(ws + WS_W2T) + (size_t)layer * 1024 * 4096, DFF, 32, 8, 4096, 0xffff};
      EpiResid e{p.out, MOD + layer * 5 * 6144 + 5 * 1024};
      RUN(if (EN_GEMM & 4) gemm_phase<128>(ga, e)); }
  }
#ifdef FINAL_SYNC
  if (p.ph_hi - p.ph_lo > 1) { grid.sync(); { const unsigned long long t0 = __builtin_amdgcn_s_memrealtime(); while (__builtin_amdgcn_s_memrealtime() - t0 < 2000ull) __builtin_amdgcn_s_sleep(8); } grid.sync(); }
#endif
#ifdef DUMP_S5P
  if (p.ph_hi - p.ph_lo > 1) {
    grid.sync();
    const float* sa = (const float*)(ws + WS_S5A);
    const unsigned* sb = (const unsigned*)(ws + WS_S5BB);
    const unsigned* sc = (const unsigned*)(ws + WS_S5CM);
    for (size_t i = (size_t)blockIdx.x * NT + opaque_tid(); i < 524288; i += (size_t)gridDim.x * NT) {
      if (i < 32768) p.out[i] = sa[i];
      unsigned w = sb[i]; p.out[65536 + 2 * i] = bflo(w); p.out[65536 + 2 * i + 1] = bfhi(w);
      unsigned w2 = sc[i]; p.out[2097152 + 2 * i] = bflo(w2); p.out[2097152 + 2 * i + 1] = bfhi(w2);
    }
  }
#endif
#ifdef DUMP_E
  if (p.ph_hi - p.ph_lo > 1) {
    grid.sync();
    const float* sp = (const float*)(ws + WS_S5E);
    for (size_t i = (size_t)blockIdx.x * NT + opaque_tid(); i < 2097152; i += (size_t)gridDim.x * NT) p.out[i] = sp[i];
  }
#endif
#ifdef DUMP_HB
  if (p.ph_hi - p.ph_lo > 1) {
    grid.sync();
    const unsigned* sp = (const unsigned*)(ws + WS_HB);
    for (size_t i = (size_t)blockIdx.x * NT + opaque_tid(); i < 4194304; i += (size_t)gridDim.x * NT) {
      unsigned w = sp[i]; p.out[2 * i] = bflo(w); p.out[2 * i + 1] = bfhi(w);
    }
  }
#endif
#ifdef DUMP_W2T
  if (p.ph_lo == 100) {
    const unsigned* sp = (const unsigned*)(ws + WS_W2T);
    for (size_t i = (size_t)blockIdx.x * NT + opaque_tid(); i < 19398656 / 2; i += (size_t)gridDim.x * NT) {
      float a = 0.f, b = 0.f;
      if (i < 2097152) { unsigned w = sp[i]; a = bflo(w); b = bfhi(w); }
      p.out[2 * i] = a; p.out[2 * i + 1] = b;
    }
  }
#endif
#undef RUN
#ifdef CHK_W2T
  grid.sync();
  { float* chk = (float*)(ws + WS_END);
    const int t = opaque_tid();
    const unsigned* sp = (const unsigned*)(ws + WS_W2T);
    const size_t per = (size_t)(33554432 / 4) / gridDim.x;
    float s = 0.f;
    for (size_t i = t; i < per; i += NT) { unsigned w = sp[(size_t)blockIdx.x * per + i]; s += (bflo(w) + 2.f * bfhi(w)) * (1.f + (float)(i & 15)); }
    float* red = (float*)smem; red[t] = s; __syncthreads();
    if (t == 0) { float a = 0.f; for (int i = 0; i < NT; ++i) a += red[i]; chk[blockIdx.x] = a; }
    __syncthreads(); }
  grid.sync();
  { const float* chk = (const float*)(ws + WS_END);
    for (size_t i = (size_t)blockIdx.x * NT + opaque_tid(); i < 19398656; i += (size_t)gridDim.x * NT) p.out[i] = chk[(i >> 10) & 255]; }
#endif
#ifdef CHK_INPUT
  grid.sync();
  { const float* chk = (const float*)(ws + WS_END);
    for (size_t i = (size_t)blockIdx.x * NT + opaque_tid(); i < 19398656; i += (size_t)gridDim.x * NT) p.out[i] = chk[(i >> 10) & 255]; }
#endif
}

extern "C" void kernel_launch(void* const* d_in, const int* in_sizes, int n_in, void* d_out, int out_size, void* d_ws, size_t ws_size, hipStream_t stream) {
  static int grid_blocks = 0;
  if (grid_blocks == 0) {
    if (n_in != 33 || ws_size < WS_END) { fprintf(stderr, "kernel_launch: unexpected n_in %d or ws_size %zu (< %zu)\n", n_in, ws_size, (size_t)WS_END); grid_blocks = -1; return; }
    int dev = 0, cus = 0, per_cu = 0;
    (void)hipGetDevice(&dev);
    (void)hipDeviceGetAttribute(&cus, hipDeviceAttributeMultiprocessorCount, dev);
    if (hipFuncSetAttribute((const void*)fwd_megakernel, hipFuncAttributeMaxDynamicSharedMemorySize, LDS_BYTES) != hipSuccess) { fprintf(stderr, "hipFuncSetAttribute failed\n"); grid_blocks = -1; return; }
    if (hipOccupancyMaxActiveBlocksPerMultiprocessor(&per_cu, (const void*)fwd_megakernel, NT, LDS_BYTES) != hipSuccess || per_cu < 1) { fprintf(stderr, "occupancy query failed (%d)\n", per_cu); (void)hipGetLastError(); per_cu = 1; }
    grid_blocks = cus * 1;
    fprintf(stderr, "kernel_launch: cus %d per_cu %d grid %d\n", cus, per_cu, grid_blocks);
  }
  if (grid_blocks < 0) return;
  Params p{};
  for (int i = 0; i < 33; ++i) p.in[i] = (const float*)d_in[i];
  p.out = (float*)d_out; p.ws = (unsigned char*)d_ws;
#if N_LAUNCH_MODE == 1
  #ifndef PH_HI
#define PH_HI NPHASE
#endif
  p.ph_lo = 0; p.ph_hi = PH_HI;
  void* args[] = {&p};
  hipError_t e = hipLaunchCooperativeKernel((void*)fwd_megakernel, dim3(grid_blocks), dim3(NT), args, LDS_BYTES, stream);
  if (e != hipSuccess) fprintf(stderr, "cooperative launch failed: %s (grid %d)\n", hipGetErrorString(e), grid_blocks);
#else
#ifndef PH_HI
#define PH_HI NPHASE
#endif
  for (int ph = 0; ph < PH_HI; ++ph) {
    p.ph_lo = ph; p.ph_hi = ph + 1;
    hipLaunchKernelGGL(fwd_megakernel, dim3(grid_blocks), dim3(NT), LDS_BYTES, stream, p);
  }
#ifdef DUMP_W2T
  p.ph_lo = 100; p.ph_hi = 101;
  hipLaunchKernelGGL(fwd_megakernel, dim3(grid_blocks), dim3(NT), LDS_BYTES, stream, p);
#endif
#endif
}
```

```cpp
#include <hip/hip_runtime.h>
#include <hip/hip_bf16.h>
#include <hip/hip_cooperative_groups.h>
#include <cstdio>
namespace cg = cooperative_groups;

typedef unsigned short bf16_t;
using bf16 = __hip_bfloat16;
using bf16x8 = __attribute__((ext_vector_type(8))) short;
using f32x4 = __attribute__((ext_vector_type(4))) float;
using f32x16 = __attribute__((ext_vector_type(16))) float;

#define B_AUX 0
#ifndef USE_GLDS
#define USE_GLDS 1
#endif
#ifndef N_LAUNCH_MODE
#define N_LAUNCH_MODE 1
#endif

constexpr int NT = 512;
constexpr int D = 1024, NTOK = 8192, DFF = 4096;
constexpr int LDS_BYTES = 131072 + 64;
constexpr int NPHASE = 31;

constexpr size_t WS_W1T = 0;
constexpr size_t WS_W2T = WS_W1T + 33554432;
constexpr size_t WS_GLUT = WS_W2T + 33554432;
constexpr size_t WS_NAQKVT = WS_GLUT + 8388608;
constexpr size_t WS_NAOT = WS_NAQKVT + 6291456;
constexpr size_t WS_GQAQKVT = WS_NAOT + 2097152;
constexpr size_t WS_GQAOT = WS_GQAQKVT + 3145728;
constexpr size_t WS_MOD = WS_GQAOT + 2097152;
constexpr size_t WS_S5A = WS_MOD + 491520;
constexpr size_t WS_S5BB = WS_S5A + 131072;
constexpr size_t WS_S5CM = WS_S5BB + 1048576;
constexpr size_t WS_S5E = WS_S5CM + 1048576;
constexpr size_t WS_CKNA = WS_S5E + 8388608;
constexpr size_t WS_CVTNA = WS_CKNA + 4194304;
constexpr size_t WS_CKGQA = WS_CVTNA + 4194304;
constexpr size_t WS_CVTGQA = WS_CKGQA + 1048576;
constexpr size_t WS_HB = WS_CVTGQA + 1048576;
constexpr size_t WS_AO = WS_HB + 16777216;
constexpr size_t WS_QK = WS_AO + 16777216;
constexpr size_t WS_VT = WS_QK + 33554432;
constexpr size_t WS_ACT = WS_VT + 16777216;
constexpr size_t WS_BAR = WS_ACT + 67108864;
constexpr size_t WS_END = WS_BAR + 16384;

constexpr size_t OUT_YS = 4194304, OUT_S5 = 8388608, OUT_NAK = 8912896, OUT_NAV = 13107200, OUT_GQAK = 17301504, OUT_GQAV = 18350080;

struct Params {
  const float* in[33];
  float* out;
  unsigned char* ws;
  int ph_lo, ph_hi;
};

extern __shared__ __attribute__((aligned(16))) unsigned char smem[];

__device__ __forceinline__ unsigned cvt_pk_bf16(float lo, float hi) {
  unsigned r; asm("v_cvt_pk_bf16_f32 %0, %1, %2" : "=v"(r) : "v"(lo), "v"(hi)); return r;
}
__device__ __forceinline__ bf16_t f2bf(float f) { return (bf16_t)(cvt_pk_bf16(f, 0.f) & 0xffffu); }
__device__ __forceinline__ float bf2f(bf16_t b) { return __uint_as_float(((unsigned)b) << 16); }
__device__ __forceinline__ float bflo(unsigned u) { return __uint_as_float(u << 16); }
__device__ __forceinline__ float bfhi(unsigned u) { return __uint_as_float(u & 0xffff0000u); }
__device__ __forceinline__ int cond_of_row(int row) { return row < 4096 ? 0 : 1 + ((row - 4096) >> 10); }

__device__ __forceinline__ int opaque_tid() { int t = threadIdx.x; asm volatile("" : "+v"(t)); return t; }
#define MFMA_SETTLE() asm volatile("s_nop 15\n\ts_nop 15" ::: "memory")
__device__ __forceinline__ void bu_mfma4(f32x16& c0, f32x16& c1, f32x16& c2, f32x16& c3, bf16x8 a, bf16x8 b0, bf16x8 b1, bf16x8 b2, bf16x8 b3) {
  asm volatile("v_mfma_f32_32x32x16_bf16 %0, %4, %5, 0\n\t"
               "v_mfma_f32_32x32x16_bf16 %1, %4, %6, 0\n\t"
               "v_mfma_f32_32x32x16_bf16 %2, %4, %7, 0\n\t"
               "v_mfma_f32_32x32x16_bf16 %3, %4, %8, 0\n\t"
               "s_nop 15\n\ts_nop 15"
               : "=&v"(c0), "=&v"(c1), "=&v"(c2), "=&v"(c3) : "v"(a), "v"(b0), "v"(b1), "v"(b2), "v"(b3));
}
struct cplx { float re, im; };
__device__ __forceinline__ cplx cmul(cplx a, cplx b) { return {a.re * b.re - a.im * b.im, a.re * b.im + a.im * b.re}; }
__device__ __forceinline__ cplx cfma(cplx a, cplx h, cplx b) {
  cplx r; r.re = fmaf(a.re, h.re, fmaf(-a.im, h.im, b.re)); r.im = fmaf(a.re, h.im, fmaf(a.im, h.re, b.im)); return r;
}

constexpr int BM = 256, BK = 64, NXCD = 8, WGM = 8;

__device__ __forceinline__ int lds_byte(int r, int c) {
  int st = (r >> 4) * 2 + (c >> 5), ob = (r & 15) * 64 + (c & 31) * 2;
  return st * 1024 + (ob ^ (((ob >> 9) & 1) << 5));
}
__device__ __forceinline__ void stage_rc(int b, int& R, int& C) {
  int st = b >> 10, sb = b & 1023, swz = sb ^ (((sb >> 9) & 1) << 5);
  R = (st / 2) * 16 + swz / 64; C = (st % 2) * 32 + (swz % 64) / 2;
}

struct GemmArgs { const bf16_t* A; int lda; const bf16_t* Bt; int ldb; int nM, nN, K; int kmask; };

template <int BN, class Epi>
__device__ __forceinline__ void gemm_phase(const GemmArgs ga, const Epi epi) {
  constexpr int TILE_A = BM * BK * 2, TILE_B = BN * BK * 2, STAGE_B = TILE_A + TILE_B, GLA = TILE_A / 8192, GLB = TILE_B / 8192, NF = BN / 64;
  unsigned char* shm = smem;
  const int tid = opaque_tid(), wid = tid >> 6, lane = tid & 63, wr = wid >> 2, wc = wid & 3, fr = lane & 15, fq = lane >> 4;
  unsigned voA[GLA], voB[GLB];
#pragma unroll
  for (int i = 0; i < GLA; ++i) { int r_, c_; stage_rc(wid * 1024 + i * 8192 + lane * 16, r_, c_); voA[i] = (unsigned)(r_ * ga.lda + c_) * 2u; }
#pragma unroll
  for (int i = 0; i < GLB; ++i) { int r_, c_; stage_rc(wid * 1024 + i * 8192 + lane * 16, r_, c_); voB[i] = (unsigned)(r_ * ga.ldb + c_) * 2u; }
  int offA[8], offB[NF];
#pragma unroll
  for (int m = 0; m < 8; ++m) offA[m] = lds_byte(wr * 128 + m * 16 + fr, fq * 8);
#pragma unroll
  for (int n = 0; n < NF; ++n) offB[n] = TILE_A + lds_byte(wc * (BN / 4) + n * 16 + fr, fq * 8);
  const int nwg = ga.nM * ga.nN, nt = ga.K / BK;
  for (int u = blockIdx.x; u < nwg; u += gridDim.x) {
    int wgid = u;
    { int q = nwg / NXCD, r = nwg % NXCD, xcd = wgid % NXCD, off = wgid / NXCD;
      wgid = (xcd < r ? xcd * (q + 1) : r * (q + 1) + (xcd - r) * q) + off; }
    constexpr int WG_ = (BN == 128) ? 4 : WGM;
    const int nig = WG_ * ga.nN, gid = wgid / nig, fm = gid * WG_, gsz = min(ga.nM - fm, WG_);
    const int pm = fm + ((wgid % nig) % gsz), pn = (wgid % nig) / gsz, brow = pm * BM, bcol = pn * BN;
    const bf16_t* Ab = ga.A + (long)brow * ga.lda;
    const bf16_t* Bb = ga.Bt + (long)bcol * ga.ldb;
#define GLDS_STAGE(buf, kt) do { \
    _Pragma("unroll") for (int i = 0; i < GLA; ++i) \
      __builtin_amdgcn_global_load_lds((const unsigned*)((const char*)(Ab + ((kt) & ga.kmask) * BK) + voA[i]), \
        (__attribute__((address_space(3))) unsigned*)(shm + (buf) * STAGE_B + wid * 1024 + i * 8192), 16, 0, 0); \
    _Pragma("unroll") for (int i = 0; i < GLB; ++i) \
      __builtin_amdgcn_global_load_lds((const unsigned*)((const char*)(Bb + ((kt) & ga.kmask) * BK) + voB[i]), \
        (__attribute__((address_space(3))) unsigned*)(shm + (buf) * STAGE_B + TILE_A + wid * 1024 + i * 8192), 16, 0, B_AUX); } while (0)
    f32x4 acc[8][NF];
#pragma unroll
    for (int m = 0; m < 8; ++m)
#pragma unroll
      for (int n = 0; n < NF; ++n) acc[m][n] = (f32x4){0.f, 0.f, 0.f, 0.f};
#define LOADF(A_, B_, ks_) do { \
      _Pragma("unroll") for (int m = 0; m < 8; ++m) A_[m] = *(const bf16x8*)(sb + offA[m] + (ks_) * 1024); \
      _Pragma("unroll") for (int n = 0; n < NF; ++n) B_[n] = *(const bf16x8*)(sb + offB[n] + (ks_) * 1024); } while (0)
#define MMAS(A_, B_) do { \
      _Pragma("unroll") for (int m = 0; m < 8; ++m) \
        _Pragma("unroll") for (int n = 0; n < NF; ++n) acc[m][n] = __builtin_amdgcn_mfma_f32_16x16x32_bf16(B_[n], A_[m], acc[m][n], 0, 0, 0); } while (0)
#define COMPUTE(cur_) do { const unsigned char* sb = shm + (cur_) * STAGE_B; \
      if constexpr (NF == 2) { \
        bf16x8 A0[8], B0[NF], A1[8], B1[NF]; \
        LOADF(A0, B0, 0); LOADF(A1, B1, 1); \
        __builtin_amdgcn_sched_barrier(0); \
        MMAS(A0, B0); MMAS(A1, B1); \
        __builtin_amdgcn_sched_barrier(0); \
      } else { \
        bf16x8 A0[8], B0[NF]; \
        LOADF(A0, B0, 0); __builtin_amdgcn_sched_barrier(0); MMAS(A0, B0); __builtin_amdgcn_sched_barrier(0); \
        LOADF(A0, B0, 1); __builtin_amdgcn_sched_barrier(0); MMAS(A0, B0); __builtin_amdgcn_sched_barrier(0); \
      } } while (0)
#if USE_GLDS
    GLDS_STAGE(0, 0);
    asm volatile("s_waitcnt vmcnt(0)" ::: "memory"); __syncthreads();
    for (int t = 0; t < nt; ++t) {
      const int cur = t & 1;
      if (t + 1 < nt) GLDS_STAGE(cur ^ 1, t + 1);
      COMPUTE(cur);
      asm volatile("s_waitcnt vmcnt(0)" ::: "memory"); __syncthreads();
    }
#else
    uint4 sa0, sa1, sa2, sa3, sb0, sb1, sb2, sb3;
    static_assert(GLA == 4 && (GLB == 2 || GLB == 4), "staging shape");
#define GSRC_A(kt, i) (*(const uint4*)((const char*)(Ab + ((kt) & ga.kmask) * BK) + voA[i]))
#define GSRC_B(kt, i) (*(const uint4*)((const char*)(Bb + ((kt) & ga.kmask) * BK) + voB[i]))
#define LDST_A(buf, i) (*(uint4*)(shm + (buf) * STAGE_B + wid * 1024 + (i) * 8192 + lane * 16))
#define LDST_B(buf, i) (*(uint4*)(shm + (buf) * STAGE_B + TILE_A + wid * 1024 + (i) * 8192 + lane * 16))
#define REG_ISSUE(kt) do { sa0 = GSRC_A(kt, 0); sa1 = GSRC_A(kt, 1); sa2 = GSRC_A(kt, 2); sa3 = GSRC_A(kt, 3); \
      sb0 = GSRC_B(kt, 0); sb1 = GSRC_B(kt, 1); if constexpr (GLB == 4) { sb2 = GSRC_B(kt, 2); sb3 = GSRC_B(kt, 3); } } while (0)
#define REG_WRITE(buf) do { LDST_A(buf, 0) = sa0; LDST_A(buf, 1) = sa1; LDST_A(buf, 2) = sa2; LDST_A(buf, 3) = sa3; \
      LDST_B(buf, 0) = sb0; LDST_B(buf, 1) = sb1; if constexpr (GLB == 4) { LDST_B(buf, 2) = sb2; LDST_B(buf, 3) = sb3; } } while (0)
    REG_ISSUE(0); REG_WRITE(0); REG_ISSUE(1); __syncthreads();
    for (int t = 0; t < nt; ++t) {
      const int cur = t & 1;
      if (t + 1 < nt) REG_WRITE(cur ^ 1);
      if (t + 2 < nt) REG_ISSUE(t + 2);
      COMPUTE(cur);
      __syncthreads();
    }
#undef REG_ISSUE
#undef REG_WRITE
#endif
#undef COMPUTE
#undef LOADF
#undef MMAS
#undef GLDS_STAGE
    epi(acc, brow + wr * 128 + fr, bcol + wc * (BN / 4) + fq * 4);
  }
  __syncthreads();
}

struct EpiSqRelu {
  bf16_t* O;
  template <int NF> __device__ __forceinline__ void operator()(const f32x4 (&acc)[8][NF], int row0, int col0) const {
#pragma unroll
    for (int m = 0; m < 8; ++m)
#pragma unroll
      for (int n = 0; n < NF; ++n) {
        f32x4 v = acc[m][n];
        float a0 = fmaxf(v[0], 0.f), a1 = fmaxf(v[1], 0.f), a2 = fmaxf(v[2], 0.f), a3 = fmaxf(v[3], 0.f);
        uint2 pk; pk.x = cvt_pk_bf16(a0 * a0, a1 * a1); pk.y = cvt_pk_bf16(a2 * a2, a3 * a3);
        *(uint2*)(O + (size_t)(row0 + 16 * m) * DFF + col0 + 16 * n) = pk;
      }
  }
};
struct EpiResid {
  float* X; const float* gate;
  template <int NF> __device__ __forceinline__ void operator()(const f32x4 (&acc)[8][NF], int row0, int col0) const {
    const float* gp = gate + cond_of_row(row0) * 6144;
#pragma unroll
    for (int n = 0; n < NF; ++n) {
      const f32x4 gv = *(const f32x4*)(gp + col0 + 16 * n);
#pragma unroll
      for (int m = 0; m < 8; ++m) {
        float* xp = X + (size_t)(row0 + 16 * m) * D + col0 + 16 * n;
        f32x4 o = *(f32x4*)xp; o += acc[m][n] * gv; *(f32x4*)xp = o;
      }
    }
  }
};
struct EpiGlu {
  float* X; const float* gate; const float* bias;
  template <int NF> __device__ __forceinline__ void operator()(const f32x4 (&acc)[8][NF], int row0, int col0) const {
    const float* gp = gate + cond_of_row(row0) * 6144;
    const int col = (col0 >> 7) * 64 + ((col0 >> 5) & 3) * 16 + (col0 & 15);
    const f32x4 gv = *(const f32x4*)(gp + col);
    const f32x4 ba = *(const f32x4*)(bias + col), bg = *(const f32x4*)(bias + 1024 + col);
#pragma unroll
    for (int m = 0; m < 8; ++m) {
      float* xp = X + (size_t)(row0 + 16 * m) * D + col;
      f32x4 a = acc[m][0] + ba, g = acc[m][1] + bg;
      f32x4 o = *(f32x4*)xp;
#pragma unroll
      for (int i = 0; i < 4; ++i) { float s = 1.f / (1.f + __expf(-g[i])); o[i] += gv[i] * a[i] * s; }
      *(f32x4*)xp = o;
    }
  }
};
struct EpiQkv {
  bf16_t* QK; int nqk; bf16_t* VT; int C; float* newv;
  template <int NF> __device__ __forceinline__ void operator()(const f32x4 (&acc)[8][NF], int row0, int col0) const {
    if (col0 < nqk) {
#pragma unroll
      for (int m = 0; m < 8; ++m)
#pragma unroll
        for (int n = 0; n < NF; ++n) {
          f32x4 v = acc[m][n];
          uint2 pk; pk.x = cvt_pk_bf16(v[0], v[1]); pk.y = cvt_pk_bf16(v[2], v[3]);
          *(uint2*)(QK + (size_t)(row0 + 16 * m) * nqk + col0 + 16 * n) = pk;
        }
    } else {
      const int vc0 = col0 - nqk;
#pragma unroll
      for (int m = 0; m < 8; ++m) {
        const int row = row0 + 16 * m;
        size_t vbase; int ldv;
        if (row < 4096) { vbase = (size_t)(row >> 8) * C * 256 + (row & 255); ldv = 256; }
        else { const int r2 = row - 4096; vbase = (size_t)4096 * C + (size_t)(r2 >> 10) * C * 1024 + (r2 & 1023); ldv = 1024; }
#pragma unroll
        for (int n = 0; n < NF; ++n) {
          const int col = vc0 + 16 * n;
          f32x4 v = acc[m][n];
#pragma unroll
          for (int i = 0; i < 4; ++i) VT[vbase + (size_t)(col + i) * ldv] = f2bf(v[i]);
          if (row < 4096) *(f32x4*)(newv + (size_t)row * C + col) = v;
        }
      }
    }
  }
};

__device__ void conv_job(const Params& p, int job, const float*& src, bf16_t*& dst, int& K, int& N, int& perm) {
  unsigned char* ws = p.ws; perm = 0;
  if (job < 4) { src = p.in[12] + (size_t)job * 1024 * 4096; dst = (bf16_t*)(ws + WS_W1T) + (size_t)job * 4096 * 1024; K = 1024; N = 4096; }
  else if (job < 8) { int l = job - 4; src = p.in[13] + (size_t)l * 4096 * 1024; dst = (bf16_t*)(ws + WS_W2T) + (size_t)l * 1024 * 4096; K = 4096; N = 1024; }
  else if (job < 10) { int s = job - 8; src = p.in[22] + (size_t)s * 1024 * 2048; dst = (bf16_t*)(ws + WS_GLUT) + (size_t)s * 2048 * 1024; K = 1024; N = 2048; perm = 1; }
  else if (job == 10) { src = p.in[24]; dst = (bf16_t*)(ws + WS_NAQKVT); K = 1024; N = 3072; }
  else if (job == 11) { src = p.in[28]; dst = (bf16_t*)(ws + WS_NAOT); K = 1024; N = 1024; }
  else if (job == 12) { src = p.in[29]; dst = (bf16_t*)(ws + WS_GQAQKVT); K = 1024; N = 1536; }
  else if (job == 13) { src = p.in[32]; dst = (bf16_t*)(ws + WS_GQAOT); K = 1024; N = 1024; }
  else if (job < 18) { int b = job - 14; src = p.in[4] + (size_t)b * 512 * 1024; dst = (bf16_t*)(ws + WS_CVTNA) + (size_t)b * 1024 * 512; K = 512; N = 1024; }
  else { int b = job - 18; src = p.in[6] + (size_t)b * 512 * 256; dst = (bf16_t*)(ws + WS_CVTGQA) + (size_t)b * 256 * 512; K = 512; N = 256; }
}

__device__ void do_transposes(const Params& p, int job_lo, int job_hi);
__device__ void phase_prologue(const Params& p) {
  const int tid = opaque_tid(), G = gridDim.x;
  unsigned char* ws = p.ws;
  float* MOD = (float*)(ws + WS_MOD);
  {
    float* sl = (float*)smem;
    float* red = (float*)smem + 5 * 1024;
    bool have = false;
    for (int it = blockIdx.x; it < 192; it += G) {
      if (!have) {
        for (int i = tid; i < 5 * 1024; i += NT) {
          int c = i >> 10, k = i & 1023;
          float v = (c == 0) ? p.in[8][k] : p.in[7][(c - 1) * 1024 + k];
          sl[i] = v / (1.f + __expf(-v));
        }
        have = true;
      }
      __syncthreads();
      const int layer = it / 48, col0 = (it % 48) * 128;
      const int cg4 = tid & 31, ksl = tid >> 5;
      const float* wp = p.in[10] + (size_t)layer * 1024 * 6144 + col0 + cg4 * 4;
      f32x4 a[5];
      for (int c = 0; c < 5; ++c) a[c] = (f32x4){0.f, 0.f, 0.f, 0.f};
#pragma unroll 8
      for (int kk = 0; kk < 64; ++kk) {
        const int k = ksl * 64 + kk;
        const f32x4 w = *(const f32x4*)(wp + (size_t)k * 6144);
        for (int c = 0; c < 5; ++c) a[c] += w * sl[c * 1024 + k];
      }
      for (int c = 0; c < 5; ++c) *(f32x4*)(red + (ksl * 5 + c) * 128 + cg4 * 4) = a[c];
      __syncthreads();
      for (int o = tid; o < 640; o += NT) {
        const int c = o >> 7, col = o & 127;
        float s = p.in[11][layer * 6144 + col0 + col];
        for (int k2 = 0; k2 < 16; ++k2) s += red[(k2 * 5 + c) * 128 + col];
        MOD[(layer * 5 + c) * 6144 + col0 + col] = s;
      }
      __syncthreads();
    }
    __syncthreads();
  }
  {
    float* S5A = (float*)(ws + WS_S5A);
    bf16_t* BB = (bf16_t*)(ws + WS_S5BB);
    bf16_t* CM = (bf16_t*)(ws + WS_S5CM);
    for (int it = (blockIdx.x + 64) % G; it < 256; it += G) {
      const int sdg = it;
      const int g = it & 63;
      const float dt = expf(p.in[16][sdg]);
      for (int idx = tid; idx < 1024; idx += NT) {
        const int pp = idx >> 4, ch = idx & 15;
        const float lr = p.in[14][sdg * 64 + pp], li = p.in[15][sdg * 64 + pp];
        const float ar = lr * dt, ai = li * dt;
        const float mag = expf(ar), cs = cosf(ai), sn = sinf(ai), sh = sinf(0.5f * ai);
        const float abr = mag * cs, abi = mag * sn;
        const float nr = expm1f(ar) * cs - 2.f * sh * sh, ni = abi;
        const float den = lr * lr + li * li;
        const float fre = (nr * lr + ni * li) / den, fim = (ni * lr - nr * li) / den;
        const float br = p.in[17][(sdg * 64 + pp) * 16 + ch], bi = p.in[18][(sdg * 64 + pp) * 16 + ch];
        const float bbr = fre * br - fim * bi, bbi = fre * bi + fim * br;
        BB[((size_t)sdg * 128 + pp) * 16 + ch] = f2bf(bbr);
        BB[((size_t)sdg * 128 + 64 + pp) * 16 + ch] = f2bf(bbi);
        const float cr = p.in[19][(sdg * 16 + ch) * 64 + pp], ci = p.in[20][(sdg * 16 + ch) * 64 + pp];
        const int q = pp & 31, s2 = (pp >> 5) * 2;
        CM[((size_t)sdg * 16 + ch) * 128 + 4 * q + s2] = f2bf(cr);
        CM[((size_t)sdg * 16 + ch) * 128 + 4 * q + s2 + 1] = f2bf(-ci);
        if (ch == 0) { S5A[(sdg * 64 + pp) * 2] = abr; S5A[(sdg * 64 + pp) * 2 + 1] = abi; }
      }
      (void)g;
    }
  }
  {
    const size_t n1 = 4 * 512 * 1024 / 4, n2 = 4 * 512 * 256 / 4;
    uint2* d1 = (uint2*)(ws + WS_CKNA); uint2* d2 = (uint2*)(ws + WS_CKGQA);
    const f32x4* s1 = (const f32x4*)p.in[3]; const f32x4* s2 = (const f32x4*)p.in[5];
    for (size_t i = (size_t)blockIdx.x * NT + tid; i < n1 + n2; i += (size_t)G * NT) {
      f32x4 v = (i < n1) ? s1[i] : s2[i - n1];
      uint2 pk; pk.x = cvt_pk_bf16(v[0], v[1]); pk.y = cvt_pk_bf16(v[2], v[3]);
      if (i < n1) d1[i] = pk; else d2[i - n1] = pk;
    }
  }
  do_transposes(p, 0, 22);
}

__device__ void do_transposes(const Params& p, int job_lo, int job_hi) {
  const int tid = opaque_tid(), G = gridDim.x;
  {
    bf16_t* T = (bf16_t*)smem;
    int base = 0;
    for (int job = job_lo; job < job_hi; ++job) {
      const float* src; bf16_t* dst; int K, N, perm;
      conv_job(p, job, src, dst, K, N, perm);
      const int tn = N >> 8, ntile = (K >> 6) * tn;
      const int start = (int)(((long)blockIdx.x - (base % G) + G) % G);
      const int n4 = tid & 63, kr0 = tid >> 6;
      f32x4 v[8];
      if (start < ntile) {
        const int k0 = (start / tn) << 6, n0 = (start % tn) << 8;
#pragma unroll
        for (int ps = 0; ps < 8; ++ps) v[ps] = *(const f32x4*)(src + (size_t)(k0 + kr0 + 8 * ps) * N + n0 + n4 * 4);
      }
      for (int tile = start; tile < ntile; tile += G) {
        const int k0 = (tile / tn) << 6, n0 = (tile % tn) << 8;
        __syncthreads();
#pragma unroll
        for (int ps = 0; ps < 8; ++ps)
#pragma unroll
          for (int i = 0; i < 4; ++i) T[(n4 * 4 + i) * 72 + kr0 + 8 * ps] = f2bf(v[ps][i]);
        if (tile + G < ntile) {
          const int k1 = ((tile + G) / tn) << 6, n1 = ((tile + G) % tn) << 8;
#pragma unroll
          for (int ps = 0; ps < 8; ++ps) v[ps] = *(const f32x4*)(src + (size_t)(k1 + kr0 + 8 * ps) * N + n1 + n4 * 4);
        }
        __syncthreads();
#pragma unroll
        for (int q = 0; q < 4; ++q) {
          const int n = (tid >> 3) + 64 * q, kc = tid & 7;
          const uint4 o = *(const uint4*)(T + n * 72 + kc * 8);
          int dr = n0 + n;
          if (perm) { const int isg = dr >= 1024, c1 = dr & 1023; dr = (c1 >> 6) * 128 + ((c1 >> 4) & 3) * 32 + (c1 & 15) + isg * 16; }
          *(uint4*)(dst + (size_t)dr * K + k0 + kc * 8) = o;
        }
      }
      base += ntile;
    }
    __syncthreads();
  }
}

__device__ void phase_norm(const Params& p, int layer, int which, bool first) {
  const int tid_ = opaque_tid(); const int lane = tid_ & 63, wave = tid_ >> 6;
  const float* MOD = (const float*)(p.ws + WS_MOD);
  bf16_t* HB = (bf16_t*)(p.ws + WS_HB);
  const float* gw = p.in[9] + (layer * 2 + which) * 1024;
  for (int row0 = (blockIdx.x * 8 + wave) * 4; row0 < NTOK; row0 += gridDim.x * 32) {
    f32x4 v[4][4]; float ss[4];
#pragma unroll
    for (int r = 0; r < 4; ++r) {
      const int row = row0 + r;
      const float* xr = first ? (row < 4096 ? p.in[0] + (size_t)row * D : p.in[1] + (size_t)(row - 4096) * D) : p.out + (size_t)row * D;
#pragma unroll
      for (int i = 0; i < 4; ++i) v[r][i] = *(const f32x4*)(xr + i * 256 + lane * 4);
    }
#pragma unroll
    for (int r = 0; r < 4; ++r) {
      float s = 0.f;
#pragma unroll
      for (int i = 0; i < 4; ++i) s += v[r][i][0] * v[r][i][0] + v[r][i][1] * v[r][i][1] + v[r][i][2] * v[r][i][2] + v[r][i][3] * v[r][i][3];
      ss[r] = s;
    }
#pragma unroll
    for (int o = 32; o > 0; o >>= 1) {
#pragma unroll
      for (int r = 0; r < 4; ++r) ss[r] += __shfl_xor(ss[r], o);
    }
    const float* mp = MOD + (layer * 5 + cond_of_row(row0)) * 6144 + which * 3072;
#pragma unroll
    for (int i = 0; i < 4; ++i) {
      const int col = i * 256 + lane * 4;
      const f32x4 gv = *(const f32x4*)(gw + col), sh = *(const f32x4*)(mp + col), sc = *(const f32x4*)(mp + 1024 + col);
#pragma unroll
      for (int r = 0; r < 4; ++r) {
        const int row = row0 + r;
        const float rstd = rsqrtf(ss[r] * (1.f / 1024.f) + 1e-6f);
        if (first) *(f32x4*)(p.out + (size_t)row * D + col) = v[r][i];
        float o[4];
#pragma unroll
        for (int j = 0; j < 4; ++j) o[j] = v[r][i][j] * rstd * gv[j] * (1.f + sc[j]) + sh[j];
        uint2 pk; pk.x = cvt_pk_bf16(o[0], o[1]); pk.y = cvt_pk_bf16(o[2], o[3]);
        *(uint2*)(HB + (size_t)row * D + col) = pk;
      }
    }
  }
}

__device__ __forceinline__ int s5_tok(int rho) { return 16 * ((rho >> 2) & 1) + (rho & 3) + 4 * (rho >> 3); }
__device__ __forceinline__ cplx shfl_c(cplx v, int src) { cplx r; r.re = __shfl(v.re, src); r.im = __shfl(v.im, src); return r; }

__device__ void phase_s5_pass1(const Params& p, int slot) {
  const int tid_ = opaque_tid(); const int lane = tid_ & 63, wave = tid_ >> 6, r = lane & 31, H = lane >> 5;
  const bf16_t* HB = (const bf16_t*)(p.ws + WS_HB);
  const float* S5A = (const float*)(p.ws + WS_S5A);
  const bf16_t* BB = (const bf16_t*)(p.ws + WS_S5BB);
  float* E = (float*)(p.ws + WS_S5E);
  const int tokr = s5_tok(r);
  for (int it = blockIdx.x * 8 + wave; it < 128 * 64; it += gridDim.x * 8) {
    const int ck = it >> 6, g = it & 63, tok0 = ck * 64;
    bf16x8 uf[2];
    _Pragma("unroll") for (int tt = 0; tt < 2; ++tt) uf[tt] = *(const bf16x8*)(HB + (size_t)(tok0 + 32 * tt + tokr) * D + g * 16 + 8 * H);
    _Pragma("unroll") for (int dir = 0; dir < 2; ++dir) {
      const int sdg = (slot * 2 + dir) * 64 + g;
      cplx a0 = {S5A[(sdg * 64 + r) * 2], S5A[(sdg * 64 + r) * 2 + 1]};
      cplx a1 = {S5A[(sdg * 64 + r + 32) * 2], S5A[(sdg * 64 + r + 32) * 2 + 1]};
      cplx a0_16 = a0, a1_16 = a1;
      _Pragma("unroll") for (int i = 0; i < 4; ++i) { a0_16 = cmul(a0_16, a0_16); a1_16 = cmul(a1_16, a1_16); }
      const cplx a0_32 = cmul(a0_16, a0_16), a1_32 = cmul(a1_16, a1_16);
      bf16x8 bfr[4];
      _Pragma("unroll") for (int ct = 0; ct < 4; ++ct) bfr[ct] = *(const bf16x8*)(BB + ((size_t)sdg * 128 + 32 * ct + r) * 16 + 8 * H);
      cplx E0 = {0.f, 0.f}, E1 = {0.f, 0.f};
      _Pragma("unroll") for (int t2 = 0; t2 < 2; ++t2) {
        const int tt = dir ? 1 - t2 : t2;
        f32x16 acc[4];
        bu_mfma4(acc[0], acc[1], acc[2], acc[3], uf[tt], bfr[0], bfr[1], bfr[2], bfr[3]);
        cplx e0 = {0.f, 0.f}, e1 = {0.f, 0.f};
        if (dir == 0) {
          _Pragma("unroll") for (int i = 0; i < 16; ++i) { e0 = cfma(a0, e0, (cplx){acc[0][i], acc[2][i]}); e1 = cfma(a1, e1, (cplx){acc[1][i], acc[3][i]}); }
        } else {
          _Pragma("unroll") for (int i = 15; i >= 0; --i) { e0 = cfma(a0, e0, (cplx){acc[0][i], acc[2][i]}); e1 = cfma(a1, e1, (cplx){acc[1][i], acc[3][i]}); }
        }
        const cplx o0 = shfl_c(e0, lane ^ 32), o1 = shfl_c(e1, lane ^ 32);
        const cplx eL0 = H ? o0 : e0, eU0 = H ? e0 : o0, eL1 = H ? o1 : e1, eU1 = H ? e1 : o1;
        cplx t0, t1;
        if (dir == 0) { t0 = cfma(a0_16, eL0, eU0); t1 = cfma(a1_16, eL1, eU1); }
        else { t0 = cfma(a0_16, eU0, eL0); t1 = cfma(a1_16, eU1, eL1); }
        E0 = cfma(a0_32, E0, t0); E1 = cfma(a1_32, E1, t1);
      }
      const int pp = H ? r + 32 : r;
      const cplx Ev = H ? E1 : E0;
      *(float2*)(E + ((size_t)((ck * 64 + g) * 2 + dir) * 64 + pp) * 2) = make_float2(Ev.re, Ev.im);
    }
  }
}

__device__ void phase_s5_pass2(const Params& p, int slot) {
  const int tid_ = opaque_tid(); const int lane = tid_ & 63, wave = tid_ >> 6, r = lane & 31, H = lane >> 5;
  bf16_t* HB = (bf16_t*)(p.ws + WS_HB);
  const float* S5A = (const float*)(p.ws + WS_S5A);
  const bf16_t* BB = (const bf16_t*)(p.ws + WS_S5BB);
  const bf16_t* CM = (const bf16_t*)(p.ws + WS_S5CM);
  const float* E = (const float*)(p.ws + WS_S5E);
  const float* Dsk = p.in[21] + slot * 1024;
  unsigned char* ldsw = smem + wave * 8704;
  const int tokr = s5_tok(r);
  for (int it = blockIdx.x * 8 + wave; it < 128 * 64; it += gridDim.x * 8) {
    const int ck = it >> 6, g = it & 63, tok0 = ck * 64;
    int c, nc, bq; bool sample;
    if (tok0 < 4096) { bq = tok0 >> 8; c = (tok0 >> 6) & 3; nc = 4; sample = false; }
    else { const int t2 = tok0 - 4096; bq = t2 >> 10; c = (t2 >> 6) & 15; nc = 16; sample = true; }
    const int ck0 = ck - c;
    bf16x8 uf[2];
    _Pragma("unroll") for (int tt = 0; tt < 2; ++tt) uf[tt] = *(const bf16x8*)(HB + (size_t)(tok0 + 32 * tt + tokr) * D + g * 16 + 8 * H);
    f32x4 yacc[2][2];
    _Pragma("unroll") for (int a = 0; a < 2; ++a) _Pragma("unroll") for (int b = 0; b < 2; ++b) yacc[a][b] = (f32x4){0.f, 0.f, 0.f, 0.f};
    _Pragma("unroll") for (int dir = 0; dir < 2; ++dir) {
      const int sdg = (slot * 2 + dir) * 64 + g;
      const cplx a0 = {S5A[(sdg * 64 + r) * 2], S5A[(sdg * 64 + r) * 2 + 1]};
      const cplx a1 = {S5A[(sdg * 64 + r + 32) * 2], S5A[(sdg * 64 + r + 32) * 2 + 1]};
      cplx a0_64 = a0, a1_64 = a1;
      _Pragma("unroll") for (int i = 0; i < 6; ++i) { a0_64 = cmul(a0_64, a0_64); a1_64 = cmul(a1_64, a1_64); }
      cplx c0 = {0.f, 0.f}, c1 = {0.f, 0.f};
      if (sample) {
        const float* h0 = p.in[2] + ((size_t)((bq * 2 + slot) * 2 + dir) * 2) * 4096 + g * 64;
        c0.re = h0[r]; c0.im = h0[4096 + r]; c1.re = h0[r + 32]; c1.im = h0[4096 + r + 32];
      }
      {
        const int ncar = dir ? nc - 1 - c : c;
        for (int j0 = 0; j0 < ncar; j0 += 8) {
          float2 va[8], vb[8];
#pragma unroll
          for (int j = 0; j < 8; ++j) {
            const int jj = min(j0 + j, ncar - 1);
            const int cc = dir ? nc - 1 - jj : jj;
            const float* ep = E + ((size_t)(((ck0 + cc) * 64 + g) * 2 + dir) * 64) * 2;
            va[j] = *(const float2*)(ep + r * 2); vb[j] = *(const float2*)(ep + (r + 32) * 2);
          }
#pragma unroll
          for (int j = 0; j < 8; ++j) if (j0 + j < ncar) {
            c0 = cfma(a0_64, c0, (cplx){va[j].x, va[j].y}); c1 = cfma(a1_64, c1, (cplx){vb[j].x, vb[j].y});
          }
        }
      }
      bf16x8 bfr[4], cfr[4];
      _Pragma("unroll") for (int ct = 0; ct < 4; ++ct) bfr[ct] = *(const bf16x8*)(BB + ((size_t)sdg * 128 + 32 * ct + r) * 16 + 8 * H);
      _Pragma("unroll") for (int ks = 0; ks < 4; ++ks) cfr[ks] = *(const bf16x8*)(CM + ((size_t)sdg * 16 + (lane & 15)) * 128 + 32 * ks + 8 * (lane >> 4));
      _Pragma("unroll") for (int t2 = 0; t2 < 2; ++t2) {
        const int tt = dir ? 1 - t2 : t2;
        f32x16 acc[4];
        bu_mfma4(acc[0], acc[1], acc[2], acc[3], uf[tt], bfr[0], bfr[1], bfr[2], bfr[3]);
        const int firstH = dir;
        cplx h0 = c0, h1 = c1;
        if (H == firstH) {
          if (dir == 0) { _Pragma("unroll") for (int i = 0; i < 16; ++i) { h0 = cfma(a0, h0, (cplx){acc[0][i], acc[2][i]}); h1 = cfma(a1, h1, (cplx){acc[1][i], acc[3][i]});
                            acc[0][i] = h0.re; acc[2][i] = h0.im; acc[1][i] = h1.re; acc[3][i] = h1.im; } }
          else { _Pragma("unroll") for (int i = 15; i >= 0; --i) { h0 = cfma(a0, h0, (cplx){acc[0][i], acc[2][i]}); h1 = cfma(a1, h1, (cplx){acc[1][i], acc[3][i]});
                            acc[0][i] = h0.re; acc[2][i] = h0.im; acc[1][i] = h1.re; acc[3][i] = h1.im; } }
        }
        h0 = shfl_c(h0, r + 32 * firstH); h1 = shfl_c(h1, r + 32 * firstH);
        if (H != firstH) {
          if (dir == 0) { _Pragma("unroll") for (int i = 0; i < 16; ++i) { h0 = cfma(a0, h0, (cplx){acc[0][i], acc[2][i]}); h1 = cfma(a1, h1, (cplx){acc[1][i], acc[3][i]});
                            acc[0][i] = h0.re; acc[2][i] = h0.im; acc[1][i] = h1.re; acc[3][i] = h1.im; } }
          else { _Pragma("unroll") for (int i = 15; i >= 0; --i) { h0 = cfma(a0, h0, (cplx){acc[0][i], acc[2][i]}); h1 = cfma(a1, h1, (cplx){acc[1][i], acc[3][i]});
                            acc[0][i] = h0.re; acc[2][i] = h0.im; acc[1][i] = h1.re; acc[3][i] = h1.im; } }
        }
        if (!sample && t2 == 1 && ((dir == 0 && c == nc - 1) || (dir == 1 && c == 0)) && H != firstH) {
          float* so = p.out + OUT_S5 + ((size_t)((bq * 2 + slot) * 2 + dir) * 2) * 4096 + g * 64;
          so[r] = h0.re; so[4096 + r] = h0.im; so[r + 32] = h1.re; so[4096 + r + 32] = h1.im;
        }
        c0 = shfl_c(h0, r + 32 * (1 - firstH)); c1 = shfl_c(h1, r + 32 * (1 - firstH));
        _Pragma("unroll") for (int i = 0; i < 16; ++i) {
          uint2 pk; pk.x = cvt_pk_bf16(acc[0][i], acc[2][i]); pk.y = cvt_pk_bf16(acc[1][i], acc[3][i]);
          *(uint2*)(ldsw + (16 * H + i) * 272 + 8 * r) = pk;
        }
        asm volatile("s_waitcnt lgkmcnt(0)" ::: "memory");
        _Pragma("unroll") for (int rt = 0; rt < 2; ++rt) _Pragma("unroll") for (int ks = 0; ks < 4; ++ks) {
          const bf16x8 af = *(const bf16x8*)(ldsw + (16 * rt + (lane & 15)) * 272 + (32 * ks + 8 * (lane >> 4)) * 2);
          yacc[tt][rt] = __builtin_amdgcn_mfma_f32_16x16x32_bf16(af, cfr[ks], yacc[tt][rt], 0, 0, 0);
        }
        asm volatile("s_waitcnt lgkmcnt(0)" ::: "memory");
      }
    }
    asm volatile("s_nop 15" : "+v"(yacc[0][0]), "+v"(yacc[0][1]), "+v"(yacc[1][0]), "+v"(yacc[1][1]));
    const int ch = lane & 15, col = g * 16 + ch;
    const float dsk = Dsk[col];
    _Pragma("unroll") for (int tt = 0; tt < 2; ++tt) _Pragma("unroll") for (int rt = 0; rt < 2; ++rt) _Pragma("unroll") for (int j = 0; j < 4; ++j) {
      const int token = tok0 + 32 * tt + 16 * rt + 4 * (lane >> 4) + j;
      bf16_t* hp = HB + (size_t)token * D + col;
      const float u = bf2f(*hp);
      const float y = yacc[tt][rt][j] + u * dsk;
      const float z = 0.7978845608028654f * (y + 0.044715f * y * y * y);
      const float th = 1.f - 2.f / (__expf(2.f * z) + 1.f);
      *hp = f2bf(0.5f * y * (1.f + th));
    }
  }
}

constexpr float LOG2E = 1.4426950408889634f;

__device__ void phase_post_na(const Params& p) {
  const int tid_ = opaque_tid(); const int lane = tid_ & 63, wave = tid_ >> 6;
  bf16_t* QK = (bf16_t*)(p.ws + WS_QK);
  const float* qn = p.in[25]; const float* kn = p.in[26];
  const float qs = 0.125f * LOG2E;
  const int d0 = (lane & 3) * 16;
  for (int row = blockIdx.x * 8 + wave; row < NTOK; row += gridDim.x * 8) {
    _Pragma("unroll") for (int part = 0; part < 2; ++part) {
      bf16_t* ptr = QK + (size_t)row * 2048 + part * 1024 + lane * 16;
      uint4 a = *(uint4*)ptr, b = *(uint4*)(ptr + 8);
      unsigned w[8] = {a.x, a.y, a.z, a.w, b.x, b.y, b.z, b.w};
      float v[16]; float ss = 0.f;
      _Pragma("unroll") for (int i = 0; i < 8; ++i) { v[2 * i] = bflo(w[i]); v[2 * i + 1] = bfhi(w[i]); }
      _Pragma("unroll") for (int i = 0; i < 16; ++i) ss += v[i] * v[i];
      ss += __shfl_xor(ss, 1); ss += __shfl_xor(ss, 2);
      const float rstd = rsqrtf(ss * (1.f / 64.f) + 1e-6f);
      const float* nw = part ? kn : qn;
      const float sc = part ? 1.f : qs;
      float o[16];
      _Pragma("unroll") for (int i = 0; i < 16; ++i) o[i] = v[i] * rstd * nw[d0 + i];
      if (part == 1 && row < 4096) {
        float* op = p.out + OUT_NAK + (size_t)row * 1024 + lane * 16;
        _Pragma("unroll") for (int i = 0; i < 4; ++i) *(f32x4*)(op + 4 * i) = (f32x4){o[4 * i], o[4 * i + 1], o[4 * i + 2], o[4 * i + 3]};
      }
      _Pragma("unroll") for (int i = 0; i < 8; ++i) w[i] = cvt_pk_bf16(o[2 * i] * sc, o[2 * i + 1] * sc);
      *(uint4*)ptr = make_uint4(w[0], w[1], w[2], w[3]); *(uint4*)(ptr + 8) = make_uint4(w[4], w[5], w[6], w[7]);
    }
  }
}

__device__ void phase_post_gqa(const Params& p) {
  const int tid_ = opaque_tid(); const int lane = tid_ & 63, wave = tid_ >> 6;
  bf16_t* QK = (bf16_t*)(p.ws + WS_QK);
  const float* qn = p.in[30]; const float* kn = p.in[31];
  const float qs = 0.08838834764831845f * LOG2E;
  for (int row = blockIdx.x * 8 + wave; row < NTOK; row += gridDim.x * 8) {
    const bool sample = row >= 4096;
    const int t = (row - 4096) & 1023;
    const float prow = (float)(t >> 6), pcol = (float)(t & 63);
    {
      const int i0 = (lane & 7) * 8;
      bf16_t* ptr = QK + (size_t)row * 1280 + (lane >> 3) * 128 + i0;
      uint4 a = *(uint4*)ptr, b = *(uint4*)(ptr + 64);
      unsigned wa[4] = {a.x, a.y, a.z, a.w}, wb[4] = {b.x, b.y, b.z, b.w};
      float x1[8], x2[8]; float ss = 0.f;
      _Pragma("unroll") for (int i = 0; i < 4; ++i) { x1[2 * i] = bflo(wa[i]); x1[2 * i + 1] = bfhi(wa[i]); x2[2 * i] = bflo(wb[i]); x2[2 * i + 1] = bfhi(wb[i]); }
      _Pragma("unroll") for (int i = 0; i < 8; ++i) ss += x1[i] * x1[i] + x2[i] * x2[i];
      ss += __shfl_xor(ss, 1); ss += __shfl_xor(ss, 2); ss += __shfl_xor(ss, 4);
      const float rstd = rsqrtf(ss * (1.f / 128.f) + 1e-6f);
      _Pragma("unroll") for (int i = 0; i < 8; ++i) { x1[i] *= rstd * qn[i0 + i]; x2[i] *= rstd * qn[64 + i0 + i]; }
      if (sample) {
        _Pragma("unroll") for (int i = 0; i < 8; ++i) {
          const int pi = i0 + i;
          const float inv = exp2f(-(float)(pi & 31) * (13.287712379549449f / 32.f));
          const float ang = (pi < 32 ? prow : pcol) * inv;
          const float cs = cosf(ang), sn = sinf(ang);
          const float y1 = x1[i] * cs - x2[i] * sn, y2 = x1[i] * sn + x2[i] * cs;
          x1[i] = y1; x2[i] = y2;
        }
      }
      _Pragma("unroll") for (int i = 0; i < 4; ++i) { wa[i] = cvt_pk_bf16(x1[2 * i] * qs, x1[2 * i + 1] * qs); wb[i] = cvt_pk_bf16(x2[2 * i] * qs, x2[2 * i + 1] * qs); }
      *(uint4*)ptr = make_uint4(wa[0], wa[1], wa[2], wa[3]); *(uint4*)(ptr + 64) = make_uint4(wb[0], wb[1], wb[2], wb[3]);
    }
    {
      const int i0 = (lane & 31) * 2;
      bf16_t* ptr = QK + (size_t)row * 1280 + 1024 + (lane >> 5) * 128 + i0;
      unsigned wa = *(unsigned*)ptr, wb = *(unsigned*)(ptr + 64);
      float x1[2] = {bflo(wa), bfhi(wa)}, x2[2] = {bflo(wb), bfhi(wb)};
      float ss = x1[0] * x1[0] + x1[1] * x1[1] + x2[0] * x2[0] + x2[1] * x2[1];
      _Pragma("unroll") for (int o = 1; o < 32; o <<= 1) ss += __shfl_xor(ss, o);
      const float rstd = rsqrtf(ss * (1.f / 128.f) + 1e-6f);
      _Pragma("unroll") for (int i = 0; i < 2; ++i) { x1[i] *= rstd * kn[i0 + i]; x2[i] *= rstd * kn[64 + i0 + i]; }
      if (!sample) {
        float* op = p.out + OUT_GQAK + (size_t)row * 256 + (lane >> 5) * 128 + i0;
        *(float2*)op = make_float2(x1[0], x1[1]); *(float2*)(op + 64) = make_float2(x2[0], x2[1]);
      } else {
        _Pragma("unroll") for (int i = 0; i < 2; ++i) {
          const int pi = i0 + i;
          const float inv = exp2f(-(float)(pi & 31) * (13.287712379549449f / 32.f));
          const float ang = (pi < 32 ? prow : pcol) * inv;
          const float cs = cosf(ang), sn = sinf(ang);
          const float y1 = x1[i] * cs - x2[i] * sn, y2 = x1[i] * sn + x2[i] * cs;
          x1[i] = y1; x2[i] = y2;
        }
      }
      *(unsigned*)ptr = cvt_pk_bf16(x1[0], x1[1]); *(unsigned*)(ptr + 64) = cvt_pk_bf16(x2[0], x2[1]);
    }
  }
}

template <int DH, bool NAL>
__device__ __forceinline__ void attn_wave(const bf16_t* Q, int ldq,
                                          const bf16_t* K0, int ldk0, const bf16_t* V0, int ldv0, int n0,
                                          const bf16_t* K1, int ldk1, const bf16_t* V1, int ldv1, int n1,
                                          bf16_t* O, int ldo, const float* rpb_h, int rr, int rs, int qc0) {
  constexpr int KS = DH / 32, DT = DH / 16;
  const int lane = opaque_tid() & 63, fr = lane & 15, g = lane >> 4;
  bf16x8 qf[2][KS];
  _Pragma("unroll") for (int qg = 0; qg < 2; ++qg) _Pragma("unroll") for (int ks = 0; ks < KS; ++ks) qf[qg][ks] = *(const bf16x8*)(Q + (size_t)(qg * 16 + fr) * ldq + ks * 32 + 8 * g);
  f32x4 o[2][DT];
  _Pragma("unroll") for (int qg = 0; qg < 2; ++qg) _Pragma("unroll") for (int dt = 0; dt < DT; ++dt) o[qg][dt] = (f32x4){0.f, 0.f, 0.f, 0.f};
  float lsum[2] = {0.f, 0.f};
  const int krow_in = 8 * (fr >> 2) + (fr & 3);
  const int nch = (n0 + n1) >> 5;
  for (int c = 0; c < nch; ++c) {
    const bool s1 = (c * 32 >= n0);
    const int kc = s1 ? c * 32 - n0 : c * 32;
    const bf16_t* K = s1 ? K1 : K0; const int ldk = s1 ? ldk1 : ldk0;
    const bf16_t* V = s1 ? V1 : V0; const int ldv = s1 ? ldv1 : ldv0;
    bf16x8 kf[2][KS], vf[DT];
    _Pragma("unroll") for (int t = 0; t < 2; ++t) _Pragma("unroll") for (int ks = 0; ks < KS; ++ks) kf[t][ks] = *(const bf16x8*)(K + (size_t)(kc + krow_in + 4 * t) * ldk + ks * 32 + 8 * g);
    _Pragma("unroll") for (int dt = 0; dt < DT; ++dt) vf[dt] = *(const bf16x8*)(V + (size_t)(16 * dt + fr) * ldv + kc + 8 * g);
    f32x4 s[2][2];
    _Pragma("unroll") for (int qg = 0; qg < 2; ++qg) _Pragma("unroll") for (int t = 0; t < 2; ++t) {
      s[qg][t] = (f32x4){0.f, 0.f, 0.f, 0.f};
      _Pragma("unroll") for (int ks = 0; ks < KS; ++ks) s[qg][t] = __builtin_amdgcn_mfma_f32_16x16x32_bf16(kf[t][ks], qf[qg][ks], s[qg][t], 0, 0, 0);
    }
    asm volatile("s_nop 15" : "+v"(s[0][0]), "+v"(s[0][1]), "+v"(s[1][0]), "+v"(s[1][1]));
    bf16x8 pf[2];
    _Pragma("unroll") for (int qg = 0; qg < 2; ++qg) {
      float pv[8];
      _Pragma("unroll") for (int i = 0; i < 8; ++i) {
        float sv = s[qg][i >> 2][i & 3];
        if (NAL && !s1) {
          const int krow = rs + (kc >> 6), kcol = (kc & 63) + 8 * g + i;
          const int qc = qc0 + qg * 16 + fr;
          const int cs = min(max(qc - 8, 0), 48);
          const bool valid = (kcol >= cs) && (kcol < cs + 16);
          const int bi = valid ? (krow - rr + 7) * 31 + (kcol - qc + 15) : 0;
          const float bias = rpb_h[bi];
          pv[i] = valid ? __builtin_amdgcn_exp2f(sv + bias * LOG2E) : 0.f;
        } else {
          pv[i] = __builtin_amdgcn_exp2f(sv);
        }
        lsum[qg] += pv[i];
      }
      union { bf16x8 v; unsigned u[4]; } pk;
      _Pragma("unroll") for (int i = 0; i < 4; ++i) pk.u[i] = cvt_pk_bf16(pv[2 * i], pv[2 * i + 1]);
      pf[qg] = pk.v;
    }
    asm volatile("s_nop 3" : "+v"(pf[0]), "+v"(pf[1]));
    _Pragma("unroll") for (int qg = 0; qg < 2; ++qg) _Pragma("unroll") for (int dt = 0; dt < DT; ++dt)
      o[qg][dt] = __builtin_amdgcn_mfma_f32_16x16x32_bf16(vf[dt], pf[qg], o[qg][dt], 0, 0, 0);
  }
  _Pragma("unroll") for (int qg = 0; qg < 2; ++qg) _Pragma("unroll") for (int dt = 0; dt < DT; ++dt) asm volatile("s_nop 7" : "+v"(o[qg][dt]));
  _Pragma("unroll") for (int qg = 0; qg < 2; ++qg) {
    float l = lsum[qg];
    l += __shfl_xor(l, 16); l += __shfl_xor(l, 32);
    const float inv = 1.f / l;
    _Pragma("unroll") for (int dt = 0; dt < DT; ++dt) {
      uint2 pk; pk.x = cvt_pk_bf16(o[qg][dt][0] * inv, o[qg][dt][1] * inv); pk.y = cvt_pk_bf16(o[qg][dt][2] * inv, o[qg][dt][3] * inv);
      *(uint2*)(O + (size_t)(qg * 16 + fr) * ldo + 16 * dt + 4 * g) = pk;
    }
  }
}

__device__ void phase_attn_na(const Params& p) {
  const int wave = opaque_tid() >> 6;
  const bf16_t* QK = (const bf16_t*)(p.ws + WS_QK);
  const bf16_t* VT = (const bf16_t*)(p.ws + WS_VT);
  const bf16_t* CK = (const bf16_t*)(p.ws + WS_CKNA);
  const bf16_t* CVT = (const bf16_t*)(p.ws + WS_CVTNA);
  bf16_t* AO = (bf16_t*)(p.ws + WS_AO);
  for (int gw = blockIdx.x * 8 + wave; gw < 4096; gw += gridDim.x * 8) {
    if (gw < 2048) {
      const int wq = gw & 1, r = (gw >> 1) & 15, h = (gw >> 5) & 15, b = gw >> 9;
      const int rs = min(max(r - 4, 0), 8);
      const int tokq = 4096 + b * 1024 + r * 64 + wq * 32;
      const int tokk = 4096 + b * 1024 + rs * 64;
      attn_wave<64, true>(QK + (size_t)tokq * 2048 + h * 64, 2048,
                          QK + (size_t)tokk * 2048 + 1024 + h * 64, 2048,
                          VT + (size_t)4096 * 1024 + ((size_t)b * 1024 + h * 64) * 1024 + rs * 64, 1024, 512,
                          CK + (size_t)b * 512 * 1024 + h * 64, 1024,
                          CVT + ((size_t)b * 1024 + h * 64) * 512, 512, 512,
                          AO + (size_t)tokq * 1024 + h * 64, 1024,
                          p.in[27] + h * 15 * 31, r, rs, wq * 32);
    } else {
      const int id = gw - 2048, qb = id & 7, h = (id >> 3) & 15, b = id >> 7;
      const int tokq = b * 256 + qb * 32;
      attn_wave<64, false>(QK + (size_t)tokq * 2048 + h * 64, 2048,
                           QK + (size_t)(b * 256) * 2048 + 1024 + h * 64, 2048,
                           VT + ((size_t)b * 1024 + h * 64) * 256, 256, 256,
                           nullptr, 0, nullptr, 0, 0,
                           AO + (size_t)tokq * 1024 + h * 64, 1024, nullptr, 0, 0, 0);
    }
  }
}

__device__ void phase_attn_gqa(const Params& p) {
  const int wave = opaque_tid() >> 6;
  const bf16_t* QK = (const bf16_t*)(p.ws + WS_QK);
  const bf16_t* VT = (const bf16_t*)(p.ws + WS_VT);
  const bf16_t* CK = (const bf16_t*)(p.ws + WS_CKGQA);
  const bf16_t* CVT = (const bf16_t*)(p.ws + WS_CVTGQA);
  bf16_t* AO = (bf16_t*)(p.ws + WS_AO);
  const int nb4 = (int)gridDim.x * 4;
  if (wave < 4) {
    for (int id = blockIdx.x * 4 + wave; id < 1024; id += nb4) {
      const int qb = id & 31, hq = (id >> 5) & 7, b = id >> 8, hk = hq >> 2;
      const int tokq = 4096 + b * 1024 + qb * 32;
      attn_wave<128, false>(QK + (size_t)tokq * 1280 + hq * 128, 1280,
                            QK + (size_t)(4096 + b * 1024) * 1280 + 1024 + hk * 128, 1280,
                            VT + (size_t)4096 * 256 + ((size_t)b * 256 + hk * 128) * 1024, 1024, 1024,
                            CK + (size_t)b * 512 * 256 + hk * 128, 256,
                            CVT + ((size_t)b * 256 + hk * 128) * 512, 512, 512,
                            AO + (size_t)tokq * 1024 + hq * 128, 1024, nullptr, 0, 0, 0);
    }
  } else {
    for (int id = blockIdx.x * 4 + (wave - 4); id < 1024; id += nb4) {
      const int qb = id & 7, hq = (id >> 3) & 7, b = id >> 6, hk = hq >> 2;
      const int tokq = b * 256 + qb * 32;
      attn_wave<128, false>(QK + (size_t)tokq * 1280 + hq * 128, 1280,
                            QK + (size_t)(b * 256) * 1280 + 1024 + hk * 128, 1280,
                            VT + ((size_t)b * 256 + hk * 128) * 256, 256, 256,
                            nullptr, 0, nullptr, 0, 0,
                            AO + (size_t)tokq * 1024 + hq * 128, 1024, nullptr, 0, 0, 0);
    }
  }
}

#define XB_TMO      128
#define XB_XCNT(j)  (256  + 64 * (j))
#define XB_XSUB(j)  (1280 + 64 * (j))
#define XB_XGEN(j)  (2304 + 64 * (j))
#define XB_TOP      3328
#define XB_TOPGEN   3392
#define XCD_BAR_WORDS 3456
#define XB_SPIN_CAP (1u << 18)
#define LAS __attribute__((address_space(3)))

__device__ __forceinline__ unsigned xb_ld(unsigned* p)              { return __hip_atomic_load(p, __ATOMIC_RELAXED, __HIP_MEMORY_SCOPE_AGENT); }
__device__ __forceinline__ unsigned xb_add(unsigned* p, unsigned v) { return __hip_atomic_fetch_add(p, v, __ATOMIC_RELAXED, __HIP_MEMORY_SCOPE_AGENT); }
__device__ __forceinline__ unsigned xb_xcc_id() { return (unsigned)__builtin_amdgcn_s_getreg((3 << 11) | 20) & 0xFu; }
#define XB_SPIN(cond, bar) do { unsigned _sp = 0; while (cond) { __builtin_amdgcn_s_sleep(1); \
    if ((++_sp & 255u) == 0u) { if (xb_ld(&(bar)[XB_TMO])) break; if (_sp > XB_SPIN_CAP) { atomicAdd(&(bar)[XB_TMO], 1u); break; } } } } while (0)

struct XcdBarrier {
    unsigned* bar; unsigned x;
    volatile LAS unsigned* st;
};

__device__ __forceinline__ XcdBarrier xcd_barrier_post(unsigned* bar, volatile LAS unsigned* st) {
    XcdBarrier b; b.bar = bar; b.x = xb_xcc_id(); b.st = st;
    if (threadIdx.x == 0) (void)xb_add(&bar[XB_XCNT(b.x)], 1u);
    return b;
}
__device__ __forceinline__ void xcd_barrier_complete(unsigned* bar, unsigned x, unsigned& nloc, unsigned& nx) {
    const unsigned G = gridDim.x * gridDim.y * gridDim.z;
    unsigned sum, cnt, mine, sp = 0u;
    for (;;) {
        sum = 0u; cnt = 0u; mine = 0u;
#pragma unroll
        for (unsigned j = 0; j < 16; ++j) { const unsigned c = xb_ld(&bar[XB_XCNT(j)]); sum += c; cnt += (c > 0u) ? 1u : 0u; mine = (j == x) ? c : mine; }
        if (sum == G) break;
        __builtin_amdgcn_s_sleep(1);
        if ((++sp & 255u) == 0u) { if (xb_ld(&bar[XB_TMO])) break; if (sp > XB_SPIN_CAP) { atomicAdd(&bar[XB_TMO], 1u); break; } }
    }
    nloc = mine > 0u ? mine : 1u; nx = cnt > 0u ? cnt : 1u;
}

__device__ __forceinline__ void xcd_barrier(const XcdBarrier& b) {
    asm volatile("s_waitcnt vmcnt(0)" ::: "memory");
    __syncthreads();
    if (threadIdx.x == 0) {
        unsigned* bar = b.bar; unsigned xb_probe = 0u;
        __builtin_amdgcn_s_waitcnt(0);
        unsigned nloc = b.st[0], nx = b.st[1];
        if (nloc == 0u) { xcd_barrier_complete(bar, b.x, nloc, nx); b.st[0] = nloc; b.st[1] = nx; }
        const unsigned old = xb_add(&bar[XB_XSUB(b.x)], 1u);
        const unsigned gen = old / nloc;
        if (old + 1u == (gen + 1u) * nloc) {
            __builtin_amdgcn_fence(__ATOMIC_RELEASE, "agent");
            asm volatile("s_waitcnt vmcnt(0)" ::: "memory");
            const unsigned og = xb_add(&bar[XB_TOP], 1u);
            const unsigned tg = og / nx;
            if (og + 1u == (tg + 1u) * nx) xb_add(&bar[XB_TOPGEN], 1u);
            else XB_SPIN(xb_ld(&bar[XB_TOPGEN]) == tg, bar);
            __builtin_amdgcn_fence(__ATOMIC_ACQUIRE, "agent"); xb_probe = xb_ld(&bar[XB_TMO]);
            xb_add(&bar[XB_XGEN(b.x)], 1u);
            asm volatile("s_waitcnt vmcnt(0)" ::: "memory");
        } else {
            XB_SPIN(xb_ld(&bar[XB_XGEN(b.x)]) == gen, bar);
            __builtin_amdgcn_fence(__ATOMIC_ACQUIRE, "agent"); xb_probe = xb_ld(&bar[XB_TMO]);
            asm volatile("s_waitcnt vmcnt(0)" ::: "memory");
        }
        asm volatile("" :: "v"(xb_probe));
        __builtin_amdgcn_s_sleep(80);
    }
    __syncthreads();
}


__device__ void phase_fake_mlp1(const Params& p) {
  const int tid = opaque_tid();
  const uint4* HB = (const uint4*)(p.ws + WS_HB);
  uint4* ACT = (uint4*)(p.ws + WS_ACT);
  for (size_t i = (size_t)blockIdx.x * NT + tid; i < (size_t)NTOK * DFF / 8; i += (size_t)gridDim.x * NT) {
    const size_t row = i >> 9, c8 = i & 511;
    uint4 v = HB[row * 128 + (c8 & 127)];
    unsigned w[4] = {v.x, v.y, v.z, v.w};
    for (int j = 0; j < 4; ++j) { float a = bflo(w[j]), b = bfhi(w[j]); w[j] = cvt_pk_bf16(a * a, b * b); }
    ACT[i] = make_uint4(w[0], w[1], w[2], w[3]);
  }
}
__global__ void __launch_bounds__(NT) fwd_megakernel(Params p) {
  cg::grid_group grid = cg::this_grid();
  unsigned char* ws = p.ws;
  const float* MOD = (const float*)(ws + WS_MOD);
  bf16_t* HB = (bf16_t*)(ws + WS_HB);
  bf16_t* AO = (bf16_t*)(ws + WS_AO);
  bf16_t* QK = (bf16_t*)(ws + WS_QK);
  bf16_t* VT = (bf16_t*)(ws + WS_VT);
  bf16_t* ACT = (bf16_t*)(ws + WS_ACT);
  int ph = 0;
#ifdef CHK_INPUT
  { float* chk = (float*)(ws + WS_END);
    const int t = opaque_tid();
    const float* sp = p.in[CHK_INPUT];
    const size_t per = (size_t)CHK_COUNT / gridDim.x;
    float s = 0.f;
    for (size_t i = t; i < per; i += NT) { float v = sp[(size_t)blockIdx.x * per + i]; s += v * (1.f + (float)(i & 15)); }
    float* red = (float*)smem; red[t] = s; __syncthreads();
    if (t == 0) { float a = 0.f; for (int i = 0; i < NT; ++i) a += red[i]; chk[blockIdx.x] = a; }
    __syncthreads(); }
#endif
#ifdef START_DELAY_TICKS
  { const unsigned long long t0 = __builtin_amdgcn_s_memrealtime(); while (__builtin_amdgcn_s_memrealtime() - t0 < START_DELAY_TICKS) __builtin_amdgcn_s_sleep(8); }
#endif
  volatile LAS unsigned* xb_st = (volatile LAS unsigned*)(smem + 131072);
  if (threadIdx.x < 2) xb_st[threadIdx.x] = 0u;
  __syncthreads();
  XcdBarrier xbar = xcd_barrier_post((unsigned*)(ws + WS_BAR), xb_st);
  if (p.ph_hi - p.ph_lo > 1) grid.sync();
#ifdef EXTRA_SYNCS
  for (int i_ = 0; i_ < EXTRA_SYNCS; ++i_) grid.sync();
#endif
#ifndef EN_GEMM
#define EN_GEMM 15
#endif
#ifndef EN_ATTN
#define EN_ATTN 1
#endif
#ifndef EN_S5
#define EN_S5 1
#endif
#ifndef EN_MISC
#define EN_MISC 1
#endif
#define RUN(body) do { if (p.ph_lo <= ph && ph < p.ph_hi) { body; if (ph + 1 < p.ph_hi) xcd_barrier(xbar); } ++ph; } while (0)

  RUN(if (EN_MISC) phase_prologue(p));
  for (int layer = 0; layer < 4; ++layer) {
    const int kind = layer % 3, slot = layer / 3;
    RUN(if (EN_MISC) phase_norm(p, layer, 0, layer == 0));
    if (kind == 0) {
      RUN(if (EN_S5) phase_s5_pass1(p, slot));
      RUN(if (EN_S5) phase_s5_pass2(p, slot));
      { GemmArgs ga{HB, D, (const bf16_t*)(ws + WS_GLUT) + (size_t)slot * 2048 * 1024, D, 32, 16, 1024, 0xffff};
        EpiGlu e{p.out, MOD + layer * 5 * 6144 + 2 * 1024, p.in[23] + slot * 2048};
        RUN(if (EN_GEMM & 1) gemm_phase<128>(ga, e)); }
    } else if (kind == 1) {
      { GemmArgs ga{HB, D, (const bf16_t*)(ws + WS_NAQKVT), D, 32, 24, 1024, 0xffff};
        EpiQkv e{QK, 2048, VT, 1024, p.out + OUT_NAV};
        RUN(if (EN_GEMM & 2) gemm_phase<128>(ga, e)); }
      RUN(if (EN_MISC) phase_post_na(p));
      RUN(if (EN_ATTN) phase_attn_na(p));
      { GemmArgs ga{AO, D, (const bf16_t*)(ws + WS_NAOT), D, 32, 8, 1024, 0xffff};
        EpiResid e{p.out, MOD + layer * 5 * 6144 + 2 * 1024};
        RUN(if (EN_GEMM & 4) gemm_phase<128>(ga, e)); }
    } else {
      { GemmArgs ga{HB, D, (const bf16_t*)(ws + WS_GQAQKVT), D, 32, 12, 1024, 0xffff};
        EpiQkv e{QK, 1280, VT, 256, p.out + OUT_GQAV};
        RUN(if (EN_GEMM & 2) gemm_phase<128>(ga, e)); }
      RUN(if (EN_MISC) phase_post_gqa(p));
      RUN(if (EN_ATTN) phase_attn_gqa(p));
      { GemmArgs ga{AO, D, (const bf16_t*)(ws + WS_GQAOT), D, 32, 8, 1024, 0xffff};
        EpiResid e{p.out, MOD + layer * 5 * 6144 + 2 * 1024};
        RUN(if (EN_GEMM & 4) gemm_phase<128>(ga, e)); }
    }
    RUN(if (EN_MISC) phase_norm(p, layer, 1, false));
    { GemmArgs ga{HB, D, (const bf16_t*)(ws + WS_W1T) + (size_t)layer * 4096 * 1024, D, 32, 16, 1024, 0xffff};
      EpiSqRelu e{ACT};
      RUN(if (EN_GEMM & 8) gemm_phase<256>(ga, e)); }
    { GemmArgs ga{ACT, DFF, (const bf16_t*)(ws + WS_W2T) + (size_t)layer * 1024 * 4096, DFF, 32, 8, 4096, 0xffff};
      EpiResid e{p.out, MOD + layer * 5 * 6144 + 5 * 1024};
      RUN(if (EN_GEMM & 4) gemm_phase<128>(ga, e)); }
  }
#ifdef FINAL_SYNC
  if (p.ph_hi - p.ph_lo > 1) { grid.sync(); { const unsigned long long t0 = __builtin_amdgcn_s_memrealtime(); while (__builtin_amdgcn_s_memrealtime() - t0 < 2000ull) __builtin_amdgcn_s_sleep(8); } grid.sync(); }
#endif
#ifdef DUMP_S5P
  if (p.ph_hi - p.ph_lo > 1) {
    grid.sync();
    const float* sa = (const float*)(ws + WS_S5A);
    const unsigned* sb = (const unsigned*)(ws + WS_S5BB);
    const unsigned* sc = (const unsigned*)(ws + WS_S5CM);
    for (size_t i = (size_t)blockIdx.x * NT + opaque_tid(); i < 524288; i += (size_t)gridDim.x * NT) {
      if (i < 32768) p.out[i] = sa[i];
      unsigned w = sb[i]; p.out[65536 + 2 * i] = bflo(w); p.out[65536 + 2 * i + 1] = bfhi(w);
      unsigned w2 = sc[i]; p.out[2097152 + 2 * i] = bflo(w2); p.out[2097152 + 2 * i + 1] = bfhi(w2);
    }
  }
#endif
#ifdef DUMP_E
  if (p.ph_hi - p.ph_lo > 1) {
    grid.sync();
    const float* sp = (const float*)(ws + WS_S5E);
    for (size_t i = (size_t)blockIdx.x * NT + opaque_tid(); i < 2097152; i += (size_t)gridDim.x * NT) p.out[i] = sp[i];
  }
#endif
#ifdef DUMP_HB
  if (p.ph_hi - p.ph_lo > 1) {
    grid.sync();
    const unsigned* sp = (const unsigned*)(ws + WS_HB);
    for (size_t i = (size_t)blockIdx.x * NT + opaque_tid(); i < 4194304; i += (size_t)gridDim.x * NT) {
      unsigned w = sp[i]; p.out[2 * i] = bflo(w); p.out[2 * i + 1] = bfhi(w);
    }
  }
#endif
#ifdef DUMP_W2T
  if (p.ph_lo == 100) {
    const unsigned* sp = (const unsigned*)(ws + WS_W2T);
    for (size_t i = (size_t)blockIdx.x * NT + opaque_tid(); i < 19398656 / 2; i += (size_t)gridDim.x * NT) {
      float a = 0.f, b = 0.f;
      if (i < 2097152) { unsigned w = sp[i]; a = bflo(w); b = bfhi(w); }
      p.out[2 * i] = a; p.out[2 * i + 1] = b;
    }
  }
#endif
#undef RUN
#ifdef CHK_W2T
  grid.sync();
  { float* chk = (float*)(ws + WS_END);
    const int t = opaque_tid();
    const unsigned* sp = (const unsigned*)(ws + WS_W2T);
    const size_t per = (size_t)(33554432 / 4) / gridDim.x;
    float s = 0.f;
    for (size_t i = t; i < per; i += NT) { unsigned w = sp[(size_t)blockIdx.x * per + i]; s += (bflo(w) + 2.f * bfhi(w)) * (1.f + (float)(i & 15)); }
    float* red = (float*)smem; red[t] = s; __syncthreads();
    if (t == 0) { float a = 0.f; for (int i = 0; i < NT; ++i) a += red[i]; chk[blockIdx.x] = a; }
    __syncthreads(); }
  grid.sync();
  { const float* chk = (const float*)(ws + WS_END);
    for (size_t i = (size_t)blockIdx.x * NT + opaque_tid(); i < 19398656; i += (size_t)gridDim.x * NT) p.out[i] = chk[(i >> 10) & 255]; }
#endif
#ifdef CHK_INPUT
  grid.sync();
  { const float* chk = (const float*)(ws + WS_END);
    for (size_t i = (size_t)blockIdx.x * NT + opaque_tid(); i < 19398656; i += (size_t)gridDim.x * NT) p.out[i] = chk[(i >> 10) & 255]; }
#endif
}

extern "C" void kernel_launch(void* const* d_in, const int* in_sizes, int n_in, void* d_out, int out_size, void* d_ws, size_t ws_size, hipStream_t stream) {
  static int grid_blocks = 0;
  if (grid_blocks == 0) {
    if (n_in != 33 || ws_size < WS_END) { fprintf(stderr, "kernel_launch: unexpected n_in %d or ws_size %zu (< %zu)\n", n_in, ws_size, (size_t)WS_END); grid_blocks = -1; return; }
    int dev = 0, cus = 0, per_cu = 0;
    (void)hipGetDevice(&dev);
    (void)hipDeviceGetAttribute(&cus, hipDeviceAttributeMultiprocessorCount, dev);
    if (hipFuncSetAttribute((const void*)fwd_megakernel, hipFuncAttributeMaxDynamicSharedMemorySize, LDS_BYTES) != hipSuccess) { fprintf(stderr, "hipFuncSetAttribute failed\n"); grid_blocks = -1; return; }
    if (hipOccupancyMaxActiveBlocksPerMultiprocessor(&per_cu, (const void*)fwd_megakernel, NT, LDS_BYTES) != hipSuccess || per_cu < 1) { fprintf(stderr, "occupancy query failed (%d)\n", per_cu); (void)hipGetLastError(); per_cu = 1; }
    grid_blocks = cus * 1;
    fprintf(stderr, "kernel_launch: cus %d per_cu %d grid %d\n", cus, per_cu, grid_blocks);
  }
  if (grid_blocks < 0) return;
  (void)hipMemsetAsync((unsigned char*)d_ws + WS_BAR, 0, 16384, stream);
  Params p{};
  for (int i = 0; i < 33; ++i) p.in[i] = (const float*)d_in[i];
  p.out = (float*)d_out; p.ws = (unsigned char*)d_ws;
#if N_LAUNCH_MODE == 1
  #ifndef PH_HI
#define PH_HI NPHASE
#endif
  p.ph_lo = 0; p.ph_hi = PH_HI;
  void* args[] = {&p};
  hipError_t e = hipLaunchCooperativeKernel((void*)fwd_megakernel, dim3(grid_blocks), dim3(NT), args, LDS_BYTES, stream);
  if (e != hipSuccess) fprintf(stderr, "cooperative launch failed: %s (grid %d)\n", hipGetErrorString(e), grid_blocks);
#else
#ifndef PH_HI
#define PH_HI NPHASE
#endif
  for (int ph = 0; ph < PH_HI; ++ph) {
    p.ph_lo = ph; p.ph_hi = ph + 1;
    hipLaunchKernelGGL(fwd_megakernel, dim3(grid_blocks), dim3(NT), LDS_BYTES, stream, p);
  }
#ifdef DUMP_W2T
  p.ph_lo = 100; p.ph_hi = 101;
  hipLaunchKernelGGL(fwd_megakernel, dim3(grid_blocks), dim3(NT), LDS_BYTES, stream, p);
#endif
#endif
}
```

```cpp
#include <hip/hip_runtime.h>
#include <hip/hip_bf16.h>
#include <hip/hip_cooperative_groups.h>
#include <cstdio>
namespace cg = cooperative_groups;

typedef unsigned short bf16_t;
using bf16 = __hip_bfloat16;
using bf16x8 = __attribute__((ext_vector_type(8))) short;
using f32x4 = __attribute__((ext_vector_type(4))) float;
using f32x16 = __attribute__((ext_vector_type(16))) float;

#define B_AUX 0
#ifndef USE_GLDS
#define USE_GLDS 1
#endif
#ifndef N_LAUNCH_MODE
#define N_LAUNCH_MODE 1
#endif

constexpr int NT = 512;
constexpr int D = 1024, NTOK = 8192, DFF = 4096;
constexpr int LDS_BYTES = 131072 + 64;
constexpr int NPHASE = 31;

constexpr size_t WS_W1T = 0;
constexpr size_t WS_W2T = WS_W1T + 33554432;
constexpr size_t WS_GLUT = WS_W2T + 33554432;
constexpr size_t WS_NAQKVT = WS_GLUT + 8388608;
constexpr size_t WS_NAOT = WS_NAQKVT + 6291456;
constexpr size_t WS_GQAQKVT = WS_NAOT + 2097152;
constexpr size_t WS_GQAOT = WS_GQAQKVT + 3145728;
constexpr size_t WS_MOD = WS_GQAOT + 2097152;
constexpr size_t WS_S5A = WS_MOD + 491520;
constexpr size_t WS_S5BB = WS_S5A + 131072;
constexpr size_t WS_S5CM = WS_S5BB + 1048576;
constexpr size_t WS_S5E = WS_S5CM + 1048576;
constexpr size_t WS_CKNA = WS_S5E + 8388608;
constexpr size_t WS_CVTNA = WS_CKNA + 4194304;
constexpr size_t WS_CKGQA = WS_CVTNA + 4194304;
constexpr size_t WS_CVTGQA = WS_CKGQA + 1048576;
constexpr size_t WS_HB = WS_CVTGQA + 1048576;
constexpr size_t WS_AO = WS_HB + 16777216;
constexpr size_t WS_QK = WS_AO + 16777216;
constexpr size_t WS_VT = WS_QK + 33554432;
constexpr size_t WS_ACT = WS_VT + 16777216;
constexpr size_t WS_BAR = WS_ACT + 67108864;
constexpr size_t WS_END = WS_BAR + 16384;

constexpr size_t OUT_YS = 4194304, OUT_S5 = 8388608, OUT_NAK = 8912896, OUT_NAV = 13107200, OUT_GQAK = 17301504, OUT_GQAV = 18350080;

struct Params {
  const float* in[33];
  float* out;
  unsigned char* ws;
  int ph_lo, ph_hi;
};

extern __shared__ __attribute__((aligned(16))) unsigned char smem[];

__device__ __forceinline__ unsigned cvt_pk_bf16(float lo, float hi) {
  unsigned r; asm("v_cvt_pk_bf16_f32 %0, %1, %2" : "=v"(r) : "v"(lo), "v"(hi)); return r;
}
__device__ __forceinline__ bf16_t f2bf(float f) { return (bf16_t)(cvt_pk_bf16(f, 0.f) & 0xffffu); }
__device__ __forceinline__ float bf2f(bf16_t b) { return __uint_as_float(((unsigned)b) << 16); }
__device__ __forceinline__ float bflo(unsigned u) { return __uint_as_float(u << 16); }
__device__ __forceinline__ float bfhi(unsigned u) { return __uint_as_float(u & 0xffff0000u); }
__device__ __forceinline__ int cond_of_row(int row) { return row < 4096 ? 0 : 1 + ((row - 4096) >> 10); }

__device__ __forceinline__ int opaque_tid() { int t = threadIdx.x; asm volatile("" : "+v"(t)); return t; }
#define MFMA_SETTLE() asm volatile("s_nop 15\n\ts_nop 15" ::: "memory")
__device__ __forceinline__ void bu_mfma4(f32x16& c0, f32x16& c1, f32x16& c2, f32x16& c3, bf16x8 a, bf16x8 b0, bf16x8 b1, bf16x8 b2, bf16x8 b3) {
  asm volatile("v_mfma_f32_32x32x16_bf16 %0, %4, %5, 0\n\t"
               "v_mfma_f32_32x32x16_bf16 %1, %4, %6, 0\n\t"
               "v_mfma_f32_32x32x16_bf16 %2, %4, %7, 0\n\t"
               "v_mfma_f32_32x32x16_bf16 %3, %4, %8, 0\n\t"
               "s_nop 15\n\ts_nop 15"
               : "=&v"(c0), "=&v"(c1), "=&v"(c2), "=&v"(c3) : "v"(a), "v"(b0), "v"(b1), "v"(b2), "v"(b3));
}
struct cplx { float re, im; };
__device__ __forceinline__ cplx cmul(cplx a, cplx b) { return {a.re * b.re - a.im * b.im, a.re * b.im + a.im * b.re}; }
__device__ __forceinline__ cplx cfma(cplx a, cplx h, cplx b) {
  cplx r; r.re = fmaf(a.re, h.re, fmaf(-a.im, h.im, b.re)); r.im = fmaf(a.re, h.im, fmaf(a.im, h.re, b.im)); return r;
}

constexpr int BM = 256, BK = 64, NXCD = 8, WGM = 8;

__device__ __forceinline__ int lds_byte(int r, int c) {
  int st = (r >> 4) * 2 + (c >> 5), ob = (r & 15) * 64 + (c & 31) * 2;
  return st * 1024 + (ob ^ (((ob >> 9) & 1) << 5));
}
__device__ __forceinline__ void stage_rc(int b, int& R, int& C) {
  int st = b >> 10, sb = b & 1023, swz = sb ^ (((sb >> 9) & 1) << 5);
  R = (st / 2) * 16 + swz / 64; C = (st % 2) * 32 + (swz % 64) / 2;
}

struct GemmArgs { const bf16_t* A; int lda; const bf16_t* Bt; int ldb; int nM, nN, K; int kmask; };

template <int BN, class Epi>
__device__ __forceinline__ void gemm_phase(const GemmArgs ga, const Epi epi) {
  constexpr int TILE_A = BM * BK * 2, TILE_B = BN * BK * 2, STAGE_B = TILE_A + TILE_B, GLA = TILE_A / 8192, GLB = TILE_B / 8192, NF = BN / 64;
  unsigned char* shm = smem;
  const int tid = opaque_tid(), wid = tid >> 6, lane = tid & 63, wr = wid >> 2, wc = wid & 3, fr = lane & 15, fq = lane >> 4;
  unsigned voA[GLA], voB[GLB];
#pragma unroll
  for (int i = 0; i < GLA; ++i) { int r_, c_; stage_rc(wid * 1024 + i * 8192 + lane * 16, r_, c_); voA[i] = (unsigned)(r_ * ga.lda + c_) * 2u; }
#pragma unroll
  for (int i = 0; i < GLB; ++i) { int r_, c_; stage_rc(wid * 1024 + i * 8192 + lane * 16, r_, c_); voB[i] = (unsigned)(r_ * ga.ldb + c_) * 2u; }
  int offA[8], offB[NF];
#pragma unroll
  for (int m = 0; m < 8; ++m) offA[m] = lds_byte(wr * 128 + m * 16 + fr, fq * 8);
#pragma unroll
  for (int n = 0; n < NF; ++n) offB[n] = TILE_A + lds_byte(wc * (BN / 4) + n * 16 + fr, fq * 8);
  const int nwg = ga.nM * ga.nN, nt = ga.K / BK;
  for (int u = blockIdx.x; u < nwg; u += gridDim.x) {
    int wgid = u;
    { int q = nwg / NXCD, r = nwg % NXCD, xcd = wgid % NXCD, off = wgid / NXCD;
      wgid = (xcd < r ? xcd * (q + 1) : r * (q + 1) + (xcd - r) * q) + off; }
    constexpr int WG_ = (BN == 128) ? 4 : WGM;
    const int nig = WG_ * ga.nN, gid = wgid / nig, fm = gid * WG_, gsz = min(ga.nM - fm, WG_);
    const int pm = fm + ((wgid % nig) % gsz), pn = (wgid % nig) / gsz, brow = pm * BM, bcol = pn * BN;
    const bf16_t* Ab = ga.A + (long)brow * ga.lda;
    const bf16_t* Bb = ga.Bt + (long)bcol * ga.ldb;
#define GLDS_STAGE(buf, kt) do { \
    _Pragma("unroll") for (int i = 0; i < GLA; ++i) \
      __builtin_amdgcn_global_load_lds((const unsigned*)((const char*)(Ab + ((kt) & ga.kmask) * BK) + voA[i]), \
        (__attribute__((address_space(3))) unsigned*)(shm + (buf) * STAGE_B + wid * 1024 + i * 8192), 16, 0, 0); \
    _Pragma("unroll") for (int i = 0; i < GLB; ++i) \
      __builtin_amdgcn_global_load_lds((const unsigned*)((const char*)(Bb + ((kt) & ga.kmask) * BK) + voB[i]), \
        (__attribute__((address_space(3))) unsigned*)(shm + (buf) * STAGE_B + TILE_A + wid * 1024 + i * 8192), 16, 0, B_AUX); } while (0)
    f32x4 acc[8][NF];
#pragma unroll
    for (int m = 0; m < 8; ++m)
#pragma unroll
      for (int n = 0; n < NF; ++n) acc[m][n] = (f32x4){0.f, 0.f, 0.f, 0.f};
#define LOADF(A_, B_, ks_) do { \
      _Pragma("unroll") for (int m = 0; m < 8; ++m) A_[m] = *(const bf16x8*)(sb + offA[m] + (ks_) * 1024); \
      _Pragma("unroll") for (int n = 0; n < NF; ++n) B_[n] = *(const bf16x8*)(sb + offB[n] + (ks_) * 1024); } while (0)
#define MMAS(A_, B_) do { \
      _Pragma("unroll") for (int m = 0; m < 8; ++m) \
        _Pragma("unroll") for (int n = 0; n < NF; ++n) acc[m][n] = __builtin_amdgcn_mfma_f32_16x16x32_bf16(B_[n], A_[m], acc[m][n], 0, 0, 0); } while (0)
#define COMPUTE(cur_) do { const unsigned char* sb = shm + (cur_) * STAGE_B; \
      if constexpr (NF == 2) { \
        bf16x8 A0[8], B0[NF], A1[8], B1[NF]; \
        LOADF(A0, B0, 0); LOADF(A1, B1, 1); \
        __builtin_amdgcn_sched_barrier(0); \
        MMAS(A0, B0); MMAS(A1, B1); \
        __builtin_amdgcn_sched_barrier(0); \
      } else { \
        bf16x8 A0[8], B0[NF]; \
        LOADF(A0, B0, 0); __builtin_amdgcn_sched_barrier(0); MMAS(A0, B0); __builtin_amdgcn_sched_barrier(0); \
        LOADF(A0, B0, 1); __builtin_amdgcn_sched_barrier(0); MMAS(A0, B0); __builtin_amdgcn_sched_barrier(0); \
      } } while (0)
#if USE_GLDS
    GLDS_STAGE(0, 0);
    asm volatile("s_waitcnt vmcnt(0)" ::: "memory"); __syncthreads();
    for (int t = 0; t < nt; ++t) {
      const int cur = t & 1;
      if (t + 1 < nt) GLDS_STAGE(cur ^ 1, t + 1);
      COMPUTE(cur);
      asm volatile("s_waitcnt vmcnt(0)" ::: "memory"); __syncthreads();
    }
#else
    uint4 sa0, sa1, sa2, sa3, sb0, sb1, sb2, sb3;
    static_assert(GLA == 4 && (GLB == 2 || GLB == 4), "staging shape");
#define GSRC_A(kt, i) (*(const uint4*)((const char*)(Ab + ((kt) & ga.kmask) * BK) + voA[i]))
#define GSRC_B(kt, i) (*(const uint4*)((const char*)(Bb + ((kt) & ga.kmask) * BK) + voB[i]))
#define LDST_A(buf, i) (*(uint4*)(shm + (buf) * STAGE_B + wid * 1024 + (i) * 8192 + lane * 16))
#define LDST_B(buf, i) (*(uint4*)(shm + (buf) * STAGE_B + TILE_A + wid * 1024 + (i) * 8192 + lane * 16))
#define REG_ISSUE(kt) do { sa0 = GSRC_A(kt, 0); sa1 = GSRC_A(kt, 1); sa2 = GSRC_A(kt, 2); sa3 = GSRC_A(kt, 3); \
      sb0 = GSRC_B(kt, 0); sb1 = GSRC_B(kt, 1); if constexpr (GLB == 4) { sb2 = GSRC_B(kt, 2); sb3 = GSRC_B(kt, 3); } } while (0)
#define REG_WRITE(buf) do { LDST_A(buf, 0) = sa0; LDST_A(buf, 1) = sa1; LDST_A(buf, 2) = sa2; LDST_A(buf, 3) = sa3; \
      LDST_B(buf, 0) = sb0; LDST_B(buf, 1) = sb1; if constexpr (GLB == 4) { LDST_B(buf, 2) = sb2; LDST_B(buf, 3) = sb3; } } while (0)
    REG_ISSUE(0); REG_WRITE(0); REG_ISSUE(1); __syncthreads();
    for (int t = 0; t < nt; ++t) {
      const int cur = t & 1;
      if (t + 1 < nt) REG_WRITE(cur ^ 1);
      if (t + 2 < nt) REG_ISSUE(t + 2);
      COMPUTE(cur);
      __syncthreads();
    }
#undef REG_ISSUE
#undef REG_WRITE
#endif
#undef COMPUTE
#undef LOADF
#undef MMAS
#undef GLDS_STAGE
    epi(acc, brow + wr * 128 + fr, bcol + wc * (BN / 4) + fq * 4);
  }
  __syncthreads();
}

struct EpiSqRelu {
  bf16_t* O;
  template <int NF> __device__ __forceinline__ void operator()(const f32x4 (&acc)[8][NF], int row0, int col0) const {
#pragma unroll
    for (int m = 0; m < 8; ++m)
#pragma unroll
      for (int n = 0; n < NF; ++n) {
        f32x4 v = acc[m][n];
        float a0 = fmaxf(v[0], 0.f), a1 = fmaxf(v[1], 0.f), a2 = fmaxf(v[2], 0.f), a3 = fmaxf(v[3], 0.f);
        uint2 pk; pk.x = cvt_pk_bf16(a0 * a0, a1 * a1); pk.y = cvt_pk_bf16(a2 * a2, a3 * a3);
        *(uint2*)(O + (size_t)(row0 + 16 * m) * DFF + col0 + 16 * n) = pk;
      }
  }
};
struct EpiResid {
  float* X; const float* gate;
  template <int NF> __device__ __forceinline__ void operator()(const f32x4 (&acc)[8][NF], int row0, int col0) const {
    const float* gp = gate + cond_of_row(row0) * 6144;
#pragma unroll
    for (int n = 0; n < NF; ++n) {
      const f32x4 gv = *(const f32x4*)(gp + col0 + 16 * n);
#pragma unroll
      for (int m = 0; m < 8; ++m) {
        float* xp = X + (size_t)(row0 + 16 * m) * D + col0 + 16 * n;
        f32x4 o = *(f32x4*)xp; o += acc[m][n] * gv; *(f32x4*)xp = o;
      }
    }
  }
};
struct EpiGlu {
  float* X; const float* gate; const float* bias;
  template <int NF> __device__ __forceinline__ void operator()(const f32x4 (&acc)[8][NF], int row0, int col0) const {
    const float* gp = gate + cond_of_row(row0) * 6144;
    const int col = (col0 >> 7) * 64 + ((col0 >> 5) & 3) * 16 + (col0 & 15);
    const f32x4 gv = *(const f32x4*)(gp + col);
    const f32x4 ba = *(const f32x4*)(bias + col), bg = *(const f32x4*)(bias + 1024 + col);
#pragma unroll
    for (int m = 0; m < 8; ++m) {
      float* xp = X + (size_t)(row0 + 16 * m) * D + col;
      f32x4 a = acc[m][0] + ba, g = acc[m][1] + bg;
      f32x4 o = *(f32x4*)xp;
#pragma unroll
      for (int i = 0; i < 4; ++i) { float s = 1.f / (1.f + __expf(-g[i])); o[i] += gv[i] * a[i] * s; }
      *(f32x4*)xp = o;
    }
  }
};
struct EpiQkv {
  bf16_t* QK; int nqk; bf16_t* VT; int C; float* newv;
  template <int NF> __device__ __forceinline__ void operator()(const f32x4 (&acc)[8][NF], int row0, int col0) const {
    if (col0 < nqk) {
#pragma unroll
      for (int m = 0; m < 8; ++m)
#pragma unroll
        for (int n = 0; n < NF; ++n) {
          f32x4 v = acc[m][n];
          uint2 pk; pk.x = cvt_pk_bf16(v[0], v[1]); pk.y = cvt_pk_bf16(v[2], v[3]);
          *(uint2*)(QK + (size_t)(row0 + 16 * m) * nqk + col0 + 16 * n) = pk;
        }
    } else {
      const int vc0 = col0 - nqk;
#pragma unroll
      for (int m = 0; m < 8; ++m) {
        const int row = row0 + 16 * m;
        size_t vbase; int ldv;
        if (row < 4096) { vbase = (size_t)(row >> 8) * C * 256 + (row & 255); ldv = 256; }
        else { const int r2 = row - 4096; vbase = (size_t)4096 * C + (size_t)(r2 >> 10) * C * 1024 + (r2 & 1023); ldv = 1024; }
#pragma unroll
        for (int n = 0; n < NF; ++n) {
          const int col = vc0 + 16 * n;
          f32x4 v = acc[m][n];
#pragma unroll
          for (int i = 0; i < 4; ++i) VT[vbase + (size_t)(col + i) * ldv] = f2bf(v[i]);
          if (row < 4096) *(f32x4*)(newv + (size_t)row * C + col) = v;
        }
      }
    }
  }
};

__device__ void conv_job(const Params& p, int job, const float*& src, bf16_t*& dst, int& K, int& N, int& perm) {
  unsigned char* ws = p.ws; perm = 0;
  if (job < 4) { src = p.in[12] + (size_t)job * 1024 * 4096; dst = (bf16_t*)(ws + WS_W1T) + (size_t)job * 4096 * 1024; K = 1024; N = 4096; }
  else if (job < 8) { int l = job - 4; src = p.in[13] + (size_t)l * 4096 * 1024; dst = (bf16_t*)(ws + WS_W2T) + (size_t)l * 1024 * 4096; K = 4096; N = 1024; }
  else if (job < 10) { int s = job - 8; src = p.in[22] + (size_t)s * 1024 * 2048; dst = (bf16_t*)(ws + WS_GLUT) + (size_t)s * 2048 * 1024; K = 1024; N = 2048; perm = 1; }
  else if (job == 10) { src = p.in[24]; dst = (bf16_t*)(ws + WS_NAQKVT); K = 1024; N = 3072; }
  else if (job == 11) { src = p.in[28]; dst = (bf16_t*)(ws + WS_NAOT); K = 1024; N = 1024; }
  else if (job == 12) { src = p.in[29]; dst = (bf16_t*)(ws + WS_GQAQKVT); K = 1024; N = 1536; }
  else if (job == 13) { src = p.in[32]; dst = (bf16_t*)(ws + WS_GQAOT); K = 1024; N = 1024; }
  else if (job < 18) { int b = job - 14; src = p.in[4] + (size_t)b * 512 * 1024; dst = (bf16_t*)(ws + WS_CVTNA) + (size_t)b * 1024 * 512; K = 512; N = 1024; }
  else { int b = job - 18; src = p.in[6] + (size_t)b * 512 * 256; dst = (bf16_t*)(ws + WS_CVTGQA) + (size_t)b * 256 * 512; K = 512; N = 256; }
}

__device__ void do_transposes(const Params& p, int job_lo, int job_hi);
__device__ void phase_prologue(const Params& p) {
  const int tid = opaque_tid(), G = gridDim.x;
  unsigned char* ws = p.ws;
  float* MOD = (float*)(ws + WS_MOD);
  {
    float* sl = (float*)smem;
    float* red = (float*)smem + 5 * 1024;
    bool have = false;
    for (int it = blockIdx.x; it < 192; it += G) {
      if (!have) {
        for (int i = tid; i < 5 * 1024; i += NT) {
          int c = i >> 10, k = i & 1023;
          float v = (c == 0) ? p.in[8][k] : p.in[7][(c - 1) * 1024 + k];
          sl[i] = v / (1.f + __expf(-v));
        }
        have = true;
      }
      __syncthreads();
      const int layer = it / 48, col0 = (it % 48) * 128;
      const int cg4 = tid & 31, ksl = tid >> 5;
      const float* wp = p.in[10] + (size_t)layer * 1024 * 6144 + col0 + cg4 * 4;
      f32x4 a[5];
      for (int c = 0; c < 5; ++c) a[c] = (f32x4){0.f, 0.f, 0.f, 0.f};
#pragma unroll 8
      for (int kk = 0; kk < 64; ++kk) {
        const int k = ksl * 64 + kk;
        const f32x4 w = *(const f32x4*)(wp + (size_t)k * 6144);
        for (int c = 0; c < 5; ++c) a[c] += w * sl[c * 1024 + k];
      }
      for (int c = 0; c < 5; ++c) *(f32x4*)(red + (ksl * 5 + c) * 128 + cg4 * 4) = a[c];
      __syncthreads();
      for (int o = tid; o < 640; o += NT) {
        const int c = o >> 7, col = o & 127;
        float s = p.in[11][layer * 6144 + col0 + col];
        for (int k2 = 0; k2 < 16; ++k2) s += red[(k2 * 5 + c) * 128 + col];
        MOD[(layer * 5 + c) * 6144 + col0 + col] = s;
      }
      __syncthreads();
    }
    __syncthreads();
  }
  {
    float* S5A = (float*)(ws + WS_S5A);
    bf16_t* BB = (bf16_t*)(ws + WS_S5BB);
    bf16_t* CM = (bf16_t*)(ws + WS_S5CM);
    for (int it = (blockIdx.x + 64) % G; it < 256; it += G) {
      const int sdg = it;
      const int g = it & 63;
      const float dt = expf(p.in[16][sdg]);
      for (int idx = tid; idx < 1024; idx += NT) {
        const int pp = idx >> 4, ch = idx & 15;
        const float lr = p.in[14][sdg * 64 + pp], li = p.in[15][sdg * 64 + pp];
        const float ar = lr * dt, ai = li * dt;
        const float mag = expf(ar), cs = cosf(ai), sn = sinf(ai), sh = sinf(0.5f * ai);
        const float abr = mag * cs, abi = mag * sn;
        const float nr = expm1f(ar) * cs - 2.f * sh * sh, ni = abi;
        const float den = lr * lr + li * li;
        const float fre = (nr * lr + ni * li) / den, fim = (ni * lr - nr * li) / den;
        const float br = p.in[17][(sdg * 64 + pp) * 16 + ch], bi = p.in[18][(sdg * 64 + pp) * 16 + ch];
        const float bbr = fre * br - fim * bi, bbi = fre * bi + fim * br;
        BB[((size_t)sdg * 128 + pp) * 16 + ch] = f2bf(bbr);
        BB[((size_t)sdg * 128 + 64 + pp) * 16 + ch] = f2bf(bbi);
        const float cr = p.in[19][(sdg * 16 + ch) * 64 + pp], ci = p.in[20][(sdg * 16 + ch) * 64 + pp];
        const int q = pp & 31, s2 = (pp >> 5) * 2;
        CM[((size_t)sdg * 16 + ch) * 128 + 4 * q + s2] = f2bf(cr);
        CM[((size_t)sdg * 16 + ch) * 128 + 4 * q + s2 + 1] = f2bf(-ci);
        if (ch == 0) { S5A[(sdg * 64 + pp) * 2] = abr; S5A[(sdg * 64 + pp) * 2 + 1] = abi; }
      }
      (void)g;
    }
  }
  {
    const size_t n1 = 4 * 512 * 1024 / 4, n2 = 4 * 512 * 256 / 4;
    uint2* d1 = (uint2*)(ws + WS_CKNA); uint2* d2 = (uint2*)(ws + WS_CKGQA);
    const f32x4* s1 = (const f32x4*)p.in[3]; const f32x4* s2 = (const f32x4*)p.in[5];
    for (size_t i = (size_t)blockIdx.x * NT + tid; i < n1 + n2; i += (size_t)G * NT) {
      f32x4 v = (i < n1) ? s1[i] : s2[i - n1];
      uint2 pk; pk.x = cvt_pk_bf16(v[0], v[1]); pk.y = cvt_pk_bf16(v[2], v[3]);
      if (i < n1) d1[i] = pk; else d2[i - n1] = pk;
    }
  }
  do_transposes(p, 0, 22);
}

__device__ void do_transposes(const Params& p, int job_lo, int job_hi) {
  const int tid = opaque_tid(), G = gridDim.x;
  {
    bf16_t* T = (bf16_t*)smem;
    int base = 0;
    for (int job = job_lo; job < job_hi; ++job) {
      const float* src; bf16_t* dst; int K, N, perm;
      conv_job(p, job, src, dst, K, N, perm);
      const int tn = N >> 8, ntile = (K >> 6) * tn;
      const int start = (int)(((long)blockIdx.x - (base % G) + G) % G);
      const int n4 = tid & 63, kr0 = tid >> 6;
      f32x4 v[8];
      if (start < ntile) {
        const int k0 = (start / tn) << 6, n0 = (start % tn) << 8;
#pragma unroll
        for (int ps = 0; ps < 8; ++ps) v[ps] = *(const f32x4*)(src + (size_t)(k0 + 8 * kr0 + ps) * N + n0 + n4 * 4);
      }
      for (int tile = start; tile < ntile; tile += G) {
        const int k0 = (tile / tn) << 6, n0 = (tile % tn) << 8;
        __syncthreads();
#pragma unroll
        for (int i = 0; i < 4; ++i) {
          uint4 w;
          w.x = cvt_pk_bf16(v[0][i], v[1][i]); w.y = cvt_pk_bf16(v[2][i], v[3][i]);
          w.z = cvt_pk_bf16(v[4][i], v[5][i]); w.w = cvt_pk_bf16(v[6][i], v[7][i]);
          *(uint4*)(T + (n4 * 4 + i) * 72 + 8 * kr0) = w;
        }
        if (tile + G < ntile) {
          const int k1 = ((tile + G) / tn) << 6, n1 = ((tile + G) % tn) << 8;
#pragma unroll
          for (int ps = 0; ps < 8; ++ps) v[ps] = *(const f32x4*)(src + (size_t)(k1 + 8 * kr0 + ps) * N + n1 + n4 * 4);
        }
        __syncthreads();
#pragma unroll
        for (int q = 0; q < 4; ++q) {
          const int n = (tid >> 3) + 64 * q, kc = tid & 7;
          const uint4 o = *(const uint4*)(T + n * 72 + kc * 8);
          int dr = n0 + n;
          if (perm) { const int isg = dr >= 1024, c1 = dr & 1023; dr = (c1 >> 6) * 128 + ((c1 >> 4) & 3) * 32 + (c1 & 15) + isg * 16; }
          *(uint4*)(dst + (size_t)dr * K + k0 + kc * 8) = o;
        }
      }
      base += ntile;
    }
    __syncthreads();
  }
}

__device__ void phase_norm(const Params& p, int layer, int which, bool first) {
  const int tid_ = opaque_tid(); const int lane = tid_ & 63, wave = tid_ >> 6;
  const float* MOD = (const float*)(p.ws + WS_MOD);
  bf16_t* HB = (bf16_t*)(p.ws + WS_HB);
  const float* gw = p.in[9] + (layer * 2 + which) * 1024;
  for (int row0 = (blockIdx.x * 8 + wave) * 4; row0 < NTOK; row0 += gridDim.x * 32) {
    f32x4 v[4][4]; float ss[4];
#pragma unroll
    for (int r = 0; r < 4; ++r) {
      const int row = row0 + r;
      const float* xr = first ? (row < 4096 ? p.in[0] + (size_t)row * D : p.in[1] + (size_t)(row - 4096) * D) : p.out + (size_t)row * D;
#pragma unroll
      for (int i = 0; i < 4; ++i) v[r][i] = *(const f32x4*)(xr + i * 256 + lane * 4);
    }
#pragma unroll
    for (int r = 0; r < 4; ++r) {
      float s = 0.f;
#pragma unroll
      for (int i = 0; i < 4; ++i) s += v[r][i][0] * v[r][i][0] + v[r][i][1] * v[r][i][1] + v[r][i][2] * v[r][i][2] + v[r][i][3] * v[r][i][3];
      ss[r] = s;
    }
#pragma unroll
    for (int o = 32; o > 0; o >>= 1) {
#pragma unroll
      for (int r = 0; r < 4; ++r) ss[r] += __shfl_xor(ss[r], o);
    }
    const float* mp = MOD + (layer * 5 + cond_of_row(row0)) * 6144 + which * 3072;
#pragma unroll
    for (int i = 0; i < 4; ++i) {
      const int col = i * 256 + lane * 4;
      const f32x4 gv = *(const f32x4*)(gw + col), sh = *(const f32x4*)(mp + col), sc = *(const f32x4*)(mp + 1024 + col);
#pragma unroll
      for (int r = 0; r < 4; ++r) {
        const int row = row0 + r;
        const float rstd = rsqrtf(ss[r] * (1.f / 1024.f) + 1e-6f);
        if (first) *(f32x4*)(p.out + (size_t)row * D + col) = v[r][i];
        float o[4];
#pragma unroll
        for (int j = 0; j < 4; ++j) o[j] = v[r][i][j] * rstd * gv[j] * (1.f + sc[j]) + sh[j];
        uint2 pk; pk.x = cvt_pk_bf16(o[0], o[1]); pk.y = cvt_pk_bf16(o[2], o[3]);
        *(uint2*)(HB + (size_t)row * D + col) = pk;
      }
    }
  }
}

__device__ __forceinline__ int s5_tok(int rho) { return 16 * ((rho >> 2) & 1) + (rho & 3) + 4 * (rho >> 3); }
__device__ __forceinline__ cplx shfl_c(cplx v, int src) { cplx r; r.re = __shfl(v.re, src); r.im = __shfl(v.im, src); return r; }

__device__ void phase_s5_pass1(const Params& p, int slot) {
  const int tid_ = opaque_tid(); const int lane = tid_ & 63, wave = tid_ >> 6, r = lane & 31, H = lane >> 5;
  const bf16_t* HB = (const bf16_t*)(p.ws + WS_HB);
  const float* S5A = (const float*)(p.ws + WS_S5A);
  const bf16_t* BB = (const bf16_t*)(p.ws + WS_S5BB);
  float* E = (float*)(p.ws + WS_S5E);
  const int tokr = s5_tok(r);
  for (int it = blockIdx.x * 8 + wave; it < 128 * 64; it += gridDim.x * 8) {
    const int ck = it >> 6, g = it & 63, tok0 = ck * 64;
    bf16x8 uf[2];
    _Pragma("unroll") for (int tt = 0; tt < 2; ++tt) uf[tt] = *(const bf16x8*)(HB + (size_t)(tok0 + 32 * tt + tokr) * D + g * 16 + 8 * H);
    _Pragma("unroll") for (int dir = 0; dir < 2; ++dir) {
      const int sdg = (slot * 2 + dir) * 64 + g;
      cplx a0 = {S5A[(sdg * 64 + r) * 2], S5A[(sdg * 64 + r) * 2 + 1]};
      cplx a1 = {S5A[(sdg * 64 + r + 32) * 2], S5A[(sdg * 64 + r + 32) * 2 + 1]};
      cplx a0_16 = a0, a1_16 = a1;
      _Pragma("unroll") for (int i = 0; i < 4; ++i) { a0_16 = cmul(a0_16, a0_16); a1_16 = cmul(a1_16, a1_16); }
      const cplx a0_32 = cmul(a0_16, a0_16), a1_32 = cmul(a1_16, a1_16);
      bf16x8 bfr[4];
      _Pragma("unroll") for (int ct = 0; ct < 4; ++ct) bfr[ct] = *(const bf16x8*)(BB + ((size_t)sdg * 128 + 32 * ct + r) * 16 + 8 * H);
      cplx E0 = {0.f, 0.f}, E1 = {0.f, 0.f};
      _Pragma("unroll") for (int t2 = 0; t2 < 2; ++t2) {
        const int tt = dir ? 1 - t2 : t2;
        f32x16 acc[4];
        bu_mfma4(acc[0], acc[1], acc[2], acc[3], uf[tt], bfr[0], bfr[1], bfr[2], bfr[3]);
        cplx e0 = {0.f, 0.f}, e1 = {0.f, 0.f};
        if (dir == 0) {
          _Pragma("unroll") for (int i = 0; i < 16; ++i) { e0 = cfma(a0, e0, (cplx){acc[0][i], acc[2][i]}); e1 = cfma(a1, e1, (cplx){acc[1][i], acc[3][i]}); }
        } else {
          _Pragma("unroll") for (int i = 15; i >= 0; --i) { e0 = cfma(a0, e0, (cplx){acc[0][i], acc[2][i]}); e1 = cfma(a1, e1, (cplx){acc[1][i], acc[3][i]}); }
        }
        const cplx o0 = shfl_c(e0, lane ^ 32), o1 = shfl_c(e1, lane ^ 32);
        const cplx eL0 = H ? o0 : e0, eU0 = H ? e0 : o0, eL1 = H ? o1 : e1, eU1 = H ? e1 : o1;
        cplx t0, t1;
        if (dir == 0) { t0 = cfma(a0_16, eL0, eU0); t1 = cfma(a1_16, eL1, eU1); }
        else { t0 = cfma(a0_16, eU0, eL0); t1 = cfma(a1_16, eU1, eL1); }
        E0 = cfma(a0_32, E0, t0); E1 = cfma(a1_32, E1, t1);
      }
      const int pp = H ? r + 32 : r;
      const cplx Ev = H ? E1 : E0;
      *(float2*)(E + ((size_t)((ck * 64 + g) * 2 + dir) * 64 + pp) * 2) = make_float2(Ev.re, Ev.im);
    }
  }
}

__device__ void phase_s5_pass2(const Params& p, int slot) {
  const int tid_ = opaque_tid(); const int lane = tid_ & 63, wave = tid_ >> 6, r = lane & 31, H = lane >> 5;
  bf16_t* HB = (bf16_t*)(p.ws + WS_HB);
  const float* S5A = (const float*)(p.ws + WS_S5A);
  const bf16_t* BB = (const bf16_t*)(p.ws + WS_S5BB);
  const bf16_t* CM = (const bf16_t*)(p.ws + WS_S5CM);
  const float* E = (const float*)(p.ws + WS_S5E);
  const float* Dsk = p.in[21] + slot * 1024;
  unsigned char* ldsw = smem + wave * 8704;
  const int tokr = s5_tok(r);
  for (int it = blockIdx.x * 8 + wave; it < 128 * 64; it += gridDim.x * 8) {
    const int ck = it >> 6, g = it & 63, tok0 = ck * 64;
    int c, nc, bq; bool sample;
    if (tok0 < 4096) { bq = tok0 >> 8; c = (tok0 >> 6) & 3; nc = 4; sample = false; }
    else { const int t2 = tok0 - 4096; bq = t2 >> 10; c = (t2 >> 6) & 15; nc = 16; sample = true; }
    const int ck0 = ck - c;
    bf16x8 uf[2];
    _Pragma("unroll") for (int tt = 0; tt < 2; ++tt) uf[tt] = *(const bf16x8*)(HB + (size_t)(tok0 + 32 * tt + tokr) * D + g * 16 + 8 * H);
    f32x4 yacc[2][2];
    _Pragma("unroll") for (int a = 0; a < 2; ++a) _Pragma("unroll") for (int b = 0; b < 2; ++b) yacc[a][b] = (f32x4){0.f, 0.f, 0.f, 0.f};
    _Pragma("unroll") for (int dir = 0; dir < 2; ++dir) {
      const int sdg = (slot * 2 + dir) * 64 + g;
      const cplx a0 = {S5A[(sdg * 64 + r) * 2], S5A[(sdg * 64 + r) * 2 + 1]};
      const cplx a1 = {S5A[(sdg * 64 + r + 32) * 2], S5A[(sdg * 64 + r + 32) * 2 + 1]};
      cplx a0_64 = a0, a1_64 = a1;
      _Pragma("unroll") for (int i = 0; i < 6; ++i) { a0_64 = cmul(a0_64, a0_64); a1_64 = cmul(a1_64, a1_64); }
      cplx c0 = {0.f, 0.f}, c1 = {0.f, 0.f};
      if (sample) {
        const float* h0 = p.in[2] + ((size_t)((bq * 2 + slot) * 2 + dir) * 2) * 4096 + g * 64;
        c0.re = h0[r]; c0.im = h0[4096 + r]; c1.re = h0[r + 32]; c1.im = h0[4096 + r + 32];
      }
      {
        const int ncar = dir ? nc - 1 - c : c;
        for (int j0 = 0; j0 < ncar; j0 += 8) {
          float2 va[8], vb[8];
#pragma unroll
          for (int j = 0; j < 8; ++j) {
            const int jj = min(j0 + j, ncar - 1);
            const int cc = dir ? nc - 1 - jj : jj;
            const float* ep = E + ((size_t)(((ck0 + cc) * 64 + g) * 2 + dir) * 64) * 2;
            va[j] = *(const float2*)(ep + r * 2); vb[j] = *(const float2*)(ep + (r + 32) * 2);
          }
#pragma unroll
          for (int j = 0; j < 8; ++j) if (j0 + j < ncar) {
            c0 = cfma(a0_64, c0, (cplx){va[j].x, va[j].y}); c1 = cfma(a1_64, c1, (cplx){vb[j].x, vb[j].y});
          }
        }
      }
      bf16x8 bfr[4], cfr[4];
      _Pragma("unroll") for (int ct = 0; ct < 4; ++ct) bfr[ct] = *(const bf16x8*)(BB + ((size_t)sdg * 128 + 32 * ct + r) * 16 + 8 * H);
      _Pragma("unroll") for (int ks = 0; ks < 4; ++ks) cfr[ks] = *(const bf16x8*)(CM + ((size_t)sdg * 16 + (lane & 15)) * 128 + 32 * ks + 8 * (lane >> 4));
      _Pragma("unroll") for (int t2 = 0; t2 < 2; ++t2) {
        const int tt = dir ? 1 - t2 : t2;
        f32x16 acc[4];
        bu_mfma4(acc[0], acc[1], acc[2], acc[3], uf[tt], bfr[0], bfr[1], bfr[2], bfr[3]);
        const int firstH = dir;
        cplx h0 = c0, h1 = c1;
        if (H == firstH) {
          if (dir == 0) { _Pragma("unroll") for (int i = 0; i < 16; ++i) { h0 = cfma(a0, h0, (cplx){acc[0][i], acc[2][i]}); h1 = cfma(a1, h1, (cplx){acc[1][i], acc[3][i]});
                            acc[0][i] = h0.re; acc[2][i] = h0.im; acc[1][i] = h1.re; acc[3][i] = h1.im; } }
          else { _Pragma("unroll") for (int i = 15; i >= 0; --i) { h0 = cfma(a0, h0, (cplx){acc[0][i], acc[2][i]}); h1 = cfma(a1, h1, (cplx){acc[1][i], acc[3][i]});
                            acc[0][i] = h0.re; acc[2][i] = h0.im; acc[1][i] = h1.re; acc[3][i] = h1.im; } }
        }
        h0 = shfl_c(h0, r + 32 * firstH); h1 = shfl_c(h1, r + 32 * firstH);
        if (H != firstH) {
          if (dir == 0) { _Pragma("unroll") for (int i = 0; i < 16; ++i) { h0 = cfma(a0, h0, (cplx){acc[0][i], acc[2][i]}); h1 = cfma(a1, h1, (cplx){acc[1][i], acc[3][i]});
                            acc[0][i] = h0.re; acc[2][i] = h0.im; acc[1][i] = h1.re; acc[3][i] = h1.im; } }
          else { _Pragma("unroll") for (int i = 15; i >= 0; --i) { h0 = cfma(a0, h0, (cplx){acc[0][i], acc[2][i]}); h1 = cfma(a1, h1, (cplx){acc[1][i], acc[3][i]});
                            acc[0][i] = h0.re; acc[2][i] = h0.im; acc[1][i] = h1.re; acc[3][i] = h1.im; } }
        }
        if (!sample && t2 == 1 && ((dir == 0 && c == nc - 1) || (dir == 1 && c == 0)) && H != firstH) {
          float* so = p.out + OUT_S5 + ((size_t)((bq * 2 + slot) * 2 + dir) * 2) * 4096 + g * 64;
          so[r] = h0.re; so[4096 + r] = h0.im; so[r + 32] = h1.re; so[4096 + r + 32] = h1.im;
        }
        c0 = shfl_c(h0, r + 32 * (1 - firstH)); c1 = shfl_c(h1, r + 32 * (1 - firstH));
        _Pragma("unroll") for (int i = 0; i < 16; ++i) {
          uint2 pk; pk.x = cvt_pk_bf16(acc[0][i], acc[2][i]); pk.y = cvt_pk_bf16(acc[1][i], acc[3][i]);
          *(uint2*)(ldsw + (16 * H + i) * 272 + 8 * r) = pk;
        }
        asm volatile("s_waitcnt lgkmcnt(0)" ::: "memory");
        _Pragma("unroll") for (int rt = 0; rt < 2; ++rt) _Pragma("unroll") for (int ks = 0; ks < 4; ++ks) {
          const bf16x8 af = *(const bf16x8*)(ldsw + (16 * rt + (lane & 15)) * 272 + (32 * ks + 8 * (lane >> 4)) * 2);
          yacc[tt][rt] = __builtin_amdgcn_mfma_f32_16x16x32_bf16(af, cfr[ks], yacc[tt][rt], 0, 0, 0);
        }
        asm volatile("s_waitcnt lgkmcnt(0)" ::: "memory");
      }
    }
    asm volatile("s_nop 15" : "+v"(yacc[0][0]), "+v"(yacc[0][1]), "+v"(yacc[1][0]), "+v"(yacc[1][1]));
    const int ch = lane & 15, col = g * 16 + ch;
    const float dsk = Dsk[col];
    _Pragma("unroll") for (int tt = 0; tt < 2; ++tt) _Pragma("unroll") for (int rt = 0; rt < 2; ++rt) _Pragma("unroll") for (int j = 0; j < 4; ++j) {
      const int token = tok0 + 32 * tt + 16 * rt + 4 * (lane >> 4) + j;
      bf16_t* hp = HB + (size_t)token * D + col;
      const float u = bf2f(*hp);
      const float y = yacc[tt][rt][j] + u * dsk;
      const float z = 0.7978845608028654f * (y + 0.044715f * y * y * y);
      const float th = 1.f - 2.f / (__expf(2.f * z) + 1.f);
      *hp = f2bf(0.5f * y * (1.f + th));
    }
  }
}

constexpr float LOG2E = 1.4426950408889634f;

__device__ void phase_post_na(const Params& p) {
  const int tid_ = opaque_tid(); const int lane = tid_ & 63, wave = tid_ >> 6;
  bf16_t* QK = (bf16_t*)(p.ws + WS_QK);
  const float* qn = p.in[25]; const float* kn = p.in[26];
  const float qs = 0.125f * LOG2E;
  const int d0 = (lane & 3) * 16;
  for (int row = blockIdx.x * 8 + wave; row < NTOK; row += gridDim.x * 8) {
    _Pragma("unroll") for (int part = 0; part < 2; ++part) {
      bf16_t* ptr = QK + (size_t)row * 2048 + part * 1024 + lane * 16;
      uint4 a = *(uint4*)ptr, b = *(uint4*)(ptr + 8);
      unsigned w[8] = {a.x, a.y, a.z, a.w, b.x, b.y, b.z, b.w};
      float v[16]; float ss = 0.f;
      _Pragma("unroll") for (int i = 0; i < 8; ++i) { v[2 * i] = bflo(w[i]); v[2 * i + 1] = bfhi(w[i]); }
      _Pragma("unroll") for (int i = 0; i < 16; ++i) ss += v[i] * v[i];
      ss += __shfl_xor(ss, 1); ss += __shfl_xor(ss, 2);
      const float rstd = rsqrtf(ss * (1.f / 64.f) + 1e-6f);
      const float* nw = part ? kn : qn;
      const float sc = part ? 1.f : qs;
      float o[16];
      _Pragma("unroll") for (int i = 0; i < 16; ++i) o[i] = v[i] * rstd * nw[d0 + i];
      if (part == 1 && row < 4096) {
        float* op = p.out + OUT_NAK + (size_t)row * 1024 + lane * 16;
        _Pragma("unroll") for (int i = 0; i < 4; ++i) *(f32x4*)(op + 4 * i) = (f32x4){o[4 * i], o[4 * i + 1], o[4 * i + 2], o[4 * i + 3]};
      }
      _Pragma("unroll") for (int i = 0; i < 8; ++i) w[i] = cvt_pk_bf16(o[2 * i] * sc, o[2 * i + 1] * sc);
      *(uint4*)ptr = make_uint4(w[0], w[1], w[2], w[3]); *(uint4*)(ptr + 8) = make_uint4(w[4], w[5], w[6], w[7]);
    }
  }
}

__device__ void phase_post_gqa(const Params& p) {
  const int tid_ = opaque_tid(); const int lane = tid_ & 63, wave = tid_ >> 6;
  bf16_t* QK = (bf16_t*)(p.ws + WS_QK);
  const float* qn = p.in[30]; const float* kn = p.in[31];
  const float qs = 0.08838834764831845f * LOG2E;
  for (int row = blockIdx.x * 8 + wave; row < NTOK; row += gridDim.x * 8) {
    const bool sample = row >= 4096;
    const int t = (row - 4096) & 1023;
    const float prow = (float)(t >> 6), pcol = (float)(t & 63);
    {
      const int i0 = (lane & 7) * 8;
      bf16_t* ptr = QK + (size_t)row * 1280 + (lane >> 3) * 128 + i0;
      uint4 a = *(uint4*)ptr, b = *(uint4*)(ptr + 64);
      unsigned wa[4] = {a.x, a.y, a.z, a.w}, wb[4] = {b.x, b.y, b.z, b.w};
      float x1[8], x2[8]; float ss = 0.f;
      _Pragma("unroll") for (int i = 0; i < 4; ++i) { x1[2 * i] = bflo(wa[i]); x1[2 * i + 1] = bfhi(wa[i]); x2[2 * i] = bflo(wb[i]); x2[2 * i + 1] = bfhi(wb[i]); }
      _Pragma("unroll") for (int i = 0; i < 8; ++i) ss += x1[i] * x1[i] + x2[i] * x2[i];
      ss += __shfl_xor(ss, 1); ss += __shfl_xor(ss, 2); ss += __shfl_xor(ss, 4);
      const float rstd = rsqrtf(ss * (1.f / 128.f) + 1e-6f);
      _Pragma("unroll") for (int i = 0; i < 8; ++i) { x1[i] *= rstd * qn[i0 + i]; x2[i] *= rstd * qn[64 + i0 + i]; }
      if (sample) {
        _Pragma("unroll") for (int i = 0; i < 8; ++i) {
          const int pi = i0 + i;
          const float inv = exp2f(-(float)(pi & 31) * (13.287712379549449f / 32.f));
          const float ang = (pi < 32 ? prow : pcol) * inv;
          const float cs = cosf(ang), sn = sinf(ang);
          const float y1 = x1[i] * cs - x2[i] * sn, y2 = x1[i] * sn + x2[i] * cs;
          x1[i] = y1; x2[i] = y2;
        }
      }
      _Pragma("unroll") for (int i = 0; i < 4; ++i) { wa[i] = cvt_pk_bf16(x1[2 * i] * qs, x1[2 * i + 1] * qs); wb[i] = cvt_pk_bf16(x2[2 * i] * qs, x2[2 * i + 1] * qs); }
      *(uint4*)ptr = make_uint4(wa[0], wa[1], wa[2], wa[3]); *(uint4*)(ptr + 64) = make_uint4(wb[0], wb[1], wb[2], wb[3]);
    }
    {
      const int i0 = (lane & 31) * 2;
      bf16_t* ptr = QK + (size_t)row * 1280 + 1024 + (lane >> 5) * 128 + i0;
      unsigned wa = *(unsigned*)ptr, wb = *(unsigned*)(ptr + 64);
      float x1[2] = {bflo(wa), bfhi(wa)}, x2[2] = {bflo(wb), bfhi(wb)};
      float ss = x1[0] * x1[0] + x1[1] * x1[1] + x2[0] * x2[0] + x2[1] * x2[1];
      _Pragma("unroll") for (int o = 1; o < 32; o <<= 1) ss += __shfl_xor(ss, o);
      const float rstd = rsqrtf(ss * (1.f / 128.f) + 1e-6f);
      _Pragma("unroll") for (int i = 0; i < 2; ++i) { x1[i] *= rstd * kn[i0 + i]; x2[i] *= rstd * kn[64 + i0 + i]; }
      if (!sample) {
        float* op = p.out + OUT_GQAK + (size_t)row * 256 + (lane >> 5) * 128 + i0;
        *(float2*)op = make_float2(x1[0], x1[1]); *(float2*)(op + 64) = make_float2(x2[0], x2[1]);
      } else {
        _Pragma("unroll") for (int i = 0; i < 2; ++i) {
          const int pi = i0 + i;
          const float inv = exp2f(-(float)(pi & 31) * (13.287712379549449f / 32.f));
          const float ang = (pi < 32 ? prow : pcol) * inv;
          const float cs = cosf(ang), sn = sinf(ang);
          const float y1 = x1[i] * cs - x2[i] * sn, y2 = x1[i] * sn + x2[i] * cs;
          x1[i] = y1; x2[i] = y2;
        }
      }
      *(unsigned*)ptr = cvt_pk_bf16(x1[0], x1[1]); *(unsigned*)(ptr + 64) = cvt_pk_bf16(x2[0], x2[1]);
    }
  }
}

template <int DH, bool NAL>
__device__ __forceinline__ void attn_wave(const bf16_t* Q, int ldq,
                                          const bf16_t* K0, int ldk0, const bf16_t* V0, int ldv0, int n0,
                                          const bf16_t* K1, int ldk1, const bf16_t* V1, int ldv1, int n1,
                                          bf16_t* O, int ldo, const float* rpb_h, int rr, int rs, int qc0) {
  constexpr int KS = DH / 32, DT = DH / 16;
  const int lane = opaque_tid() & 63, fr = lane & 15, g = lane >> 4;
  bf16x8 qf[2][KS];
  _Pragma("unroll") for (int qg = 0; qg < 2; ++qg) _Pragma("unroll") for (int ks = 0; ks < KS; ++ks) qf[qg][ks] = *(const bf16x8*)(Q + (size_t)(qg * 16 + fr) * ldq + ks * 32 + 8 * g);
  f32x4 o[2][DT];
  _Pragma("unroll") for (int qg = 0; qg < 2; ++qg) _Pragma("unroll") for (int dt = 0; dt < DT; ++dt) o[qg][dt] = (f32x4){0.f, 0.f, 0.f, 0.f};
  float lsum[2] = {0.f, 0.f};
  const int krow_in = 8 * (fr >> 2) + (fr & 3);
  const int nch = (n0 + n1) >> 5;
  for (int c = 0; c < nch; ++c) {
    const bool s1 = (c * 32 >= n0);
    const int kc = s1 ? c * 32 - n0 : c * 32;
    const bf16_t* K = s1 ? K1 : K0; const int ldk = s1 ? ldk1 : ldk0;
    const bf16_t* V = s1 ? V1 : V0; const int ldv = s1 ? ldv1 : ldv0;
    bf16x8 kf[2][KS], vf[DT];
    _Pragma("unroll") for (int t = 0; t < 2; ++t) _Pragma("unroll") for (int ks = 0; ks < KS; ++ks) kf[t][ks] = *(const bf16x8*)(K + (size_t)(kc + krow_in + 4 * t) * ldk + ks * 32 + 8 * g);
    _Pragma("unroll") for (int dt = 0; dt < DT; ++dt) vf[dt] = *(const bf16x8*)(V + (size_t)(16 * dt + fr) * ldv + kc + 8 * g);
    f32x4 s[2][2];
    _Pragma("unroll") for (int qg = 0; qg < 2; ++qg) _Pragma("unroll") for (int t = 0; t < 2; ++t) {
      s[qg][t] = (f32x4){0.f, 0.f, 0.f, 0.f};
      _Pragma("unroll") for (int ks = 0; ks < KS; ++ks) s[qg][t] = __builtin_amdgcn_mfma_f32_16x16x32_bf16(kf[t][ks], qf[qg][ks], s[qg][t], 0, 0, 0);
    }
    asm volatile("s_nop 15" : "+v"(s[0][0]), "+v"(s[0][1]), "+v"(s[1][0]), "+v"(s[1][1]));
    bf16x8 pf[2];
    _Pragma("unroll") for (int qg = 0; qg < 2; ++qg) {
      float pv[8];
      _Pragma("unroll") for (int i = 0; i < 8; ++i) {
        float sv = s[qg][i >> 2][i & 3];
        if (NAL && !s1) {
          const int krow = rs + (kc >> 6), kcol = (kc & 63) + 8 * g + i;
          const int qc = qc0 + qg * 16 + fr;
          const int cs = min(max(qc - 8, 0), 48);
          const bool valid = (kcol >= cs) && (kcol < cs + 16);
          const int bi = valid ? (krow - rr + 7) * 31 + (kcol - qc + 15) : 0;
          const float bias = rpb_h[bi];
          pv[i] = valid ? __builtin_amdgcn_exp2f(sv + bias * LOG2E) : 0.f;
        } else {
          pv[i] = __builtin_amdgcn_exp2f(sv);
        }
        lsum[qg] += pv[i];
      }
      union { bf16x8 v; unsigned u[4]; } pk;
      _Pragma("unroll") for (int i = 0; i < 4; ++i) pk.u[i] = cvt_pk_bf16(pv[2 * i], pv[2 * i + 1]);
      pf[qg] = pk.v;
    }
    asm volatile("s_nop 3" : "+v"(pf[0]), "+v"(pf[1]));
    _Pragma("unroll") for (int qg = 0; qg < 2; ++qg) _Pragma("unroll") for (int dt = 0; dt < DT; ++dt)
      o[qg][dt] = __builtin_amdgcn_mfma_f32_16x16x32_bf16(vf[dt], pf[qg], o[qg][dt], 0, 0, 0);
  }
  _Pragma("unroll") for (int qg = 0; qg < 2; ++qg) _Pragma("unroll") for (int dt = 0; dt < DT; ++dt) asm volatile("s_nop 7" : "+v"(o[qg][dt]));
  _Pragma("unroll") for (int qg = 0; qg < 2; ++qg) {
    float l = lsum[qg];
    l += __shfl_xor(l, 16); l += __shfl_xor(l, 32);
    const float inv = 1.f / l;
    _Pragma("unroll") for (int dt = 0; dt < DT; ++dt) {
      uint2 pk; pk.x = cvt_pk_bf16(o[qg][dt][0] * inv, o[qg][dt][1] * inv); pk.y = cvt_pk_bf16(o[qg][dt][2] * inv, o[qg][dt][3] * inv);
      *(uint2*)(O + (size_t)(qg * 16 + fr) * ldo + 16 * dt + 4 * g) = pk;
    }
  }
}

__device__ void phase_attn_na(const Params& p) {
  const int wave = opaque_tid() >> 6;
  const bf16_t* QK = (const bf16_t*)(p.ws + WS_QK);
  const bf16_t* VT = (const bf16_t*)(p.ws + WS_VT);
  const bf16_t* CK = (const bf16_t*)(p.ws + WS_CKNA);
  const bf16_t* CVT = (const bf16_t*)(p.ws + WS_CVTNA);
  bf16_t* AO = (bf16_t*)(p.ws + WS_AO);
  for (int gw = blockIdx.x * 8 + wave; gw < 4096; gw += gridDim.x * 8) {
    if (gw < 2048) {
      const int wq = gw & 1, r = (gw >> 1) & 15, h = (gw >> 5) & 15, b = gw >> 9;
      const int rs = min(max(r - 4, 0), 8);
      const int tokq = 4096 + b * 1024 + r * 64 + wq * 32;
      const int tokk = 4096 + b * 1024 + rs * 64;
      attn_wave<64, true>(QK + (size_t)tokq * 2048 + h * 64, 2048,
                          QK + (size_t)tokk * 2048 + 1024 + h * 64, 2048,
                          VT + (size_t)4096 * 1024 + ((size_t)b * 1024 + h * 64) * 1024 + rs * 64, 1024, 512,
                          CK + (size_t)b * 512 * 1024 + h * 64, 1024,
                          CVT + ((size_t)b * 1024 + h * 64) * 512, 512, 512,
                          AO + (size_t)tokq * 1024 + h * 64, 1024,
                          p.in[27] + h * 15 * 31, r, rs, wq * 32);
    } else {
      const int id = gw - 2048, qb = id & 7, h = (id >> 3) & 15, b = id >> 7;
      const int tokq = b * 256 + qb * 32;
      attn_wave<64, false>(QK + (size_t)tokq * 2048 + h * 64, 2048,
                           QK + (size_t)(b * 256) * 2048 + 1024 + h * 64, 2048,
                           VT + ((size_t)b * 1024 + h * 64) * 256, 256, 256,
                           nullptr, 0, nullptr, 0, 0,
                           AO + (size_t)tokq * 1024 + h * 64, 1024, nullptr, 0, 0, 0);
    }
  }
}

__device__ void phase_attn_gqa(const Params& p) {
  const int wave = opaque_tid() >> 6;
  const bf16_t* QK = (const bf16_t*)(p.ws + WS_QK);
  const bf16_t* VT = (const bf16_t*)(p.ws + WS_VT);
  const bf16_t* CK = (const bf16_t*)(p.ws + WS_CKGQA);
  const bf16_t* CVT = (const bf16_t*)(p.ws + WS_CVTGQA);
  bf16_t* AO = (bf16_t*)(p.ws + WS_AO);
  const int nb4 = (int)gridDim.x * 4;
  if (wave < 4) {
    for (int id = blockIdx.x * 4 + wave; id < 1024; id += nb4) {
      const int qb = id & 31, hq = (id >> 5) & 7, b = id >> 8, hk = hq >> 2;
      const int tokq = 4096 + b * 1024 + qb * 32;
      attn_wave<128, false>(QK + (size_t)tokq * 1280 + hq * 128, 1280,
                            QK + (size_t)(4096 + b * 1024) * 1280 + 1024 + hk * 128, 1280,
                            VT + (size_t)4096 * 256 + ((size_t)b * 256 + hk * 128) * 1024, 1024, 1024,
                            CK + (size_t)b * 512 * 256 + hk * 128, 256,
                            CVT + ((size_t)b * 256 + hk * 128) * 512, 512, 512,
                            AO + (size_t)tokq * 1024 + hq * 128, 1024, nullptr, 0, 0, 0);
    }
  } else {
    for (int id = blockIdx.x * 4 + (wave - 4); id < 1024; id += nb4) {
      const int qb = id & 7, hq = (id >> 3) & 7, b = id >> 6, hk = hq >> 2;
      const int tokq = b * 256 + qb * 32;
      attn_wave<128, false>(QK + (size_t)tokq * 1280 + hq * 128, 1280,
                            QK + (size_t)(b * 256) * 1280 + 1024 + hk * 128, 1280,
                            VT + ((size_t)b * 256 + hk * 128) * 256, 256, 256,
                            nullptr, 0, nullptr, 0, 0,
                            AO + (size_t)tokq * 1024 + hq * 128, 1024, nullptr, 0, 0, 0);
    }
  }
}

#define XB_TMO      128
#define XB_XCNT(j)  (256  + 64 * (j))
#define XB_XSUB(j)  (1280 + 64 * (j))
#define XB_XGEN(j)  (2304 + 64 * (j))
#define XB_TOP      3328
#define XB_TOPGEN   3392
#define XCD_BAR_WORDS 3456
#define XB_SPIN_CAP (1u << 18)
#define LAS __attribute__((address_space(3)))

__device__ __forceinline__ unsigned xb_ld(unsigned* p)              { return __hip_atomic_load(p, __ATOMIC_RELAXED, __HIP_MEMORY_SCOPE_AGENT); }
__device__ __forceinline__ unsigned xb_add(unsigned* p, unsigned v) { return __hip_atomic_fetch_add(p, v, __ATOMIC_RELAXED, __HIP_MEMORY_SCOPE_AGENT); }
__device__ __forceinline__ unsigned xb_xcc_id() { return (unsigned)__builtin_amdgcn_s_getreg((3 << 11) | 20) & 0xFu; }
#define XB_SPIN(cond, bar) do { unsigned _sp = 0; while (cond) { __builtin_amdgcn_s_sleep(1); \
    if ((++_sp & 255u) == 0u) { if (xb_ld(&(bar)[XB_TMO])) break; if (_sp > XB_SPIN_CAP) { atomicAdd(&(bar)[XB_TMO], 1u); break; } } } } while (0)

struct XcdBarrier {
    unsigned* bar; unsigned x;
    volatile LAS unsigned* st;
};

__device__ __forceinline__ XcdBarrier xcd_barrier_post(unsigned* bar, volatile LAS unsigned* st) {
    XcdBarrier b; b.bar = bar; b.x = xb_xcc_id(); b.st = st;
    if (threadIdx.x == 0) (void)xb_add(&bar[XB_XCNT(b.x)], 1u);
    return b;
}
__device__ __forceinline__ void xcd_barrier_complete(unsigned* bar, unsigned x, unsigned& nloc, unsigned& nx) {
    const unsigned G = gridDim.x * gridDim.y * gridDim.z;
    unsigned sum, cnt, mine, sp = 0u;
    for (;;) {
        sum = 0u; cnt = 0u; mine = 0u;
#pragma unroll
        for (unsigned j = 0; j < 16; ++j) { const unsigned c = xb_ld(&bar[XB_XCNT(j)]); sum += c; cnt += (c > 0u) ? 1u : 0u; mine = (j == x) ? c : mine; }
        if (sum == G) break;
        __builtin_amdgcn_s_sleep(1);
        if ((++sp & 255u) == 0u) { if (xb_ld(&bar[XB_TMO])) break; if (sp > XB_SPIN_CAP) { atomicAdd(&bar[XB_TMO], 1u); break; } }
    }
    nloc = mine > 0u ? mine : 1u; nx = cnt > 0u ? cnt : 1u;
}

__device__ __forceinline__ void xcd_barrier(const XcdBarrier& b) {
    asm volatile("s_waitcnt vmcnt(0)" ::: "memory");
    __syncthreads();
    if (threadIdx.x == 0) {
        unsigned* bar = b.bar; unsigned xb_probe = 0u;
        __builtin_amdgcn_s_waitcnt(0);
        unsigned nloc = b.st[0], nx = b.st[1];
        if (nloc == 0u) { xcd_barrier_complete(bar, b.x, nloc, nx); b.st[0] = nloc; b.st[1] = nx; }
        const unsigned old = xb_add(&bar[XB_XSUB(b.x)], 1u);
        const unsigned gen = old / nloc;
        if (old + 1u == (gen + 1u) * nloc) {
            __builtin_amdgcn_fence(__ATOMIC_RELEASE, "agent");
            asm volatile("s_waitcnt vmcnt(0)" ::: "memory");
            const unsigned og = xb_add(&bar[XB_TOP], 1u);
            const unsigned tg = og / nx;
            if (og + 1u == (tg + 1u) * nx) xb_add(&bar[XB_TOPGEN], 1u);
            else XB_SPIN(xb_ld(&bar[XB_TOPGEN]) == tg, bar);
            __builtin_amdgcn_fence(__ATOMIC_ACQUIRE, "agent"); xb_probe = xb_ld(&bar[XB_TMO]);
            xb_add(&bar[XB_XGEN(b.x)], 1u);
            asm volatile("s_waitcnt vmcnt(0)" ::: "memory");
        } else {
            XB_SPIN(xb_ld(&bar[XB_XGEN(b.x)]) == gen, bar);
            __builtin_amdgcn_fence(__ATOMIC_ACQUIRE, "agent"); xb_probe = xb_ld(&bar[XB_TMO]);
            asm volatile("s_waitcnt vmcnt(0)" ::: "memory");
        }
        asm volatile("" :: "v"(xb_probe));
        __builtin_amdgcn_s_sleep(80);
    }
    __syncthreads();
}


__device__ void phase_fake_mlp1(const Params& p) {
  const int tid = opaque_tid();
  const uint4* HB = (const uint4*)(p.ws + WS_HB);
  uint4* ACT = (uint4*)(p.ws + WS_ACT);
  for (size_t i = (size_t)blockIdx.x * NT + tid; i < (size_t)NTOK * DFF / 8; i += (size_t)gridDim.x * NT) {
    const size_t row = i >> 9, c8 = i & 511;
    uint4 v = HB[row * 128 + (c8 & 127)];
    unsigned w[4] = {v.x, v.y, v.z, v.w};
    for (int j = 0; j < 4; ++j) { float a = bflo(w[j]), b = bfhi(w[j]); w[j] = cvt_pk_bf16(a * a, b * b); }
    ACT[i] = make_uint4(w[0], w[1], w[2], w[3]);
  }
}
__global__ void __launch_bounds__(NT) fwd_megakernel(Params p) {
  cg::grid_group grid = cg::this_grid();
  unsigned char* ws = p.ws;
  const float* MOD = (const float*)(ws + WS_MOD);
  bf16_t* HB = (bf16_t*)(ws + WS_HB);
  bf16_t* AO = (bf16_t*)(ws + WS_AO);
  bf16_t* QK = (bf16_t*)(ws + WS_QK);
  bf16_t* VT = (bf16_t*)(ws + WS_VT);
  bf16_t* ACT = (bf16_t*)(ws + WS_ACT);
  int ph = 0;
#ifdef CHK_INPUT
  { float* chk = (float*)(ws + WS_END);
    const int t = opaque_tid();
    const float* sp = p.in[CHK_INPUT];
    const size_t per = (size_t)CHK_COUNT / gridDim.x;
    float s = 0.f;
    for (size_t i = t; i < per; i += NT) { float v = sp[(size_t)blockIdx.x * per + i]; s += v * (1.f + (float)(i & 15)); }
    float* red = (float*)smem; red[t] = s; __syncthreads();
    if (t == 0) { float a = 0.f; for (int i = 0; i < NT; ++i) a += red[i]; chk[blockIdx.x] = a; }
    __syncthreads(); }
#endif
#ifdef START_DELAY_TICKS
  { const unsigned long long t0 = __builtin_amdgcn_s_memrealtime(); while (__builtin_amdgcn_s_memrealtime() - t0 < START_DELAY_TICKS) __builtin_amdgcn_s_sleep(8); }
#endif
  volatile LAS unsigned* xb_st = (volatile LAS unsigned*)(smem + 131072);
  if (threadIdx.x < 2) xb_st[threadIdx.x] = 0u;
  __syncthreads();
  XcdBarrier xbar = xcd_barrier_post((unsigned*)(ws + WS_BAR), xb_st);
  if (p.ph_hi - p.ph_lo > 1) grid.sync();
#ifdef EXTRA_SYNCS
  for (int i_ = 0; i_ < EXTRA_SYNCS; ++i_) grid.sync();
#endif
#ifndef EN_GEMM
#define EN_GEMM 15
#endif
#ifndef EN_ATTN
#define EN_ATTN 1
#endif
#ifndef EN_S5
#define EN_S5 1
#endif
#ifndef EN_MISC
#define EN_MISC 1
#endif
#define RUN(body) do { if (p.ph_lo <= ph && ph < p.ph_hi) { body; if (ph + 1 < p.ph_hi) xcd_barrier(xbar); } ++ph; } while (0)

  RUN(if (EN_MISC) phase_prologue(p));
  for (int layer = 0; layer < 4; ++layer) {
    const int kind = layer % 3, slot = layer / 3;
    RUN(if (EN_MISC) phase_norm(p, layer, 0, layer == 0));
    if (kind == 0) {
      RUN(if (EN_S5) phase_s5_pass1(p, slot));
      RUN(if (EN_S5) phase_s5_pass2(p, slot));
      { GemmArgs ga{HB, D, (const bf16_t*)(ws + WS_GLUT) + (size_t)slot * 2048 * 1024, D, 32, 16, 1024, 0xffff};
        EpiGlu e{p.out, MOD + layer * 5 * 6144 + 2 * 1024, p.in[23] + slot * 2048};
        RUN(if (EN_GEMM & 1) gemm_phase<128>(ga, e)); }
    } else if (kind == 1) {
      { GemmArgs ga{HB, D, (const bf16_t*)(ws + WS_NAQKVT), D, 32, 24, 1024, 0xffff};
        EpiQkv e{QK, 2048, VT, 1024, p.out + OUT_NAV};
        RUN(if (EN_GEMM & 2) gemm_phase<128>(ga, e)); }
      RUN(if (EN_MISC) phase_post_na(p));
      RUN(if (EN_ATTN) phase_attn_na(p));
      { GemmArgs ga{AO, D, (const bf16_t*)(ws + WS_NAOT), D, 32, 8, 1024, 0xffff};
        EpiResid e{p.out, MOD + layer * 5 * 6144 + 2 * 1024};
        RUN(if (EN_GEMM & 4) gemm_phase<128>(ga, e)); }
    } else {
      { GemmArgs ga{HB, D, (const bf16_t*)(ws + WS_GQAQKVT), D, 32, 12, 1024, 0xffff};
        EpiQkv e{QK, 1280, VT, 256, p.out + OUT_GQAV};
        RUN(if (EN_GEMM & 2) gemm_phase<128>(ga, e)); }
      RUN(if (EN_MISC) phase_post_gqa(p));
      RUN(if (EN_ATTN) phase_attn_gqa(p));
      { GemmArgs ga{AO, D, (const bf16_t*)(ws + WS_GQAOT), D, 32, 8, 1024, 0xffff};
        EpiResid e{p.out, MOD + layer * 5 * 6144 + 2 * 1024};
        RUN(if (EN_GEMM & 4) gemm_phase<128>(ga, e)); }
    }
    RUN(if (EN_MISC) phase_norm(p, layer, 1, false));
    { GemmArgs ga{HB, D, (const bf16_t*)(ws + WS_W1T) + (size_t)layer * 4096 * 1024, D, 32, 16, 1024, 0xffff};
      EpiSqRelu e{ACT};
      RUN(if (EN_GEMM & 8) gemm_phase<256>(ga, e)); }
    { GemmArgs ga{ACT, DFF, (const bf16_t*)(ws + WS_W2T) + (size_t)layer * 1024 * 4096, DFF, 32, 8, 4096, 0xffff};
      EpiResid e{p.out, MOD + layer * 5 * 6144 + 5 * 1024};
      RUN(if (EN_GEMM & 4) gemm_phase<128>(ga, e)); }
  }
#ifdef FINAL_SYNC
  if (p.ph_hi - p.ph_lo > 1) { grid.sync(); { const unsigned long long t0 = __builtin_amdgcn_s_memrealtime(); while (__builtin_amdgcn_s_memrealtime() - t0 < 2000ull) __builtin_amdgcn_s_sleep(8); } grid.sync(); }
#endif
#ifdef DUMP_S5P
  if (p.ph_hi - p.ph_lo > 1) {
    grid.sync();
    const float* sa = (const float*)(ws + WS_S5A);
    const unsigned* sb = (const unsigned*)(ws + WS_S5BB);
    const unsigned* sc = (const unsigned*)(ws + WS_S5CM);
    for (size_t i = (size_t)blockIdx.x * NT + opaque_tid(); i < 524288; i += (size_t)gridDim.x * NT) {
      if (i < 32768) p.out[i] = sa[i];
      unsigned w = sb[i]; p.out[65536 + 2 * i] = bflo(w); p.out[65536 + 2 * i + 1] = bfhi(w);
      unsigned w2 = sc[i]; p.out[2097152 + 2 * i] = bflo(w2); p.out[2097152 + 2 * i + 1] = bfhi(w2);
    }
  }
#endif
#ifdef DUMP_E
  if (p.ph_hi - p.ph_lo > 1) {
    grid.sync();
    const float* sp = (const float*)(ws + WS_S5E);
    for (size_t i = (size_t)blockIdx.x * NT + opaque_tid(); i < 2097152; i += (size_t)gridDim.x * NT) p.out[i] = sp[i];
  }
#endif
#ifdef DUMP_HB
  if (p.ph_hi - p.ph_lo > 1) {
    grid.sync();
    const unsigned* sp = (const unsigned*)(ws + WS_HB);
    for (size_t i = (size_t)blockIdx.x * NT + opaque_tid(); i < 4194304; i += (size_t)gridDim.x * NT) {
      unsigned w = sp[i]; p.out[2 * i] = bflo(w); p.out[2 * i + 1] = bfhi(w);
    }
  }
#endif
#ifdef DUMP_W2T
  if (p.ph_lo == 100) {
    const unsigned* sp = (const unsigned*)(ws + WS_W2T);
    for (size_t i = (size_t)blockIdx.x * NT + opaque_tid(); i < 19398656 / 2; i += (size_t)gridDim.x * NT) {
      float a = 0.f, b = 0.f;
      if (i < 2097152) { unsigned w = sp[i]; a = bflo(w); b = bfhi(w); }
      p.out[2 * i] = a; p.out[2 * i + 1] = b;
    }
  }
#endif
#undef RUN
#ifdef CHK_W2T
  grid.sync();
  { float* chk = (float*)(ws + WS_END);
    const int t = opaque_tid();
    const unsigned* sp = (const unsigned*)(ws + WS_W2T);
    const size_t per = (size_t)(33554432 / 4) / gridDim.x;
    float s = 0.f;
    for (size_t i = t; i < per; i += NT) { unsigned w = sp[(size_t)blockIdx.x * per + i]; s += (bflo(w) + 2.f * bfhi(w)) * (1.f + (float)(i & 15)); }
    float* red = (float*)smem; red[t] = s; __syncthreads();
    if (t == 0) { float a = 0.f; for (int i = 0; i < NT; ++i) a += red[i]; chk[blockIdx.x] = a; }
    __syncthreads(); }
  grid.sync();
  { const float* chk = (const float*)(ws + WS_END);
    for (size_t i = (size_t)blockIdx.x * NT + opaque_tid(); i < 19398656; i += (size_t)gridDim.x * NT) p.out[i] = chk[(i >> 10) & 255]; }
#endif
#ifdef CHK_INPUT
  grid.sync();
  { const float* chk = (const float*)(ws + WS_END);
    for (size_t i = (size_t)blockIdx.x * NT + opaque_tid(); i < 19398656; i += (size_t)gridDim.x * NT) p.out[i] = chk[(i >> 10) & 255]; }
#endif
}

extern "C" void kernel_launch(void* const* d_in, const int* in_sizes, int n_in, void* d_out, int out_size, void* d_ws, size_t ws_size, hipStream_t stream) {
  static int grid_blocks = 0;
  if (grid_blocks == 0) {
    if (n_in != 33 || ws_size < WS_END) { fprintf(stderr, "kernel_launch: unexpected n_in %d or ws_size %zu (< %zu)\n", n_in, ws_size, (size_t)WS_END); grid_blocks = -1; return; }
    int dev = 0, cus = 0, per_cu = 0;
    (void)hipGetDevice(&dev);
    (void)hipDeviceGetAttribute(&cus, hipDeviceAttributeMultiprocessorCount, dev);
    if (hipFuncSetAttribute((const void*)fwd_megakernel, hipFuncAttributeMaxDynamicSharedMemorySize, LDS_BYTES) != hipSuccess) { fprintf(stderr, "hipFuncSetAttribute failed\n"); grid_blocks = -1; return; }
    if (hipOccupancyMaxActiveBlocksPerMultiprocessor(&per_cu, (const void*)fwd_megakernel, NT, LDS_BYTES) != hipSuccess || per_cu < 1) { fprintf(stderr, "occupancy query failed (%d)\n", per_cu); (void)hipGetLastError(); per_cu = 1; }
    grid_blocks = cus * 1;
    fprintf(stderr, "kernel_launch: cus %d per_cu %d grid %d\n", cus, per_cu, grid_blocks);
  }
  if (grid_blocks < 0) return;
  (void)hipMemsetAsync((unsigned char*)d_ws + WS_BAR, 0, 16384, stream);
  Params p{};
  for (int i = 0; i < 33; ++i) p.in[i] = (const float*)d_in[i];
  p.out = (float*)d_out; p.ws = (unsigned char*)d_ws;
#if N_LAUNCH_MODE == 1
  #ifndef PH_HI
#define PH_HI NPHASE
#endif
  p.ph_lo = 0; p.ph_hi = PH_HI;
  void* args[] = {&p};
  hipError_t e = hipLaunchCooperativeKernel((void*)fwd_megakernel, dim3(grid_blocks), dim3(NT), args, LDS_BYTES, stream);
  if (e != hipSuccess) fprintf(stderr, "cooperative launch failed: %s (grid %d)\n", hipGetErrorString(e), grid_blocks);
#else
#ifndef PH_HI
#define PH_HI NPHASE
#endif
  for (int ph = 0; ph < PH_HI; ++ph) {
    p.ph_lo = ph; p.ph_hi = ph + 1;
    hipLaunchKernelGGL(fwd_megakernel, dim3(grid_blocks), dim3(NT), LDS_BYTES, stream, p);
  }
#ifdef DUMP_W2T
  p.ph_lo = 100; p.ph_hi = 101;
  hipLaunchKernelGGL(fwd_megakernel, dim3(grid_blocks), dim3(NT), LDS_BYTES, stream, p);
#endif
#endif
}
```

```cpp
#include <hip/hip_runtime.h>
#include <hip/hip_bf16.h>
#include <hip/hip_cooperative_groups.h>
#include <cstdio>
namespace cg = cooperative_groups;

typedef unsigned short bf16_t;
using bf16 = __hip_bfloat16;
using bf16x8 = __attribute__((ext_vector_type(8))) short;
using f32x4 = __attribute__((ext_vector_type(4))) float;
using f32x16 = __attribute__((ext_vector_type(16))) float;

#define B_AUX 0
#ifndef USE_GLDS
#define USE_GLDS 1
#endif
#ifndef N_LAUNCH_MODE
#define N_LAUNCH_MODE 1
#endif

constexpr int NT = 512;
constexpr int D = 1024, NTOK = 8192, DFF = 4096;
constexpr int LDS_BYTES = 131072 + 64;
constexpr int NPHASE = 31;

constexpr size_t WS_W1T = 0;
constexpr size_t WS_W2T = WS_W1T + 33554432;
constexpr size_t WS_GLUT = WS_W2T + 33554432;
constexpr size_t WS_NAQKVT = WS_GLUT + 8388608;
constexpr size_t WS_NAOT = WS_NAQKVT + 6291456;
constexpr size_t WS_GQAQKVT = WS_NAOT + 2097152;
constexpr size_t WS_GQAOT = WS_GQAQKVT + 3145728;
constexpr size_t WS_MOD = WS_GQAOT + 2097152;
constexpr size_t WS_S5A = WS_MOD + 491520;
constexpr size_t WS_S5BB = WS_S5A + 131072;
constexpr size_t WS_S5CM = WS_S5BB + 1048576;
constexpr size_t WS_S5E = WS_S5CM + 1048576;
constexpr size_t WS_CKNA = WS_S5E + 8388608;
constexpr size_t WS_CVTNA = WS_CKNA + 4194304;
constexpr size_t WS_CKGQA = WS_CVTNA + 4194304;
constexpr size_t WS_CVTGQA = WS_CKGQA + 1048576;
constexpr size_t WS_HB = WS_CVTGQA + 1048576;
constexpr size_t WS_AO = WS_HB + 16777216;
constexpr size_t WS_QK = WS_AO + 16777216;
constexpr size_t WS_VT = WS_QK + 33554432;
constexpr size_t WS_ACT = WS_VT + 16777216;
constexpr size_t WS_BAR = WS_ACT + 67108864;
constexpr size_t WS_END = WS_BAR + 16384;

constexpr size_t OUT_YS = 4194304, OUT_S5 = 8388608, OUT_NAK = 8912896, OUT_NAV = 13107200, OUT_GQAK = 17301504, OUT_GQAV = 18350080;

struct Params {
  const float* in[33];
  float* out;
  unsigned char* ws;
  int ph_lo, ph_hi;
};

extern __shared__ __attribute__((aligned(16))) unsigned char smem[];

__device__ __forceinline__ unsigned cvt_pk_bf16(float lo, float hi) {
  unsigned r; asm("v_cvt_pk_bf16_f32 %0, %1, %2" : "=v"(r) : "v"(lo), "v"(hi)); return r;
}
__device__ __forceinline__ bf16_t f2bf(float f) { return (bf16_t)(cvt_pk_bf16(f, 0.f) & 0xffffu); }
__device__ __forceinline__ float bf2f(bf16_t b) { return __uint_as_float(((unsigned)b) << 16); }
__device__ __forceinline__ float bflo(unsigned u) { return __uint_as_float(u << 16); }
__device__ __forceinline__ float bfhi(unsigned u) { return __uint_as_float(u & 0xffff0000u); }
__device__ __forceinline__ int cond_of_row(int row) { return row < 4096 ? 0 : 1 + ((row - 4096) >> 10); }

__device__ __forceinline__ int opaque_tid() { int t = threadIdx.x; asm volatile("" : "+v"(t)); return t; }
#define MFMA_SETTLE() asm volatile("s_nop 15\n\ts_nop 15" ::: "memory")
__device__ __forceinline__ void bu_mfma4(f32x16& c0, f32x16& c1, f32x16& c2, f32x16& c3, bf16x8 a, bf16x8 b0, bf16x8 b1, bf16x8 b2, bf16x8 b3) {
  asm volatile("v_mfma_f32_32x32x16_bf16 %0, %4, %5, 0\n\t"
               "v_mfma_f32_32x32x16_bf16 %1, %4, %6, 0\n\t"
               "v_mfma_f32_32x32x16_bf16 %2, %4, %7, 0\n\t"
               "v_mfma_f32_32x32x16_bf16 %3, %4, %8, 0\n\t"
               "s_nop 15\n\ts_nop 15"
               : "=&v"(c0), "=&v"(c1), "=&v"(c2), "=&v"(c3) : "v"(a), "v"(b0), "v"(b1), "v"(b2), "v"(b3));
}
struct cplx { float re, im; };
__device__ __forceinline__ cplx cmul(cplx a, cplx b) { return {a.re * b.re - a.im * b.im, a.re * b.im + a.im * b.re}; }
__device__ __forceinline__ cplx cfma(cplx a, cplx h, cplx b) {
  cplx r; r.re = fmaf(a.re, h.re, fmaf(-a.im, h.im, b.re)); r.im = fmaf(a.re, h.im, fmaf(a.im, h.re, b.im)); return r;
}

constexpr int BM = 256, BK = 64, NXCD = 8, WGM = 8;

__device__ __forceinline__ int lds_byte(int r, int c) {
  int st = (r >> 4) * 2 + (c >> 5), ob = (r & 15) * 64 + (c & 31) * 2;
  return st * 1024 + (ob ^ (((ob >> 9) & 1) << 5));
}
__device__ __forceinline__ void stage_rc(int b, int& R, int& C) {
  int st = b >> 10, sb = b & 1023, swz = sb ^ (((sb >> 9) & 1) << 5);
  R = (st / 2) * 16 + swz / 64; C = (st % 2) * 32 + (swz % 64) / 2;
}

struct GemmArgs { const bf16_t* A; int lda; const bf16_t* Bt; int ldb; int nM, nN, K; int kmask; };

template <int BN, class Epi>
__device__ __forceinline__ void gemm_phase(const GemmArgs ga, const Epi epi) {
  constexpr int TILE_A = BM * BK * 2, TILE_B = BN * BK * 2, STAGE_B = TILE_A + TILE_B, GLA = TILE_A / 8192, GLB = TILE_B / 8192, NF = BN / 64;
  unsigned char* shm = smem;
  const int tid = opaque_tid(), wid = tid >> 6, lane = tid & 63, wr = wid >> 2, wc = wid & 3, fr = lane & 15, fq = lane >> 4;
  unsigned voA[GLA], voB[GLB];
#pragma unroll
  for (int i = 0; i < GLA; ++i) { int r_, c_; stage_rc(wid * 1024 + i * 8192 + lane * 16, r_, c_); voA[i] = (unsigned)(r_ * ga.lda + c_) * 2u; }
#pragma unroll
  for (int i = 0; i < GLB; ++i) { int r_, c_; stage_rc(wid * 1024 + i * 8192 + lane * 16, r_, c_); voB[i] = (unsigned)(r_ * ga.ldb + c_) * 2u; }
  int offA[8], offB[NF];
#pragma unroll
  for (int m = 0; m < 8; ++m) offA[m] = lds_byte(wr * 128 + m * 16 + fr, fq * 8);
#pragma unroll
  for (int n = 0; n < NF; ++n) offB[n] = TILE_A + lds_byte(wc * (BN / 4) + n * 16 + fr, fq * 8);
  const int nwg = ga.nM * ga.nN, nt = ga.K / BK;
  for (int u = blockIdx.x; u < nwg; u += gridDim.x) {
    int wgid = u;
    { int q = nwg / NXCD, r = nwg % NXCD, xcd = wgid % NXCD, off = wgid / NXCD;
      wgid = (xcd < r ? xcd * (q + 1) : r * (q + 1) + (xcd - r) * q) + off; }
    constexpr int WG_ = (BN == 128) ? 4 : WGM;
    const int nig = WG_ * ga.nN, gid = wgid / nig, fm = gid * WG_, gsz = min(ga.nM - fm, WG_);
    const int pm = fm + ((wgid % nig) % gsz), pn = (wgid % nig) / gsz, brow = pm * BM, bcol = pn * BN;
    const bf16_t* Ab = ga.A + (long)brow * ga.lda;
    const bf16_t* Bb = ga.Bt + (long)bcol * ga.ldb;
#define GLDS_STAGE(buf, kt) do { \
    _Pragma("unroll") for (int i = 0; i < GLA; ++i) \
      __builtin_amdgcn_global_load_lds((const unsigned*)((const char*)(Ab + ((kt) & ga.kmask) * BK) + voA[i]), \
        (__attribute__((address_space(3))) unsigned*)(shm + (buf) * STAGE_B + wid * 1024 + i * 8192), 16, 0, 0); \
    _Pragma("unroll") for (int i = 0; i < GLB; ++i) \
      __builtin_amdgcn_global_load_lds((const unsigned*)((const char*)(Bb + ((kt) & ga.kmask) * BK) + voB[i]), \
        (__attribute__((address_space(3))) unsigned*)(shm + (buf) * STAGE_B + TILE_A + wid * 1024 + i * 8192), 16, 0, B_AUX); } while (0)
    f32x4 acc[8][NF];
#pragma unroll
    for (int m = 0; m < 8; ++m)
#pragma unroll
      for (int n = 0; n < NF; ++n) acc[m][n] = (f32x4){0.f, 0.f, 0.f, 0.f};
#define LOADF(A_, B_, ks_) do { \
      _Pragma("unroll") for (int m = 0; m < 8; ++m) A_[m] = *(const bf16x8*)(sb + offA[m] + (ks_) * 1024); \
      _Pragma("unroll") for (int n = 0; n < NF; ++n) B_[n] = *(const bf16x8*)(sb + offB[n] + (ks_) * 1024); } while (0)
#define MMAS(A_, B_) do { \
      _Pragma("unroll") for (int m = 0; m < 8; ++m) \
        _Pragma("unroll") for (int n = 0; n < NF; ++n) acc[m][n] = __builtin_amdgcn_mfma_f32_16x16x32_bf16(B_[n], A_[m], acc[m][n], 0, 0, 0); } while (0)
#define COMPUTE(cur_) do { const unsigned char* sb = shm + (cur_) * STAGE_B; \
      if constexpr (NF == 2) { \
        bf16x8 A0[8], B0[NF], A1[8], B1[NF]; \
        LOADF(A0, B0, 0); LOADF(A1, B1, 1); \
        __builtin_amdgcn_sched_barrier(0); \
        MMAS(A0, B0); MMAS(A1, B1); \
        __builtin_amdgcn_sched_barrier(0); \
      } else { \
        bf16x8 A0[8], B0[NF]; \
        LOADF(A0, B0, 0); __builtin_amdgcn_sched_barrier(0); MMAS(A0, B0); __builtin_amdgcn_sched_barrier(0); \
        LOADF(A0, B0, 1); __builtin_amdgcn_sched_barrier(0); MMAS(A0, B0); __builtin_amdgcn_sched_barrier(0); \
      } } while (0)
#if USE_GLDS
    GLDS_STAGE(0, 0);
    asm volatile("s_waitcnt vmcnt(0)" ::: "memory"); __syncthreads();
    for (int t = 0; t < nt; ++t) {
      const int cur = t & 1;
      if (t + 1 < nt) GLDS_STAGE(cur ^ 1, t + 1);
      COMPUTE(cur);
      asm volatile("s_waitcnt vmcnt(0)" ::: "memory"); __syncthreads();
    }
#else
    uint4 sa0, sa1, sa2, sa3, sb0, sb1, sb2, sb3;
    static_assert(GLA == 4 && (GLB == 2 || GLB == 4), "staging shape");
#define GSRC_A(kt, i) (*(const uint4*)((const char*)(Ab + ((kt) & ga.kmask) * BK) + voA[i]))
#define GSRC_B(kt, i) (*(const uint4*)((const char*)(Bb + ((kt) & ga.kmask) * BK) + voB[i]))
#define LDST_A(buf, i) (*(uint4*)(shm + (buf) * STAGE_B + wid * 1024 + (i) * 8192 + lane * 16))
#define LDST_B(buf, i) (*(uint4*)(shm + (buf) * STAGE_B + TILE_A + wid * 1024 + (i) * 8192 + lane * 16))
#define REG_ISSUE(kt) do { sa0 = GSRC_A(kt, 0); sa1 = GSRC_A(kt, 1); sa2 = GSRC_A(kt, 2); sa3 = GSRC_A(kt, 3); \
      sb0 = GSRC_B(kt, 0); sb1 = GSRC_B(kt, 1); if constexpr (GLB == 4) { sb2 = GSRC_B(kt, 2); sb3 = GSRC_B(kt, 3); } } while (0)
#define REG_WRITE(buf) do { LDST_A(buf, 0) = sa0; LDST_A(buf, 1) = sa1; LDST_A(buf, 2) = sa2; LDST_A(buf, 3) = sa3; \
      LDST_B(buf, 0) = sb0; LDST_B(buf, 1) = sb1; if constexpr (GLB == 4) { LDST_B(buf, 2) = sb2; LDST_B(buf, 3) = sb3; } } while (0)
    REG_ISSUE(0); REG_WRITE(0); REG_ISSUE(1); __syncthreads();
    for (int t = 0; t < nt; ++t) {
      const int cur = t & 1;
      if (t + 1 < nt) REG_WRITE(cur ^ 1);
      if (t + 2 < nt) REG_ISSUE(t + 2);
      COMPUTE(cur);
      __syncthreads();
    }
#undef REG_ISSUE
#undef REG_WRITE
#endif
#undef COMPUTE
#undef LOADF
#undef MMAS
#undef GLDS_STAGE
    epi(acc, brow + wr * 128 + fr, bcol + wc * (BN / 4) + fq * 4);
  }
  __syncthreads();
}

struct EpiSqRelu {
  bf16_t* O;
  template <int NF> __device__ __forceinline__ void operator()(const f32x4 (&acc)[8][NF], int row0, int col0) const {
#pragma unroll
    for (int m = 0; m < 8; ++m)
#pragma unroll
      for (int n = 0; n < NF; ++n) {
        f32x4 v = acc[m][n];
        float a0 = fmaxf(v[0], 0.f), a1 = fmaxf(v[1], 0.f), a2 = fmaxf(v[2], 0.f), a3 = fmaxf(v[3], 0.f);
        uint2 pk; pk.x = cvt_pk_bf16(a0 * a0, a1 * a1); pk.y = cvt_pk_bf16(a2 * a2, a3 * a3);
        *(uint2*)(O + (size_t)(row0 + 16 * m) * DFF + col0 + 16 * n) = pk;
      }
  }
};
struct EpiResid {
  float* X; const float* gate;
  template <int NF> __device__ __forceinline__ void operator()(const f32x4 (&acc)[8][NF], int row0, int col0) const {
    const float* gp = gate + cond_of_row(row0) * 6144;
#pragma unroll
    for (int n = 0; n < NF; ++n) {
      const f32x4 gv = *(const f32x4*)(gp + col0 + 16 * n);
#pragma unroll
      for (int m = 0; m < 8; ++m) {
        float* xp = X + (size_t)(row0 + 16 * m) * D + col0 + 16 * n;
        f32x4 o = *(f32x4*)xp; o += acc[m][n] * gv; *(f32x4*)xp = o;
      }
    }
  }
};
struct EpiGlu {
  float* X; const float* gate; const float* bias;
  template <int NF> __device__ __forceinline__ void operator()(const f32x4 (&acc)[8][NF], int row0, int col0) const {
    const float* gp = gate + cond_of_row(row0) * 6144;
    const int col = (col0 >> 7) * 64 + ((col0 >> 5) & 3) * 16 + (col0 & 15);
    const f32x4 gv = *(const f32x4*)(gp + col);
    const f32x4 ba = *(const f32x4*)(bias + col), bg = *(const f32x4*)(bias + 1024 + col);
#pragma unroll
    for (int m = 0; m < 8; ++m) {
      float* xp = X + (size_t)(row0 + 16 * m) * D + col;
      f32x4 a = acc[m][0] + ba, g = acc[m][1] + bg;
      f32x4 o = *(f32x4*)xp;
#pragma unroll
      for (int i = 0; i < 4; ++i) { float s = 1.f / (1.f + __expf(-g[i])); o[i] += gv[i] * a[i] * s; }
      *(f32x4*)xp = o;
    }
  }
};
struct EpiQkv {
  bf16_t* QK; int nqk; bf16_t* VT; int C; float* newv;
  template <int NF> __device__ __forceinline__ void operator()(const f32x4 (&acc)[8][NF], int row0, int col0) const {
    if (col0 < nqk) {
#pragma unroll
      for (int m = 0; m < 8; ++m)
#pragma unroll
        for (int n = 0; n < NF; ++n) {
          f32x4 v = acc[m][n];
          uint2 pk; pk.x = cvt_pk_bf16(v[0], v[1]); pk.y = cvt_pk_bf16(v[2], v[3]);
          *(uint2*)(QK + (size_t)(row0 + 16 * m) * nqk + col0 + 16 * n) = pk;
        }
    } else {
      const int vc0 = col0 - nqk;
#pragma unroll
      for (int m = 0; m < 8; ++m) {
        const int row = row0 + 16 * m;
        size_t vbase; int ldv;
        if (row < 4096) { vbase = (size_t)(row >> 8) * C * 256 + (row & 255); ldv = 256; }
        else { const int r2 = row - 4096; vbase = (size_t)4096 * C + (size_t)(r2 >> 10) * C * 1024 + (r2 & 1023); ldv = 1024; }
#pragma unroll
        for (int n = 0; n < NF; ++n) {
          const int col = vc0 + 16 * n;
          f32x4 v = acc[m][n];
#pragma unroll
          for (int i = 0; i < 4; ++i) VT[vbase + (size_t)(col + i) * ldv] = f2bf(v[i]);
          if (row < 4096) *(f32x4*)(newv + (size_t)row * C + col) = v;
        }
      }
    }
  }
};

__device__ void conv_job(const Params& p, int job, const float*& src, bf16_t*& dst, int& K, int& N, int& perm) {
  unsigned char* ws = p.ws; perm = 0;
  if (job < 4) { src = p.in[12] + (size_t)job * 1024 * 4096; dst = (bf16_t*)(ws + WS_W1T) + (size_t)job * 4096 * 1024; K = 1024; N = 4096; }
  else if (job < 8) { int l = job - 4; src = p.in[13] + (size_t)l * 4096 * 1024; dst = (bf16_t*)(ws + WS_W2T) + (size_t)l * 1024 * 4096; K = 4096; N = 1024; }
  else if (job < 10) { int s = job - 8; src = p.in[22] + (size_t)s * 1024 * 2048; dst = (bf16_t*)(ws + WS_GLUT) + (size_t)s * 2048 * 1024; K = 1024; N = 2048; perm = 1; }
  else if (job == 10) { src = p.in[24]; dst = (bf16_t*)(ws + WS_NAQKVT); K = 1024; N = 3072; }
  else if (job == 11) { src = p.in[28]; dst = (bf16_t*)(ws + WS_NAOT); K = 1024; N = 1024; }
  else if (job == 12) { src = p.in[29]; dst = (bf16_t*)(ws + WS_GQAQKVT); K = 1024; N = 1536; }
  else if (job == 13) { src = p.in[32]; dst = (bf16_t*)(ws + WS_GQAOT); K = 1024; N = 1024; }
  else if (job < 18) { int b = job - 14; src = p.in[4] + (size_t)b * 512 * 1024; dst = (bf16_t*)(ws + WS_CVTNA) + (size_t)b * 1024 * 512; K = 512; N = 1024; }
  else { int b = job - 18; src = p.in[6] + (size_t)b * 512 * 256; dst = (bf16_t*)(ws + WS_CVTGQA) + (size_t)b * 256 * 512; K = 512; N = 256; }
}

__device__ void do_transposes(const Params& p, int job_lo, int job_hi);
__device__ void phase_prologue(const Params& p) {
  const int tid = opaque_tid(), G = gridDim.x;
  unsigned char* ws = p.ws;
  float* MOD = (float*)(ws + WS_MOD);
  {
    float* sl = (float*)smem;
    float* red = (float*)smem + 5 * 1024;
    bool have = false;
    for (int it = blockIdx.x; it < 192; it += G) {
      if (!have) {
        for (int i = tid; i < 5 * 1024; i += NT) {
          int c = i >> 10, k = i & 1023;
          float v = (c == 0) ? p.in[8][k] : p.in[7][(c - 1) * 1024 + k];
          sl[i] = v / (1.f + __expf(-v));
        }
        have = true;
      }
      __syncthreads();
      const int layer = it / 48, col0 = (it % 48) * 128;
      const int cg4 = tid & 31, ksl = tid >> 5;
      const float* wp = p.in[10] + (size_t)layer * 1024 * 6144 + col0 + cg4 * 4;
      f32x4 a[5];
      for (int c = 0; c < 5; ++c) a[c] = (f32x4){0.f, 0.f, 0.f, 0.f};
#pragma unroll 8
      for (int kk = 0; kk < 64; ++kk) {
        const int k = ksl * 64 + kk;
        const f32x4 w = *(const f32x4*)(wp + (size_t)k * 6144);
        for (int c = 0; c < 5; ++c) a[c] += w * sl[c * 1024 + k];
      }
      for (int c = 0; c < 5; ++c) *(f32x4*)(red + (ksl * 5 + c) * 128 + cg4 * 4) = a[c];
      __syncthreads();
      for (int o = tid; o < 640; o += NT) {
        const int c = o >> 7, col = o & 127;
        float s = p.in[11][layer * 6144 + col0 + col];
        for (int k2 = 0; k2 < 16; ++k2) s += red[(k2 * 5 + c) * 128 + col];
        MOD[(layer * 5 + c) * 6144 + col0 + col] = s;
      }
      __syncthreads();
    }
    __syncthreads();
  }
  {
    float* S5A = (float*)(ws + WS_S5A);
    bf16_t* BB = (bf16_t*)(ws + WS_S5BB);
    bf16_t* CM = (bf16_t*)(ws + WS_S5CM);
    for (int it = (blockIdx.x + 64) % G; it < 256; it += G) {
      const int sdg = it;
      const int g = it & 63;
      const float dt = expf(p.in[16][sdg]);
      for (int idx = tid; idx < 1024; idx += NT) {
        const int pp = idx >> 4, ch = idx & 15;
        const float lr = p.in[14][sdg * 64 + pp], li = p.in[15][sdg * 64 + pp];
        const float ar = lr * dt, ai = li * dt;
        const float mag = expf(ar), cs = cosf(ai), sn = sinf(ai), sh = sinf(0.5f * ai);
        const float abr = mag * cs, abi = mag * sn;
        const float nr = expm1f(ar) * cs - 2.f * sh * sh, ni = abi;
        const float den = lr * lr + li * li;
        const float fre = (nr * lr + ni * li) / den, fim = (ni * lr - nr * li) / den;
        const float br = p.in[17][(sdg * 64 + pp) * 16 + ch], bi = p.in[18][(sdg * 64 + pp) * 16 + ch];
        const float bbr = fre * br - fim * bi, bbi = fre * bi + fim * br;
        BB[((size_t)sdg * 128 + pp) * 16 + ch] = f2bf(bbr);
        BB[((size_t)sdg * 128 + 64 + pp) * 16 + ch] = f2bf(bbi);
        const float cr = p.in[19][(sdg * 16 + ch) * 64 + pp], ci = p.in[20][(sdg * 16 + ch) * 64 + pp];
        const int q = pp & 31, s2 = (pp >> 5) * 2;
        CM[((size_t)sdg * 16 + ch) * 128 + 4 * q + s2] = f2bf(cr);
        CM[((size_t)sdg * 16 + ch) * 128 + 4 * q + s2 + 1] = f2bf(-ci);
        if (ch == 0) { S5A[(sdg * 64 + pp) * 2] = abr; S5A[(sdg * 64 + pp) * 2 + 1] = abi; }
      }
      (void)g;
    }
  }
  {
    const size_t n1 = 4 * 512 * 1024 / 4, n2 = 4 * 512 * 256 / 4;
    uint2* d1 = (uint2*)(ws + WS_CKNA); uint2* d2 = (uint2*)(ws + WS_CKGQA);
    const f32x4* s1 = (const f32x4*)p.in[3]; const f32x4* s2 = (const f32x4*)p.in[5];
    for (size_t i = (size_t)blockIdx.x * NT + tid; i < n1 + n2; i += (size_t)G * NT) {
      f32x4 v = (i < n1) ? s1[i] : s2[i - n1];
      uint2 pk; pk.x = cvt_pk_bf16(v[0], v[1]); pk.y = cvt_pk_bf16(v[2], v[3]);
      if (i < n1) d1[i] = pk; else d2[i - n1] = pk;
    }
  }
  do_transposes(p, 0, 22);
}

__device__ void do_transposes(const Params& p, int job_lo, int job_hi) {
  const int tid = opaque_tid(), G = gridDim.x;
  {
    bf16_t* T = (bf16_t*)smem;
    int base = 0;
    for (int job = job_lo; job < job_hi; ++job) {
      const float* src; bf16_t* dst; int K, N, perm;
      conv_job(p, job, src, dst, K, N, perm);
      const int tn = N >> 8, ntile = (K >> 6) * tn;
      const int start = (int)(((long)blockIdx.x - (base % G) + G) % G);
      const int n4 = tid & 63, kr0 = tid >> 6;
      f32x4 v[8];
      if (start < ntile) {
        const int k0 = (start / tn) << 6, n0 = (start % tn) << 8;
#pragma unroll
        for (int ps = 0; ps < 8; ++ps) v[ps] = *(const f32x4*)(src + (size_t)(k0 + 8 * kr0 + ps) * N + n0 + n4 * 4);
      }
      for (int tile = start; tile < ntile; tile += G) {
        const int k0 = (tile / tn) << 6, n0 = (tile % tn) << 8;
        __syncthreads();
#pragma unroll
        for (int i = 0; i < 4; ++i) {
          uint4 w;
          w.x = cvt_pk_bf16(v[0][i], v[1][i]); w.y = cvt_pk_bf16(v[2][i], v[3][i]);
          w.z = cvt_pk_bf16(v[4][i], v[5][i]); w.w = cvt_pk_bf16(v[6][i], v[7][i]);
          *(uint4*)(T + (n4 * 4 + i) * 72 + 8 * kr0) = w;
        }
        if (tile + G < ntile) {
          const int k1 = ((tile + G) / tn) << 6, n1 = ((tile + G) % tn) << 8;
#pragma unroll
          for (int ps = 0; ps < 8; ++ps) v[ps] = *(const f32x4*)(src + (size_t)(k1 + 8 * kr0 + ps) * N + n1 + n4 * 4);
        }
        __syncthreads();
#pragma unroll
        for (int q = 0; q < 4; ++q) {
          const int n = (tid >> 3) + 64 * q, kc = tid & 7;
          const uint4 o = *(const uint4*)(T + n * 72 + kc * 8);
          int dr = n0 + n;
          if (perm) { const int isg = dr >= 1024, c1 = dr & 1023; dr = (c1 >> 6) * 128 + ((c1 >> 4) & 3) * 32 + (c1 & 15) + isg * 16; }
          *(uint4*)(dst + (size_t)dr * K + k0 + kc * 8) = o;
        }
      }
      base += ntile;
    }
    __syncthreads();
  }
}

__device__ void phase_norm(const Params& p, int layer, int which, bool first) {
  const int tid_ = opaque_tid(); const int lane = tid_ & 63, wave = tid_ >> 6;
  const float* MOD = (const float*)(p.ws + WS_MOD);
  bf16_t* HB = (bf16_t*)(p.ws + WS_HB);
  const float* gw = p.in[9] + (layer * 2 + which) * 1024;
  for (int row0 = (blockIdx.x * 8 + wave) * 4; row0 < NTOK; row0 += gridDim.x * 32) {
    f32x4 v[4][4]; float ss[4];
#pragma unroll
    for (int r = 0; r < 4; ++r) {
      const int row = row0 + r;
      const float* xr = first ? (row < 4096 ? p.in[0] + (size_t)row * D : p.in[1] + (size_t)(row - 4096) * D) : p.out + (size_t)row * D;
#pragma unroll
      for (int i = 0; i < 4; ++i) v[r][i] = *(const f32x4*)(xr + i * 256 + lane * 4);
    }
#pragma unroll
    for (int r = 0; r < 4; ++r) {
      float s = 0.f;
#pragma unroll
      for (int i = 0; i < 4; ++i) s += v[r][i][0] * v[r][i][0] + v[r][i][1] * v[r][i][1] + v[r][i][2] * v[r][i][2] + v[r][i][3] * v[r][i][3];
      ss[r] = s;
    }
#pragma unroll
    for (int o = 32; o > 0; o >>= 1) {
#pragma unroll
      for (int r = 0; r < 4; ++r) ss[r] += __shfl_xor(ss[r], o);
    }
    const float* mp = MOD + (layer * 5 + cond_of_row(row0)) * 6144 + which * 3072;
#pragma unroll
    for (int i = 0; i < 4; ++i) {
      const int col = i * 256 + lane * 4;
      const f32x4 gv = *(const f32x4*)(gw + col), sh = *(const f32x4*)(mp + col), sc = *(const f32x4*)(mp + 1024 + col);
#pragma unroll
      for (int r = 0; r < 4; ++r) {
        const int row = row0 + r;
        const float rstd = rsqrtf(ss[r] * (1.f / 1024.f) + 1e-6f);
        if (first) *(f32x4*)(p.out + (size_t)row * D + col) = v[r][i];
        float o[4];
#pragma unroll
        for (int j = 0; j < 4; ++j) o[j] = v[r][i][j] * rstd * gv[j] * (1.f + sc[j]) + sh[j];
        uint2 pk; pk.x = cvt_pk_bf16(o[0], o[1]); pk.y = cvt_pk_bf16(o[2], o[3]);
        *(uint2*)(HB + (size_t)row * D + col) = pk;
      }
    }
  }
}

__device__ __forceinline__ int s5_tok(int rho) { return 16 * ((rho >> 2) & 1) + (rho & 3) + 4 * (rho >> 3); }
__device__ __forceinline__ cplx shfl_c(cplx v, int src) { cplx r; r.re = __shfl(v.re, src); r.im = __shfl(v.im, src); return r; }

__device__ void phase_s5_pass1(const Params& p, int slot) {
  const int tid_ = opaque_tid(); const int lane = tid_ & 63, wave = tid_ >> 6, r = lane & 31, H = lane >> 5;
  const bf16_t* HB = (const bf16_t*)(p.ws + WS_HB);
  const float* S5A = (const float*)(p.ws + WS_S5A);
  const bf16_t* BB = (const bf16_t*)(p.ws + WS_S5BB);
  float* E = (float*)(p.ws + WS_S5E);
  const int tokr = s5_tok(r);
  for (int it = blockIdx.x * 8 + wave; it < 128 * 64; it += gridDim.x * 8) {
    const int ck = it >> 6, g = it & 63, tok0 = ck * 64;
    bf16x8 uf[2];
    _Pragma("unroll") for (int tt = 0; tt < 2; ++tt) uf[tt] = *(const bf16x8*)(HB + (size_t)(tok0 + 32 * tt + tokr) * D + g * 16 + 8 * H);
    _Pragma("unroll") for (int dir = 0; dir < 2; ++dir) {
      const int sdg = (slot * 2 + dir) * 64 + g;
      cplx a0 = {S5A[(sdg * 64 + r) * 2], S5A[(sdg * 64 + r) * 2 + 1]};
      cplx a1 = {S5A[(sdg * 64 + r + 32) * 2], S5A[(sdg * 64 + r + 32) * 2 + 1]};
      cplx a0_16 = a0, a1_16 = a1;
      _Pragma("unroll") for (int i = 0; i < 4; ++i) { a0_16 = cmul(a0_16, a0_16); a1_16 = cmul(a1_16, a1_16); }
      const cplx a0_32 = cmul(a0_16, a0_16), a1_32 = cmul(a1_16, a1_16);
      bf16x8 bfr[4];
      _Pragma("unroll") for (int ct = 0; ct < 4; ++ct) bfr[ct] = *(const bf16x8*)(BB + ((size_t)sdg * 128 + 32 * ct + r) * 16 + 8 * H);
      cplx E0 = {0.f, 0.f}, E1 = {0.f, 0.f};
      _Pragma("unroll") for (int t2 = 0; t2 < 2; ++t2) {
        const int tt = dir ? 1 - t2 : t2;
        f32x16 acc[4];
        bu_mfma4(acc[0], acc[1], acc[2], acc[3], uf[tt], bfr[0], bfr[1], bfr[2], bfr[3]);
        cplx e0 = {0.f, 0.f}, e1 = {0.f, 0.f};
        if (dir == 0) {
          _Pragma("unroll") for (int i = 0; i < 16; ++i) { e0 = cfma(a0, e0, (cplx){acc[0][i], acc[2][i]}); e1 = cfma(a1, e1, (cplx){acc[1][i], acc[3][i]}); }
        } else {
          _Pragma("unroll") for (int i = 15; i >= 0; --i) { e0 = cfma(a0, e0, (cplx){acc[0][i], acc[2][i]}); e1 = cfma(a1, e1, (cplx){acc[1][i], acc[3][i]}); }
        }
        const cplx o0 = shfl_c(e0, lane ^ 32), o1 = shfl_c(e1, lane ^ 32);
        const cplx eL0 = H ? o0 : e0, eU0 = H ? e0 : o0, eL1 = H ? o1 : e1, eU1 = H ? e1 : o1;
        cplx t0, t1;
        if (dir == 0) { t0 = cfma(a0_16, eL0, eU0); t1 = cfma(a1_16, eL1, eU1); }
        else { t0 = cfma(a0_16, eU0, eL0); t1 = cfma(a1_16, eU1, eL1); }
        E0 = cfma(a0_32, E0, t0); E1 = cfma(a1_32, E1, t1);
      }
      const int pp = H ? r + 32 : r;
      const cplx Ev = H ? E1 : E0;
      *(float2*)(E + ((size_t)((ck * 64 + g) * 2 + dir) * 64 + pp) * 2) = make_float2(Ev.re, Ev.im);
    }
  }
}

__device__ void phase_s5_pass2(const Params& p, int slot) {
  const int tid_ = opaque_tid(); const int lane = tid_ & 63, wave = tid_ >> 6, r = lane & 31, H = lane >> 5;
  bf16_t* HB = (bf16_t*)(p.ws + WS_HB);
  const float* S5A = (const float*)(p.ws + WS_S5A);
  const bf16_t* BB = (const bf16_t*)(p.ws + WS_S5BB);
  const bf16_t* CM = (const bf16_t*)(p.ws + WS_S5CM);
  const float* E = (const float*)(p.ws + WS_S5E);
  const float* Dsk = p.in[21] + slot * 1024;
  unsigned char* ldsw = smem + wave * 8704;
  const int tokr = s5_tok(r);
  for (int it = blockIdx.x * 8 + wave; it < 128 * 64; it += gridDim.x * 8) {
    const int ck = it >> 6, g = it & 63, tok0 = ck * 64;
    int c, nc, bq; bool sample;
    if (tok0 < 4096) { bq = tok0 >> 8; c = (tok0 >> 6) & 3; nc = 4; sample = false; }
    else { const int t2 = tok0 - 4096; bq = t2 >> 10; c = (t2 >> 6) & 15; nc = 16; sample = true; }
    const int ck0 = ck - c;
    bf16x8 uf[2];
    _Pragma("unroll") for (int tt = 0; tt < 2; ++tt) uf[tt] = *(const bf16x8*)(HB + (size_t)(tok0 + 32 * tt + tokr) * D + g * 16 + 8 * H);
    f32x4 yacc[2][2];
    _Pragma("unroll") for (int a = 0; a < 2; ++a) _Pragma("unroll") for (int b = 0; b < 2; ++b) yacc[a][b] = (f32x4){0.f, 0.f, 0.f, 0.f};
    _Pragma("unroll") for (int dir = 0; dir < 2; ++dir) {
      const int sdg = (slot * 2 + dir) * 64 + g;
      const cplx a0 = {S5A[(sdg * 64 + r) * 2], S5A[(sdg * 64 + r) * 2 + 1]};
      const cplx a1 = {S5A[(sdg * 64 + r + 32) * 2], S5A[(sdg * 64 + r + 32) * 2 + 1]};
      cplx a0_64 = a0, a1_64 = a1;
      _Pragma("unroll") for (int i = 0; i < 6; ++i) { a0_64 = cmul(a0_64, a0_64); a1_64 = cmul(a1_64, a1_64); }
      cplx c0 = {0.f, 0.f}, c1 = {0.f, 0.f};
      if (sample) {
        const float* h0 = p.in[2] + ((size_t)((bq * 2 + slot) * 2 + dir) * 2) * 4096 + g * 64;
        c0.re = h0[r]; c0.im = h0[4096 + r]; c1.re = h0[r + 32]; c1.im = h0[4096 + r + 32];
      }
      {
        const int ncar = dir ? nc - 1 - c : c;
        for (int j0 = 0; j0 < ncar; j0 += 8) {
          float2 va[8], vb[8];
#pragma unroll
          for (int j = 0; j < 8; ++j) {
            const int jj = min(j0 + j, ncar - 1);
            const int cc = dir ? nc - 1 - jj : jj;
            const float* ep = E + ((size_t)(((ck0 + cc) * 64 + g) * 2 + dir) * 64) * 2;
            va[j] = *(const float2*)(ep + r * 2); vb[j] = *(const float2*)(ep + (r + 32) * 2);
          }
#pragma unroll
          for (int j = 0; j < 8; ++j) if (j0 + j < ncar) {
            c0 = cfma(a0_64, c0, (cplx){va[j].x, va[j].y}); c1 = cfma(a1_64, c1, (cplx){vb[j].x, vb[j].y});
          }
        }
      }
      bf16x8 bfr[4], cfr[4];
      _Pragma("unroll") for (int ct = 0; ct < 4; ++ct) bfr[ct] = *(const bf16x8*)(BB + ((size_t)sdg * 128 + 32 * ct + r) * 16 + 8 * H);
      _Pragma("unroll") for (int ks = 0; ks < 4; ++ks) cfr[ks] = *(const bf16x8*)(CM + ((size_t)sdg * 16 + (lane & 15)) * 128 + 32 * ks + 8 * (lane >> 4));
      _Pragma("unroll") for (int t2 = 0; t2 < 2; ++t2) {
        const int tt = dir ? 1 - t2 : t2;
        f32x16 acc[4];
        bu_mfma4(acc[0], acc[1], acc[2], acc[3], uf[tt], bfr[0], bfr[1], bfr[2], bfr[3]);
        const int firstH = dir;
        cplx h0 = c0, h1 = c1;
        if (H == firstH) {
          if (dir == 0) { _Pragma("unroll") for (int i = 0; i < 16; ++i) { h0 = cfma(a0, h0, (cplx){acc[0][i], acc[2][i]}); h1 = cfma(a1, h1, (cplx){acc[1][i], acc[3][i]});
                            acc[0][i] = h0.re; acc[2][i] = h0.im; acc[1][i] = h1.re; acc[3][i] = h1.im; } }
          else { _Pragma("unroll") for (int i = 15; i >= 0; --i) { h0 = cfma(a0, h0, (cplx){acc[0][i], acc[2][i]}); h1 = cfma(a1, h1, (cplx){acc[1][i], acc[3][i]});
                            acc[0][i] = h0.re; acc[2][i] = h0.im; acc[1][i] = h1.re; acc[3][i] = h1.im; } }
        }
        h0 = shfl_c(h0, r + 32 * firstH); h1 = shfl_c(h1, r + 32 * firstH);
        if (H != firstH) {
          if (dir == 0) { _Pragma("unroll") for (int i = 0; i < 16; ++i) { h0 = cfma(a0, h0, (cplx){acc[0][i], acc[2][i]}); h1 = cfma(a1, h1, (cplx){acc[1][i], acc[3][i]});
                            acc[0][i] = h0.re; acc[2][i] = h0.im; acc[1][i] = h1.re; acc[3][i] = h1.im; } }
          else { _Pragma("unroll") for (int i = 15; i >= 0; --i) { h0 = cfma(a0, h0, (cplx){acc[0][i], acc[2][i]}); h1 = cfma(a1, h1, (cplx){acc[1][i], acc[3][i]});
                            acc[0][i] = h0.re; acc[2][i] = h0.im; acc[1][i] = h1.re; acc[3][i] = h1.im; } }
        }
        if (!sample && t2 == 1 && ((dir == 0 && c == nc - 1) || (dir == 1 && c == 0)) && H != firstH) {
          float* so = p.out + OUT_S5 + ((size_t)((bq * 2 + slot) * 2 + dir) * 2) * 4096 + g * 64;
          so[r] = h0.re; so[4096 + r] = h0.im; so[r + 32] = h1.re; so[4096 + r + 32] = h1.im;
        }
        c0 = shfl_c(h0, r + 32 * (1 - firstH)); c1 = shfl_c(h1, r + 32 * (1 - firstH));
        _Pragma("unroll") for (int i = 0; i < 16; ++i) {
          uint2 pk; pk.x = cvt_pk_bf16(acc[0][i], acc[2][i]); pk.y = cvt_pk_bf16(acc[1][i], acc[3][i]);
          *(uint2*)(ldsw + (16 * H + i) * 272 + 8 * r) = pk;
        }
        asm volatile("s_waitcnt lgkmcnt(0)" ::: "memory");
        _Pragma("unroll") for (int rt = 0; rt < 2; ++rt) _Pragma("unroll") for (int ks = 0; ks < 4; ++ks) {
          const bf16x8 af = *(const bf16x8*)(ldsw + (16 * rt + (lane & 15)) * 272 + (32 * ks + 8 * (lane >> 4)) * 2);
          yacc[tt][rt] = __builtin_amdgcn_mfma_f32_16x16x32_bf16(af, cfr[ks], yacc[tt][rt], 0, 0, 0);
        }
        asm volatile("s_waitcnt lgkmcnt(0)" ::: "memory");
      }
    }
    asm volatile("s_nop 15" : "+v"(yacc[0][0]), "+v"(yacc[0][1]), "+v"(yacc[1][0]), "+v"(yacc[1][1]));
    const int ch = lane & 15, col = g * 16 + ch;
    const float dsk = Dsk[col];
    _Pragma("unroll") for (int tt = 0; tt < 2; ++tt) _Pragma("unroll") for (int rt = 0; rt < 2; ++rt) _Pragma("unroll") for (int j = 0; j < 4; ++j) {
      const int token = tok0 + 32 * tt + 16 * rt + 4 * (lane >> 4) + j;
      bf16_t* hp = HB + (size_t)token * D + col;
      const float u = bf2f(*hp);
      const float y = yacc[tt][rt][j] + u * dsk;
      const float z = 0.7978845608028654f * (y + 0.044715f * y * y * y);
      const float th = 1.f - 2.f / (__expf(2.f * z) + 1.f);
      *hp = f2bf(0.5f * y * (1.f + th));
    }
  }
}

constexpr float LOG2E = 1.4426950408889634f;

__device__ void phase_post_na(const Params& p) {
  const int tid_ = opaque_tid(); const int lane = tid_ & 63, wave = tid_ >> 6;
  bf16_t* QK = (bf16_t*)(p.ws + WS_QK);
  const float* qn = p.in[25]; const float* kn = p.in[26];
  const float qs = 0.125f * LOG2E;
  const int d0 = (lane & 3) * 16;
  for (int row = blockIdx.x * 8 + wave; row < NTOK; row += gridDim.x * 8) {
    _Pragma("unroll") for (int part = 0; part < 2; ++part) {
      bf16_t* ptr = QK + (size_t)row * 2048 + part * 1024 + lane * 16;
      uint4 a = *(uint4*)ptr, b = *(uint4*)(ptr + 8);
      unsigned w[8] = {a.x, a.y, a.z, a.w, b.x, b.y, b.z, b.w};
      float v[16]; float ss = 0.f;
      _Pragma("unroll") for (int i = 0; i < 8; ++i) { v[2 * i] = bflo(w[i]); v[2 * i + 1] = bfhi(w[i]); }
      _Pragma("unroll") for (int i = 0; i < 16; ++i) ss += v[i] * v[i];
      ss += __shfl_xor(ss, 1); ss += __shfl_xor(ss, 2);
      const float rstd = rsqrtf(ss * (1.f / 64.f) + 1e-6f);
      const float* nw = part ? kn : qn;
      const float sc = part ? 1.f : qs;
      float o[16];
      _Pragma("unroll") for (int i = 0; i < 16; ++i) o[i] = v[i] * rstd * nw[d0 + i];
      if (part == 1 && row < 4096) {
        float* op = p.out + OUT_NAK + (size_t)row * 1024 + lane * 16;
        _Pragma("unroll") for (int i = 0; i < 4; ++i) *(f32x4*)(op + 4 * i) = (f32x4){o[4 * i], o[4 * i + 1], o[4 * i + 2], o[4 * i + 3]};
      }
      _Pragma("unroll") for (int i = 0; i < 8; ++i) w[i] = cvt_pk_bf16(o[2 * i] * sc, o[2 * i + 1] * sc);
      *(uint4*)ptr = make_uint4(w[0], w[1], w[2], w[3]); *(uint4*)(ptr + 8) = make_uint4(w[4], w[5], w[6], w[7]);
    }
  }
}

__device__ void phase_post_gqa(const Params& p) {
  const int tid_ = opaque_tid(); const int lane = tid_ & 63, wave = tid_ >> 6;
  bf16_t* QK = (bf16_t*)(p.ws + WS_QK);
  const float* qn = p.in[30]; const float* kn = p.in[31];
  const float qs = 0.08838834764831845f * LOG2E;
  for (int row = blockIdx.x * 8 + wave; row < NTOK; row += gridDim.x * 8) {
    const bool sample = row >= 4096;
    const int t = (row - 4096) & 1023;
    const float prow = (float)(t >> 6), pcol = (float)(t & 63);
    {
      const int i0 = (lane & 7) * 8;
      bf16_t* ptr = QK + (size_t)row * 1280 + (lane >> 3) * 128 + i0;
      uint4 a = *(uint4*)ptr, b = *(uint4*)(ptr + 64);
      unsigned wa[4] = {a.x, a.y, a.z, a.w}, wb[4] = {b.x, b.y, b.z, b.w};
      float x1[8], x2[8]; float ss = 0.f;
      _Pragma("unroll") for (int i = 0; i < 4; ++i) { x1[2 * i] = bflo(wa[i]); x1[2 * i + 1] = bfhi(wa[i]); x2[2 * i] = bflo(wb[i]); x2[2 * i + 1] = bfhi(wb[i]); }
      _Pragma("unroll") for (int i = 0; i < 8; ++i) ss += x1[i] * x1[i] + x2[i] * x2[i];
      ss += __shfl_xor(ss, 1); ss += __shfl_xor(ss, 2); ss += __shfl_xor(ss, 4);
      const float rstd = rsqrtf(ss * (1.f / 128.f) + 1e-6f);
      _Pragma("unroll") for (int i = 0; i < 8; ++i) { x1[i] *= rstd * qn[i0 + i]; x2[i] *= rstd * qn[64 + i0 + i]; }
      if (sample) {
        _Pragma("unroll") for (int i = 0; i < 8; ++i) {
          const int pi = i0 + i;
          const float inv = exp2f(-(float)(pi & 31) * (13.287712379549449f / 32.f));
          const float ang = (pi < 32 ? prow : pcol) * inv;
          const float cs = cosf(ang), sn = sinf(ang);
          const float y1 = x1[i] * cs - x2[i] * sn, y2 = x1[i] * sn + x2[i] * cs;
          x1[i] = y1; x2[i] = y2;
        }
      }
      _Pragma("unroll") for (int i = 0; i < 4; ++i) { wa[i] = cvt_pk_bf16(x1[2 * i] * qs, x1[2 * i + 1] * qs); wb[i] = cvt_pk_bf16(x2[2 * i] * qs, x2[2 * i + 1] * qs); }
      *(uint4*)ptr = make_uint4(wa[0], wa[1], wa[2], wa[3]); *(uint4*)(ptr + 64) = make_uint4(wb[0], wb[1], wb[2], wb[3]);
    }
    {
      const int i0 = (lane & 31) * 2;
      bf16_t* ptr = QK + (size_t)row * 1280 + 1024 + (lane >> 5) * 128 + i0;
      unsigned wa = *(unsigned*)ptr, wb = *(unsigned*)(ptr + 64);
      float x1[2] = {bflo(wa), bfhi(wa)}, x2[2] = {bflo(wb), bfhi(wb)};
      float ss = x1[0] * x1[0] + x1[1] * x1[1] + x2[0] * x2[0] + x2[1] * x2[1];
      _Pragma("unroll") for (int o = 1; o < 32; o <<= 1) ss += __shfl_xor(ss, o);
      const float rstd = rsqrtf(ss * (1.f / 128.f) + 1e-6f);
      _Pragma("unroll") for (int i = 0; i < 2; ++i) { x1[i] *= rstd * kn[i0 + i]; x2[i] *= rstd * kn[64 + i0 + i]; }
      if (!sample) {
        float* op = p.out + OUT_GQAK + (size_t)row * 256 + (lane >> 5) * 128 + i0;
        *(float2*)op = make_float2(x1[0], x1[1]); *(float2*)(op + 64) = make_float2(x2[0], x2[1]);
      } else {
        _Pragma("unroll") for (int i = 0; i < 2; ++i) {
          const int pi = i0 + i;
          const float inv = exp2f(-(float)(pi & 31) * (13.287712379549449f / 32.f));
          const float ang = (pi < 32 ? prow : pcol) * inv;
          const float cs = cosf(ang), sn = sinf(ang);
          const float y1 = x1[i] * cs - x2[i] * sn, y2 = x1[i] * sn + x2[i] * cs;
          x1[i] = y1; x2[i] = y2;
        }
      }
      *(unsigned*)ptr = cvt_pk_bf16(x1[0], x1[1]); *(unsigned*)(ptr + 64) = cvt_pk_bf16(x2[0], x2[1]);
    }
  }
}

template <int DH, bool NAL>
__device__ __forceinline__ void attn_wave(const bf16_t* Q, int ldq,
                                          const bf16_t* K0, int ldk0, const bf16_t* V0, int ldv0, int n0,
                                          const bf16_t* K1, int ldk1, const bf16_t* V1, int ldv1, int n1,
                                          bf16_t* O, int ldo, const float* rpb_h, int rr, int rs, int qc0) {
  constexpr int KS = DH / 32, DT = DH / 16;
  const int lane = opaque_tid() & 63, fr = lane & 15, g = lane >> 4;
  bf16x8 qf[2][KS];
  _Pragma("unroll") for (int qg = 0; qg < 2; ++qg) _Pragma("unroll") for (int ks = 0; ks < KS; ++ks) qf[qg][ks] = *(const bf16x8*)(Q + (size_t)(qg * 16 + fr) * ldq + ks * 32 + 8 * g);
  f32x4 o[2][DT];
  _Pragma("unroll") for (int qg = 0; qg < 2; ++qg) _Pragma("unroll") for (int dt = 0; dt < DT; ++dt) o[qg][dt] = (f32x4){0.f, 0.f, 0.f, 0.f};
  float lsum[2] = {0.f, 0.f};
  const int krow_in = 8 * (fr >> 2) + (fr & 3);
  const int nch = (n0 + n1) >> 5;
  for (int c = 0; c < nch; ++c) {
    const bool s1 = (c * 32 >= n0);
    const int kc = s1 ? c * 32 - n0 : c * 32;
    const bf16_t* K = s1 ? K1 : K0; const int ldk = s1 ? ldk1 : ldk0;
    const bf16_t* V = s1 ? V1 : V0; const int ldv = s1 ? ldv1 : ldv0;
    bf16x8 kf[2][KS], vf[DT];
    _Pragma("unroll") for (int t = 0; t < 2; ++t) _Pragma("unroll") for (int ks = 0; ks < KS; ++ks) kf[t][ks] = *(const bf16x8*)(K + (size_t)(kc + krow_in + 4 * t) * ldk + ks * 32 + 8 * g);
    _Pragma("unroll") for (int dt = 0; dt < DT; ++dt) vf[dt] = *(const bf16x8*)(V + (size_t)(16 * dt + fr) * ldv + kc + 8 * g);
    f32x4 s[2][2];
    _Pragma("unroll") for (int qg = 0; qg < 2; ++qg) _Pragma("unroll") for (int t = 0; t < 2; ++t) {
      s[qg][t] = (f32x4){0.f, 0.f, 0.f, 0.f};
      _Pragma("unroll") for (int ks = 0; ks < KS; ++ks) s[qg][t] = __builtin_amdgcn_mfma_f32_16x16x32_bf16(kf[t][ks], qf[qg][ks], s[qg][t], 0, 0, 0);
    }
    asm volatile("s_nop 15" : "+v"(s[0][0]), "+v"(s[0][1]), "+v"(s[1][0]), "+v"(s[1][1]));
    bf16x8 pf[2];
    _Pragma("unroll") for (int qg = 0; qg < 2; ++qg) {
      float pv[8];
      _Pragma("unroll") for (int i = 0; i < 8; ++i) {
        float sv = s[qg][i >> 2][i & 3];
        if (NAL && !s1) {
          const int krow = rs + (kc >> 6), kcol = (kc & 63) + 8 * g + i;
          const int qc = qc0 + qg * 16 + fr;
          const int cs = min(max(qc - 8, 0), 48);
          const bool valid = (kcol >= cs) && (kcol < cs + 16);
          const int bi = valid ? (krow - rr + 7) * 31 + (kcol - qc + 15) : 0;
          const float bias = rpb_h[bi];
          pv[i] = valid ? __builtin_amdgcn_exp2f(sv + bias * LOG2E) : 0.f;
        } else {
          pv[i] = __builtin_amdgcn_exp2f(sv);
        }
        lsum[qg] += pv[i];
      }
      union { bf16x8 v; unsigned u[4]; } pk;
      _Pragma("unroll") for (int i = 0; i < 4; ++i) pk.u[i] = cvt_pk_bf16(pv[2 * i], pv[2 * i + 1]);
      pf[qg] = pk.v;
    }
    asm volatile("s_nop 3" : "+v"(pf[0]), "+v"(pf[1]));
    _Pragma("unroll") for (int qg = 0; qg < 2; ++qg) _Pragma("unroll") for (int dt = 0; dt < DT; ++dt)
      o[qg][dt] = __builtin_amdgcn_mfma_f32_16x16x32_bf16(vf[dt], pf[qg], o[qg][dt], 0, 0, 0);
  }
  _Pragma("unroll") for (int qg = 0; qg < 2; ++qg) _Pragma("unroll") for (int dt = 0; dt < DT; ++dt) asm volatile("s_nop 7" : "+v"(o[qg][dt]));
  _Pragma("unroll") for (int qg = 0; qg < 2; ++qg) {
    float l = lsum[qg];
    l += __shfl_xor(l, 16); l += __shfl_xor(l, 32);
    const float inv = 1.f / l;
    _Pragma("unroll") for (int dt = 0; dt < DT; ++dt) {
      uint2 pk; pk.x = cvt_pk_bf16(o[qg][dt][0] * inv, o[qg][dt][1] * inv); pk.y = cvt_pk_bf16(o[qg][dt][2] * inv, o[qg][dt][3] * inv);
      *(uint2*)(O + (size_t)(qg * 16 + fr) * ldo + 16 * dt + 4 * g) = pk;
    }
  }
}

__device__ void phase_attn_na(const Params& p) {
  const int wave = opaque_tid() >> 6;
  const bf16_t* QK = (const bf16_t*)(p.ws + WS_QK);
  const bf16_t* VT = (const bf16_t*)(p.ws + WS_VT);
  const bf16_t* CK = (const bf16_t*)(p.ws + WS_CKNA);
  const bf16_t* CVT = (const bf16_t*)(p.ws + WS_CVTNA);
  bf16_t* AO = (bf16_t*)(p.ws + WS_AO);
  for (int gw = blockIdx.x * 8 + wave; gw < 4096; gw += gridDim.x * 8) {
    if (gw < 2048) {
      const int wq = gw & 1, r = (gw >> 1) & 15, h = (gw >> 5) & 15, b = gw >> 9;
      const int rs = min(max(r - 4, 0), 8);
      const int tokq = 4096 + b * 1024 + r * 64 + wq * 32;
      const int tokk = 4096 + b * 1024 + rs * 64;
      attn_wave<64, true>(QK + (size_t)tokq * 2048 + h * 64, 2048,
                          QK + (size_t)tokk * 2048 + 1024 + h * 64, 2048,
                          VT + (size_t)4096 * 1024 + ((size_t)b * 1024 + h * 64) * 1024 + rs * 64, 1024, 512,
                          CK + (size_t)b * 512 * 1024 + h * 64, 1024,
                          CVT + ((size_t)b * 1024 + h * 64) * 512, 512, 512,
                          AO + (size_t)tokq * 1024 + h * 64, 1024,
                          p.in[27] + h * 15 * 31, r, rs, wq * 32);
    } else {
      const int id = gw - 2048, qb = id & 7, h = (id >> 3) & 15, b = id >> 7;
      const int tokq = b * 256 + qb * 32;
      attn_wave<64, false>(QK + (size_t)tokq * 2048 + h * 64, 2048,
                           QK + (size_t)(b * 256) * 2048 + 1024 + h * 64, 2048,
                           VT + ((size_t)b * 1024 + h * 64) * 256, 256, 256,
                           nullptr, 0, nullptr, 0, 0,
                           AO + (size_t)tokq * 1024 + h * 64, 1024, nullptr, 0, 0, 0);
    }
  }
}

__device__ __forceinline__ void attn_block_gqa_latent(const bf16_t* Q, const bf16_t* K0, const bf16_t* V0, const bf16_t* K1, const bf16_t* V1, bf16_t* O) {
  constexpr int DH = 128, KS = 4, DT = 8, KROW = 272, VROW = 80, KBUF = 32 * KROW, VBUF = 128 * VROW, NCH = 48;
  const int tid = opaque_tid(), lane = tid & 63, wave = tid >> 6, fr = lane & 15, g = lane >> 4;
  unsigned char* kS = smem;
  unsigned char* vS = smem + 2 * KBUF;
  const bf16_t* Qw = Q + (size_t)(wave * 32) * 1280;
  bf16x8 qf[2][KS];
  _Pragma("unroll") for (int qg = 0; qg < 2; ++qg) _Pragma("unroll") for (int ks = 0; ks < KS; ++ks) qf[qg][ks] = *(const bf16x8*)(Qw + (size_t)(qg * 16 + fr) * 1280 + ks * 32 + 8 * g);
  f32x4 o[2][DT];
  _Pragma("unroll") for (int qg = 0; qg < 2; ++qg) _Pragma("unroll") for (int dt = 0; dt < DT; ++dt) o[qg][dt] = (f32x4){0.f, 0.f, 0.f, 0.f};
  float lsum[2] = {0.f, 0.f};
  const int krow_in = 8 * (fr >> 2) + (fr & 3);
  const int skey = tid >> 4, skp = tid & 15, sd = tid >> 2, svp = tid & 3;
  uint4 rk, rv;
#define LD_CHUNK(c_) do { const int kc_ = (c_) * 32; \
    if (kc_ < 1024) { rk = *(const uint4*)(K0 + (size_t)(kc_ + skey) * 1280 + skp * 8); rv = *(const uint4*)(V0 + (size_t)sd * 1024 + kc_ + svp * 8); } \
    else { rk = *(const uint4*)(K1 + (size_t)(kc_ - 1024 + skey) * 256 + skp * 8); rv = *(const uint4*)(V1 + (size_t)sd * 512 + (kc_ - 1024) + svp * 8); } } while (0)
#define ST_CHUNK(buf_) do { *(uint4*)(kS + (buf_) * KBUF + skey * KROW + skp * 16) = rk; *(uint4*)(vS + (buf_) * VBUF + sd * VROW + svp * 16) = rv; } while (0)
  __syncthreads();
  LD_CHUNK(0); ST_CHUNK(0);
  __syncthreads();
  for (int c = 0; c < NCH; ++c) {
    const int buf = c & 1;
    if (c + 1 < NCH) LD_CHUNK(c + 1);
    const unsigned char* kb = kS + buf * KBUF; const unsigned char* vb = vS + buf * VBUF;
    bf16x8 kf[2][KS], vf[DT];
    _Pragma("unroll") for (int t = 0; t < 2; ++t) _Pragma("unroll") for (int ks = 0; ks < KS; ++ks) kf[t][ks] = *(const bf16x8*)(kb + (krow_in + 4 * t) * KROW + (ks * 32 + 8 * g) * 2);
    _Pragma("unroll") for (int dt = 0; dt < DT; ++dt) vf[dt] = *(const bf16x8*)(vb + (16 * dt + fr) * VROW + 16 * g);
    f32x4 s[2][2];
    _Pragma("unroll") for (int qg = 0; qg < 2; ++qg) _Pragma("unroll") for (int t = 0; t < 2; ++t) {
      s[qg][t] = (f32x4){0.f, 0.f, 0.f, 0.f};
      _Pragma("unroll") for (int ks = 0; ks < KS; ++ks) s[qg][t] = __builtin_amdgcn_mfma_f32_16x16x32_bf16(kf[t][ks], qf[qg][ks], s[qg][t], 0, 0, 0);
    }
    asm volatile("s_nop 15" : "+v"(s[0][0]), "+v"(s[0][1]), "+v"(s[1][0]), "+v"(s[1][1]));
    bf16x8 pf[2];
    _Pragma("unroll") for (int qg = 0; qg < 2; ++qg) {
      float pv[8];
      _Pragma("unroll") for (int i = 0; i < 8; ++i) { pv[i] = __builtin_amdgcn_exp2f(s[qg][i >> 2][i & 3]); lsum[qg] += pv[i]; }
      union { bf16x8 v; unsigned u[4]; } pk;
      _Pragma("unroll") for (int i = 0; i < 4; ++i) pk.u[i] = cvt_pk_bf16(pv[2 * i], pv[2 * i + 1]);
      pf[qg] = pk.v;
    }
    asm volatile("s_nop 3" : "+v"(pf[0]), "+v"(pf[1]));
    _Pragma("unroll") for (int qg = 0; qg < 2; ++qg) _Pragma("unroll") for (int dt = 0; dt < DT; ++dt)
      o[qg][dt] = __builtin_amdgcn_mfma_f32_16x16x32_bf16(vf[dt], pf[qg], o[qg][dt], 0, 0, 0);
    if (c + 1 < NCH) ST_CHUNK(buf ^ 1);
    __syncthreads();
  }
#undef LD_CHUNK
#undef ST_CHUNK
  _Pragma("unroll") for (int qg = 0; qg < 2; ++qg) _Pragma("unroll") for (int dt = 0; dt < DT; ++dt) asm volatile("s_nop 7" : "+v"(o[qg][dt]));
  bf16_t* Ow = O + (size_t)(wave * 32) * 1024;
  _Pragma("unroll") for (int qg = 0; qg < 2; ++qg) {
    float l = lsum[qg];
    l += __shfl_xor(l, 16); l += __shfl_xor(l, 32);
    const float inv = 1.f / l;
    _Pragma("unroll") for (int dt = 0; dt < DT; ++dt) {
      uint2 pk; pk.x = cvt_pk_bf16(o[qg][dt][0] * inv, o[qg][dt][1] * inv); pk.y = cvt_pk_bf16(o[qg][dt][2] * inv, o[qg][dt][3] * inv);
      *(uint2*)(Ow + (size_t)(qg * 16 + fr) * 1024 + 16 * dt + 4 * g) = pk;
    }
  }
}

__device__ void phase_attn_gqa(const Params& p) {
  const int wave = opaque_tid() >> 6;
  const bf16_t* QK = (const bf16_t*)(p.ws + WS_QK);
  const bf16_t* VT = (const bf16_t*)(p.ws + WS_VT);
  const bf16_t* CK = (const bf16_t*)(p.ws + WS_CKGQA);
  const bf16_t* CVT = (const bf16_t*)(p.ws + WS_CVTGQA);
  bf16_t* AO = (bf16_t*)(p.ws + WS_AO);
  const int G = gridDim.x, nlat = G >= 256 ? 128 : G / 2;
  if ((int)blockIdx.x < nlat) {
    for (int id = blockIdx.x; id < 128; id += nlat) {
      const int qblk = id & 3, hq = (id >> 2) & 7, b = id >> 5, hk = hq >> 2;
      const int tokq = 4096 + b * 1024 + qblk * 256;
      attn_block_gqa_latent(QK + (size_t)tokq * 1280 + hq * 128,
                            QK + (size_t)(4096 + b * 1024) * 1280 + 1024 + hk * 128,
                            VT + (size_t)4096 * 256 + ((size_t)b * 256 + hk * 128) * 1024,
                            CK + (size_t)b * 512 * 256 + hk * 128,
                            CVT + ((size_t)b * 256 + hk * 128) * 512,
                            AO + (size_t)tokq * 1024 + hq * 128);
    }
  } else {
    const int nw = (G - nlat) * 8;
    for (int id = ((int)blockIdx.x - nlat) * 8 + wave; id < 1024; id += nw) {
      const int qb = id & 7, hq = (id >> 3) & 7, b = id >> 6, hk = hq >> 2;
      const int tokq = b * 256 + qb * 32;
      attn_wave<128, false>(QK + (size_t)tokq * 1280 + hq * 128, 1280,
                            QK + (size_t)(b * 256) * 1280 + 1024 + hk * 128, 1280,
                            VT + ((size_t)b * 256 + hk * 128) * 256, 256, 256,
                            nullptr, 0, nullptr, 0, 0,
                            AO + (size_t)tokq * 1024 + hq * 128, 1024, nullptr, 0, 0, 0);
    }
  }
}

#define XB_TMO      128
#define XB_XCNT(j)  (256  + 64 * (j))
#define XB_XSUB(j)  (1280 + 64 * (j))
#define XB_XGEN(j)  (2304 + 64 * (j))
#define XB_TOP      3328
#define XB_TOPGEN   3392
#define XCD_BAR_WORDS 3456
#define XB_SPIN_CAP (1u << 18)
#define LAS __attribute__((address_space(3)))

__device__ __forceinline__ unsigned xb_ld(unsigned* p)              { return __hip_atomic_load(p, __ATOMIC_RELAXED, __HIP_MEMORY_SCOPE_AGENT); }
__device__ __forceinline__ unsigned xb_add(unsigned* p, unsigned v) { return __hip_atomic_fetch_add(p, v, __ATOMIC_RELAXED, __HIP_MEMORY_SCOPE_AGENT); }
__device__ __forceinline__ unsigned xb_xcc_id() { return (unsigned)__builtin_amdgcn_s_getreg((3 << 11) | 20) & 0xFu; }
#define XB_SPIN(cond, bar) do { unsigned _sp = 0; while (cond) { __builtin_amdgcn_s_sleep(1); \
    if ((++_sp & 255u) == 0u) { if (xb_ld(&(bar)[XB_TMO])) break; if (_sp > XB_SPIN_CAP) { atomicAdd(&(bar)[XB_TMO], 1u); break; } } } } while (0)

struct XcdBarrier {
    unsigned* bar; unsigned x;
    volatile LAS unsigned* st;
};

__device__ __forceinline__ XcdBarrier xcd_barrier_post(unsigned* bar, volatile LAS unsigned* st) {
    XcdBarrier b; b.bar = bar; b.x = xb_xcc_id(); b.st = st;
    if (threadIdx.x == 0) (void)xb_add(&bar[XB_XCNT(b.x)], 1u);
    return b;
}
__device__ __forceinline__ void xcd_barrier_complete(unsigned* bar, unsigned x, unsigned& nloc, unsigned& nx) {
    const unsigned G = gridDim.x * gridDim.y * gridDim.z;
    unsigned sum, cnt, mine, sp = 0u;
    for (;;) {
        sum = 0u; cnt = 0u; mine = 0u;
#pragma unroll
        for (unsigned j = 0; j < 16; ++j) { const unsigned c = xb_ld(&bar[XB_XCNT(j)]); sum += c; cnt += (c > 0u) ? 1u : 0u; mine = (j == x) ? c : mine; }
        if (sum == G) break;
        __builtin_amdgcn_s_sleep(1);
        if ((++sp & 255u) == 0u) { if (xb_ld(&bar[XB_TMO])) break; if (sp > XB_SPIN_CAP) { atomicAdd(&bar[XB_TMO], 1u); break; } }
    }
    nloc = mine > 0u ? mine : 1u; nx = cnt > 0u ? cnt : 1u;
}

__device__ __forceinline__ void xcd_barrier(const XcdBarrier& b) {
    asm volatile("s_waitcnt vmcnt(0)" ::: "memory");
    __syncthreads();
    if (threadIdx.x == 0) {
        unsigned* bar = b.bar; unsigned xb_probe = 0u;
        __builtin_amdgcn_s_waitcnt(0);
        unsigned nloc = b.st[0], nx = b.st[1];
        if (nloc == 0u) { xcd_barrier_complete(bar, b.x, nloc, nx); b.st[0] = nloc; b.st[1] = nx; }
        const unsigned old = xb_add(&bar[XB_XSUB(b.x)], 1u);
        const unsigned gen = old / nloc;
        if (old + 1u == (gen + 1u) * nloc) {
            __builtin_amdgcn_fence(__ATOMIC_RELEASE, "agent");
            asm volatile("s_waitcnt vmcnt(0)" ::: "memory");
            const unsigned og = xb_add(&bar[XB_TOP], 1u);
            const unsigned tg = og / nx;
            if (og + 1u == (tg + 1u) * nx) xb_add(&bar[XB_TOPGEN], 1u);
            else XB_SPIN(xb_ld(&bar[XB_TOPGEN]) == tg, bar);
            __builtin_amdgcn_fence(__ATOMIC_ACQUIRE, "agent"); xb_probe = xb_ld(&bar[XB_TMO]);
            xb_add(&bar[XB_XGEN(b.x)], 1u);
            asm volatile("s_waitcnt vmcnt(0)" ::: "memory");
        } else {
            XB_SPIN(xb_ld(&bar[XB_XGEN(b.x)]) == gen, bar);
            __builtin_amdgcn_fence(__ATOMIC_ACQUIRE, "agent"); xb_probe = xb_ld(&bar[XB_TMO]);
            asm volatile("s_waitcnt vmcnt(0)" ::: "memory");
        }
        asm volatile("" :: "v"(xb_probe));
        __builtin_amdgcn_s_sleep(80);
    }
    __syncthreads();
}


__device__ void phase_fake_mlp1(const Params& p) {
  const int tid = opaque_tid();
  const uint4* HB = (const uint4*)(p.ws + WS_HB);
  uint4* ACT = (uint4*)(p.ws + WS_ACT);
  for (size_t i = (size_t)blockIdx.x * NT + tid; i < (size_t)NTOK * DFF / 8; i += (size_t)gridDim.x * NT) {
    const size_t row = i >> 9, c8 = i & 511;
    uint4 v = HB[row * 128 + (c8 & 127)];
    unsigned w[4] = {v.x, v.y, v.z, v.w};
    for (int j = 0; j < 4; ++j) { float a = bflo(w[j]), b = bfhi(w[j]); w[j] = cvt_pk_bf16(a * a, b * b); }
    ACT[i] = make_uint4(w[0], w[1], w[2], w[3]);
  }
}
__global__ void __launch_bounds__(NT) fwd_megakernel(Params p) {
  cg::grid_group grid = cg::this_grid();
  unsigned char* ws = p.ws;
  const float* MOD = (const float*)(ws + WS_MOD);
  bf16_t* HB = (bf16_t*)(ws + WS_HB);
  bf16_t* AO = (bf16_t*)(ws + WS_AO);
  bf16_t* QK = (bf16_t*)(ws + WS_QK);
  bf16_t* VT = (bf16_t*)(ws + WS_VT);
  bf16_t* ACT = (bf16_t*)(ws + WS_ACT);
  int ph = 0;
#ifdef CHK_INPUT
  { float* chk = (float*)(ws + WS_END);
    const int t = opaque_tid();
    const float* sp = p.in[CHK_INPUT];
    const size_t per = (size_t)CHK_COUNT / gridDim.x;
    float s = 0.f;
    for (size_t i = t; i < per; i += NT) { float v = sp[(size_t)blockIdx.x * per + i]; s += v * (1.f + (float)(i & 15)); }
    float* red = (float*)smem; red[t] = s; __syncthreads();
    if (t == 0) { float a = 0.f; for (int i = 0; i < NT; ++i) a += red[i]; chk[blockIdx.x] = a; }
    __syncthreads(); }
#endif
#ifdef START_DELAY_TICKS
  { const unsigned long long t0 = __builtin_amdgcn_s_memrealtime(); while (__builtin_amdgcn_s_memrealtime() - t0 < START_DELAY_TICKS) __builtin_amdgcn_s_sleep(8); }
#endif
  volatile LAS unsigned* xb_st = (volatile LAS unsigned*)(smem + 131072);
  if (threadIdx.x < 2) xb_st[threadIdx.x] = 0u;
  __syncthreads();
  XcdBarrier xbar = xcd_barrier_post((unsigned*)(ws + WS_BAR), xb_st);
  if (p.ph_hi - p.ph_lo > 1) grid.sync();
#ifdef EXTRA_SYNCS
  for (int i_ = 0; i_ < EXTRA_SYNCS; ++i_) grid.sync();
#endif
#ifndef EN_GEMM
#define EN_GEMM 15
#endif
#ifndef EN_ATTN
#define EN_ATTN 1
#endif
#ifndef EN_S5
#define EN_S5 1
#endif
#ifndef EN_MISC
#define EN_MISC 1
#endif
#define RUN(body) do { if (p.ph_lo <= ph && ph < p.ph_hi) { body; if (ph + 1 < p.ph_hi) xcd_barrier(xbar); } ++ph; } while (0)

  RUN(if (EN_MISC) phase_prologue(p));
  for (int layer = 0; layer < 4; ++layer) {
    const int kind = layer % 3, slot = layer / 3;
    RUN(if (EN_MISC) phase_norm(p, layer, 0, layer == 0));
    if (kind == 0) {
      RUN(if (EN_S5) phase_s5_pass1(p, slot));
      RUN(if (EN_S5) phase_s5_pass2(p, slot));
      { GemmArgs ga{HB, D, (const bf16_t*)(ws + WS_GLUT) + (size_t)slot * 2048 * 1024, D, 32, 16, 1024, 0xffff};
        EpiGlu e{p.out, MOD + layer * 5 * 6144 + 2 * 1024, p.in[23] + slot * 2048};
        RUN(if (EN_GEMM & 1) gemm_phase<128>(ga, e)); }
    } else if (kind == 1) {
      { GemmArgs ga{HB, D, (const bf16_t*)(ws + WS_NAQKVT), D, 32, 24, 1024, 0xffff};
        EpiQkv e{QK, 2048, VT, 1024, p.out + OUT_NAV};
        RUN(if (EN_GEMM & 2) gemm_phase<128>(ga, e)); }
      RUN(if (EN_MISC) phase_post_na(p));
      RUN(if (EN_ATTN) phase_attn_na(p));
      { GemmArgs ga{AO, D, (const bf16_t*)(ws + WS_NAOT), D, 32, 8, 1024, 0xffff};
        EpiResid e{p.out, MOD + layer * 5 * 6144 + 2 * 1024};
        RUN(if (EN_GEMM & 4) gemm_phase<128>(ga, e)); }
    } else {
      { GemmArgs ga{HB, D, (const bf16_t*)(ws + WS_GQAQKVT), D, 32, 12, 1024, 0xffff};
        EpiQkv e{QK, 1280, VT, 256, p.out + OUT_GQAV};
        RUN(if (EN_GEMM & 2) gemm_phase<128>(ga, e)); }
      RUN(if (EN_MISC) phase_post_gqa(p));
      RUN(if (EN_ATTN) phase_attn_gqa(p));
      { GemmArgs ga{AO, D, (const bf16_t*)(ws + WS_GQAOT), D, 32, 8, 1024, 0xffff};
        EpiResid e{p.out, MOD + layer * 5 * 6144 + 2 * 1024};
        RUN(if (EN_GEMM & 4) gemm_phase<128>(ga, e)); }
    }
    RUN(if (EN_MISC) phase_norm(p, layer, 1, false));
    { GemmArgs ga{HB, D, (const bf16_t*)(ws + WS_W1T) + (size_t)layer * 4096 * 1024, D, 32, 16, 1024, 0xffff};
      EpiSqRelu e{ACT};
      RUN(if (EN_GEMM & 8) gemm_phase<256>(ga, e)); }
    { GemmArgs ga{ACT, DFF, (const bf16_t*)(ws + WS_W2T) + (size_t)layer * 1024 * 4096, DFF, 32, 8, 4096, 0xffff};
      EpiResid e{p.out, MOD + layer * 5 * 6144 + 5 * 1024};
      RUN(if (EN_GEMM & 4) gemm_phase<128>(ga, e)); }
  }
#ifdef FINAL_SYNC
  if (p.ph_hi - p.ph_lo > 1) { grid.sync(); { const unsigned long long t0 = __builtin_amdgcn_s_memrealtime(); while (__builtin_amdgcn_s_memrealtime() - t0 < 2000ull) __builtin_amdgcn_s_sleep(8); } grid.sync(); }
#endif
#ifdef DUMP_S5P
  if (p.ph_hi - p.ph_lo > 1) {
    grid.sync();
    const float* sa = (const float*)(ws + WS_S5A);
    const unsigned* sb = (const unsigned*)(ws + WS_S5BB);
    const unsigned* sc = (const unsigned*)(ws + WS_S5CM);
    for (size_t i = (size_t)blockIdx.x * NT + opaque_tid(); i < 524288; i += (size_t)gridDim.x * NT) {
      if (i < 32768) p.out[i] = sa[i];
      unsigned w = sb[i]; p.out[65536 + 2 * i] = bflo(w); p.out[65536 + 2 * i + 1] = bfhi(w);
      unsigned w2 = sc[i]; p.out[2097152 + 2 * i] = bflo(w2); p.out[2097152 + 2 * i + 1] = bfhi(w2);
    }
  }
#endif
#ifdef DUMP_E
  if (p.ph_hi - p.ph_lo > 1) {
    grid.sync();
    const float* sp = (const float*)(ws + WS_S5E);
    for (size_t i = (size_t)blockIdx.x * NT + opaque_tid(); i < 2097152; i += (size_t)gridDim.x * NT) p.out[i] = sp[i];
  }
#endif
#ifdef DUMP_HB
  if (p.ph_hi - p.ph_lo > 1) {
    grid.sync();
    const unsigned* sp = (const unsigned*)(ws + WS_HB);
    for (size_t i = (size_t)blockIdx.x * NT + opaque_tid(); i < 4194304; i += (size_t)gridDim.x * NT) {
      unsigned w = sp[i]; p.out[2 * i] = bflo(w); p.out[2 * i + 1] = bfhi(w);
    }
  }
#endif
#ifdef DUMP_W2T
  if (p.ph_lo == 100) {
    const unsigned* sp = (const unsigned*)(ws + WS_W2T);
    for (size_t i = (size_t)blockIdx.x * NT + opaque_tid(); i < 19398656 / 2; i += (size_t)gridDim.x * NT) {
      float a = 0.f, b = 0.f;
      if (i < 2097152) { unsigned w = sp[i]; a = bflo(w); b = bfhi(w); }
      p.out[2 * i] = a; p.out[2 * i + 1] = b;
    }
  }
#endif
#undef RUN
#ifdef CHK_W2T
  grid.sync();
  { float* chk = (float*)(ws + WS_END);
    const int t = opaque_tid();
    const unsigned* sp = (const unsigned*)(ws + WS_W2T);
    const size_t per = (size_t)(33554432 / 4) / gridDim.x;
    float s = 0.f;
    for (size_t i = t; i < per; i += NT) { unsigned w = sp[(size_t)blockIdx.x * per + i]; s += (bflo(w) + 2.f * bfhi(w)) * (1.f + (float)(i & 15)); }
    float* red = (float*)smem; red[t] = s; __syncthreads();
    if (t == 0) { float a = 0.f; for (int i = 0; i < NT; ++i) a += red[i]; chk[blockIdx.x] = a; }
    __syncthreads(); }
  grid.sync();
  { const float* chk = (const float*)(ws + WS_END);
    for (size_t i = (size_t)blockIdx.x * NT + opaque_tid(); i < 19398656; i += (size_t)gridDim.x * NT) p.out[i] = chk[(i >> 10) & 255]; }
#endif
#ifdef CHK_INPUT
  grid.sync();
  { const float* chk = (const float*)(ws + WS_END);
    for (size_t i = (size_t)blockIdx.x * NT + opaque_tid(); i < 19398656; i += (size_t)gridDim.x * NT) p.out[i] = chk[(i >> 10) & 255]; }
#endif
}

extern "C" void kernel_launch(void* const* d_in, const int* in_sizes, int n_in, void* d_out, int out_size, void* d_ws, size_t ws_size, hipStream_t stream) {
  static int grid_blocks = 0;
  if (grid_blocks == 0) {
    if (n_in != 33 || ws_size < WS_END) { fprintf(stderr, "kernel_launch: unexpected n_in %d or ws_size %zu (< %zu)\n", n_in, ws_size, (size_t)WS_END); grid_blocks = -1; return; }
    int dev = 0, cus = 0, per_cu = 0;
    (void)hipGetDevice(&dev);
    (void)hipDeviceGetAttribute(&cus, hipDeviceAttributeMultiprocessorCount, dev);
    if (hipFuncSetAttribute((const void*)fwd_megakernel, hipFuncAttributeMaxDynamicSharedMemorySize, LDS_BYTES) != hipSuccess) { fprintf(stderr, "hipFuncSetAttribute failed\n"); grid_blocks = -1; return; }
    if (hipOccupancyMaxActiveBlocksPerMultiprocessor(&per_cu, (const void*)fwd_megakernel, NT, LDS_BYTES) != hipSuccess || per_cu < 1) { fprintf(stderr, "occupancy query failed (%d)\n", per_cu); (void)hipGetLastError(); per_cu = 1; }
    grid_blocks = cus * 1;
    fprintf(stderr, "kernel_launch: cus %d per_cu %d grid %d\n", cus, per_cu, grid_blocks);
  }
  if (grid_blocks < 0) return;
  (void)hipMemsetAsync((unsigned char*)d_ws + WS_BAR, 0, 16384, stream);
  Params p{};
  for (int i = 0; i < 33; ++i) p.in[i] = (const float*)d_in[i];
  p.out = (float*)d_out; p.ws = (unsigned char*)d_ws;
#if N_LAUNCH_MODE == 1
  #ifndef PH_HI
#define PH_HI NPHASE
#endif
  p.ph_lo = 0; p.ph_hi = PH_HI;
  void* args[] = {&p};
  hipError_t e = hipLaunchCooperativeKernel((void*)fwd_megakernel, dim3(grid_blocks), dim3(NT), args, LDS_BYTES, stream);
  if (e != hipSuccess) fprintf(stderr, "cooperative launch failed: %s (grid %d)\n", hipGetErrorString(e), grid_blocks);
#else
#ifndef PH_HI
#define PH_HI NPHASE
#endif
  for (int ph = 0; ph < PH_HI; ++ph) {
    p.ph_lo = ph; p.ph_hi = ph + 1;
    hipLaunchKernelGGL(fwd_megakernel, dim3(grid_blocks), dim3(NT), LDS_BYTES, stream, p);
  }
#ifdef DUMP_W2T
  p.ph_lo = 100; p.ph_hi = 101;
  hipLaunchKernelGGL(fwd_megakernel, dim3(grid_blocks), dim3(NT), LDS_BYTES, stream, p);
#endif
#endif
}
```

```cpp
#include <hip/hip_runtime.h>
#include <hip/hip_bf16.h>
#include <hip/hip_cooperative_groups.h>
#include <cstdio>
namespace cg = cooperative_groups;

typedef unsigned short bf16_t;
using bf16 = __hip_bfloat16;
using bf16x8 = __attribute__((ext_vector_type(8))) short;
using f32x4 = __attribute__((ext_vector_type(4))) float;
using f32x16 = __attribute__((ext_vector_type(16))) float;

#define B_AUX 0
#ifndef USE_GLDS
#define USE_GLDS 1
#endif
#ifndef N_LAUNCH_MODE
#define N_LAUNCH_MODE 1
#endif

constexpr int NT = 512;
constexpr int D = 1024, NTOK = 8192, DFF = 4096;
constexpr int LDS_BYTES = 131072 + 64;
constexpr int NPHASE = 31;

constexpr size_t WS_W1T = 0;
constexpr size_t WS_W2T = WS_W1T + 33554432;
constexpr size_t WS_GLUT = WS_W2T + 33554432;
constexpr size_t WS_NAQKVT = WS_GLUT + 8388608;
constexpr size_t WS_NAOT = WS_NAQKVT + 6291456;
constexpr size_t WS_GQAQKVT = WS_NAOT + 2097152;
constexpr size_t WS_GQAOT = WS_GQAQKVT + 3145728;
constexpr size_t WS_MOD = WS_GQAOT + 2097152;
constexpr size_t WS_S5A = WS_MOD + 491520;
constexpr size_t WS_S5BB = WS_S5A + 131072;
constexpr size_t WS_S5CM = WS_S5BB + 1048576;
constexpr size_t WS_S5E = WS_S5CM + 1048576;
constexpr size_t WS_CKNA = WS_S5E + 8388608;
constexpr size_t WS_CVTNA = WS_CKNA + 4194304;
constexpr size_t WS_CKGQA = WS_CVTNA + 4194304;
constexpr size_t WS_CVTGQA = WS_CKGQA + 1048576;
constexpr size_t WS_HB = WS_CVTGQA + 1048576;
constexpr size_t WS_AO = WS_HB + 16777216;
constexpr size_t WS_QK = WS_AO + 16777216;
constexpr size_t WS_VT = WS_QK + 33554432;
constexpr size_t WS_ACT = WS_VT + 16777216;
constexpr size_t WS_BAR = WS_ACT + 67108864;
constexpr size_t WS_END = WS_BAR + 16384;

constexpr size_t OUT_YS = 4194304, OUT_S5 = 8388608, OUT_NAK = 8912896, OUT_NAV = 13107200, OUT_GQAK = 17301504, OUT_GQAV = 18350080;

struct Params {
  const float* in[33];
  float* out;
  unsigned char* ws;
  int ph_lo, ph_hi;
};

extern __shared__ __attribute__((aligned(16))) unsigned char smem[];

__device__ __forceinline__ unsigned cvt_pk_bf16(float lo, float hi) {
  unsigned r; asm("v_cvt_pk_bf16_f32 %0, %1, %2" : "=v"(r) : "v"(lo), "v"(hi)); return r;
}
__device__ __forceinline__ bf16_t f2bf(float f) { return (bf16_t)(cvt_pk_bf16(f, 0.f) & 0xffffu); }
__device__ __forceinline__ float bf2f(bf16_t b) { return __uint_as_float(((unsigned)b) << 16); }
__device__ __forceinline__ float bflo(unsigned u) { return __uint_as_float(u << 16); }
__device__ __forceinline__ float bfhi(unsigned u) { return __uint_as_float(u & 0xffff0000u); }
__device__ __forceinline__ int cond_of_row(int row) { return row < 4096 ? 0 : 1 + ((row - 4096) >> 10); }

__device__ __forceinline__ int opaque_tid() { int t = threadIdx.x; asm volatile("" : "+v"(t)); return t; }
#define MFMA_SETTLE() asm volatile("s_nop 15\n\ts_nop 15" ::: "memory")
__device__ __forceinline__ void bu_mfma4(f32x16& c0, f32x16& c1, f32x16& c2, f32x16& c3, bf16x8 a, bf16x8 b0, bf16x8 b1, bf16x8 b2, bf16x8 b3) {
  asm volatile("v_mfma_f32_32x32x16_bf16 %0, %4, %5, 0\n\t"
               "v_mfma_f32_32x32x16_bf16 %1, %4, %6, 0\n\t"
               "v_mfma_f32_32x32x16_bf16 %2, %4, %7, 0\n\t"
               "v_mfma_f32_32x32x16_bf16 %3, %4, %8, 0\n\t"
               "s_nop 15\n\ts_nop 15"
               : "=&v"(c0), "=&v"(c1), "=&v"(c2), "=&v"(c3) : "v"(a), "v"(b0), "v"(b1), "v"(b2), "v"(b3));
}
struct cplx { float re, im; };
__device__ __forceinline__ cplx cmul(cplx a, cplx b) { return {a.re * b.re - a.im * b.im, a.re * b.im + a.im * b.re}; }
__device__ __forceinline__ cplx cfma(cplx a, cplx h, cplx b) {
  cplx r; r.re = fmaf(a.re, h.re, fmaf(-a.im, h.im, b.re)); r.im = fmaf(a.re, h.im, fmaf(a.im, h.re, b.im)); return r;
}

constexpr int BM = 256, BK = 64, NXCD = 8, WGM = 8;

__device__ __forceinline__ int lds_byte(int r, int c) {
  int st = (r >> 4) * 2 + (c >> 5), ob = (r & 15) * 64 + (c & 31) * 2;
  return st * 1024 + (ob ^ (((ob >> 9) & 1) << 5));
}
__device__ __forceinline__ void stage_rc(int b, int& R, int& C) {
  int st = b >> 10, sb = b & 1023, swz = sb ^ (((sb >> 9) & 1) << 5);
  R = (st / 2) * 16 + swz / 64; C = (st % 2) * 32 + (swz % 64) / 2;
}

struct GemmArgs { const bf16_t* A; int lda; const bf16_t* Bt; int ldb; int nM, nN, K; int kmask; };

template <int BN, class Epi>
__device__ __forceinline__ void gemm_phase(const GemmArgs ga, const Epi epi) {
  constexpr int TILE_A = BM * BK * 2, TILE_B = BN * BK * 2, STAGE_B = TILE_A + TILE_B, GLA = TILE_A / 8192, GLB = TILE_B / 8192, NF = BN / 64;
  unsigned char* shm = smem;
  const int tid = opaque_tid(), wid = tid >> 6, lane = tid & 63, wr = wid >> 2, wc = wid & 3, fr = lane & 15, fq = lane >> 4;
  unsigned voA[GLA], voB[GLB];
#pragma unroll
  for (int i = 0; i < GLA; ++i) { int r_, c_; stage_rc(wid * 1024 + i * 8192 + lane * 16, r_, c_); voA[i] = (unsigned)(r_ * ga.lda + c_) * 2u; }
#pragma unroll
  for (int i = 0; i < GLB; ++i) { int r_, c_; stage_rc(wid * 1024 + i * 8192 + lane * 16, r_, c_); voB[i] = (unsigned)(r_ * ga.ldb + c_) * 2u; }
  int offA[8], offB[NF];
#pragma unroll
  for (int m = 0; m < 8; ++m) offA[m] = lds_byte(wr * 128 + m * 16 + fr, fq * 8);
#pragma unroll
  for (int n = 0; n < NF; ++n) offB[n] = TILE_A + lds_byte(wc * (BN / 4) + n * 16 + fr, fq * 8);
  const int nwg = ga.nM * ga.nN, nt = ga.K / BK;
  for (int u = blockIdx.x; u < nwg; u += gridDim.x) {
    int wgid = u;
    { int q = nwg / NXCD, r = nwg % NXCD, xcd = wgid % NXCD, off = wgid / NXCD;
      wgid = (xcd < r ? xcd * (q + 1) : r * (q + 1) + (xcd - r) * q) + off; }
    constexpr int WG_ = (BN == 128) ? 4 : WGM;
    const int nig = WG_ * ga.nN, gid = wgid / nig, fm = gid * WG_, gsz = min(ga.nM - fm, WG_);
    const int pm = fm + ((wgid % nig) % gsz), pn = (wgid % nig) / gsz, brow = pm * BM, bcol = pn * BN;
    const bf16_t* Ab = ga.A + (long)brow * ga.lda;
    const bf16_t* Bb = ga.Bt + (long)bcol * ga.ldb;
#define GLDS_STAGE(buf, kt) do { \
    _Pragma("unroll") for (int i = 0; i < GLA; ++i) \
      __builtin_amdgcn_global_load_lds((const unsigned*)((const char*)(Ab + ((kt) & ga.kmask) * BK) + voA[i]), \
        (__attribute__((address_space(3))) unsigned*)(shm + (buf) * STAGE_B + wid * 1024 + i * 8192), 16, 0, 0); \
    _Pragma("unroll") for (int i = 0; i < GLB; ++i) \
      __builtin_amdgcn_global_load_lds((const unsigned*)((const char*)(Bb + ((kt) & ga.kmask) * BK) + voB[i]), \
        (__attribute__((address_space(3))) unsigned*)(shm + (buf) * STAGE_B + TILE_A + wid * 1024 + i * 8192), 16, 0, B_AUX); } while (0)
    f32x4 acc[8][NF];
#pragma unroll
    for (int m = 0; m < 8; ++m)
#pragma unroll
      for (int n = 0; n < NF; ++n) acc[m][n] = (f32x4){0.f, 0.f, 0.f, 0.f};
#define LOADF(A_, B_, ks_) do { \
      _Pragma("unroll") for (int m = 0; m < 8; ++m) A_[m] = *(const bf16x8*)(sb + offA[m] + (ks_) * 1024); \
      _Pragma("unroll") for (int n = 0; n < NF; ++n) B_[n] = *(const bf16x8*)(sb + offB[n] + (ks_) * 1024); } while (0)
#define MMAS(A_, B_) do { \
      _Pragma("unroll") for (int m = 0; m < 8; ++m) \
        _Pragma("unroll") for (int n = 0; n < NF; ++n) acc[m][n] = __builtin_amdgcn_mfma_f32_16x16x32_bf16(B_[n], A_[m], acc[m][n], 0, 0, 0); } while (0)
#define COMPUTE(cur_) do { const unsigned char* sb = shm + (cur_) * STAGE_B; \
      if constexpr (NF == 2) { \
        bf16x8 A0[8], B0[NF], A1[8], B1[NF]; \
        LOADF(A0, B0, 0); LOADF(A1, B1, 1); \
        __builtin_amdgcn_sched_barrier(0); \
        MMAS(A0, B0); MMAS(A1, B1); \
        __builtin_amdgcn_sched_barrier(0); \
      } else { \
        bf16x8 A0[8], B0[NF]; \
        LOADF(A0, B0, 0); __builtin_amdgcn_sched_barrier(0); MMAS(A0, B0); __builtin_amdgcn_sched_barrier(0); \
        LOADF(A0, B0, 1); __builtin_amdgcn_sched_barrier(0); MMAS(A0, B0); __builtin_amdgcn_sched_barrier(0); \
      } } while (0)
#if USE_GLDS
    GLDS_STAGE(0, 0);
    asm volatile("s_waitcnt vmcnt(0)" ::: "memory"); __syncthreads();
    for (int t = 0; t < nt; ++t) {
      const int cur = t & 1;
      if (t + 1 < nt) GLDS_STAGE(cur ^ 1, t + 1);
      COMPUTE(cur);
      asm volatile("s_waitcnt vmcnt(0)" ::: "memory"); __syncthreads();
    }
#else
    uint4 sa0, sa1, sa2, sa3, sb0, sb1, sb2, sb3;
    static_assert(GLA == 4 && (GLB == 2 || GLB == 4), "staging shape");
#define GSRC_A(kt, i) (*(const uint4*)((const char*)(Ab + ((kt) & ga.kmask) * BK) + voA[i]))
#define GSRC_B(kt, i) (*(const uint4*)((const char*)(Bb + ((kt) & ga.kmask) * BK) + voB[i]))
#define LDST_A(buf, i) (*(uint4*)(shm + (buf) * STAGE_B + wid * 1024 + (i) * 8192 + lane * 16))
#define LDST_B(buf, i) (*(uint4*)(shm + (buf) * STAGE_B + TILE_A + wid * 1024 + (i) * 8192 + lane * 16))
#define REG_ISSUE(kt) do { sa0 = GSRC_A(kt, 0); sa1 = GSRC_A(kt, 1); sa2 = GSRC_A(kt, 2); sa3 = GSRC_A(kt, 3); \
      sb0 = GSRC_B(kt, 0); sb1 = GSRC_B(kt, 1); if constexpr (GLB == 4) { sb2 = GSRC_B(kt, 2); sb3 = GSRC_B(kt, 3); } } while (0)
#define REG_WRITE(buf) do { LDST_A(buf, 0) = sa0; LDST_A(buf, 1) = sa1; LDST_A(buf, 2) = sa2; LDST_A(buf, 3) = sa3; \
      LDST_B(buf, 0) = sb0; LDST_B(buf, 1) = sb1; if constexpr (GLB == 4) { LDST_B(buf, 2) = sb2; LDST_B(buf, 3) = sb3; } } while (0)
    REG_ISSUE(0); REG_WRITE(0); REG_ISSUE(1); __syncthreads();
    for (int t = 0; t < nt; ++t) {
      const int cur = t & 1;
      if (t + 1 < nt) REG_WRITE(cur ^ 1);
      if (t + 2 < nt) REG_ISSUE(t + 2);
      COMPUTE(cur);
      __syncthreads();
    }
#undef REG_ISSUE
#undef REG_WRITE
#endif
#undef COMPUTE
#undef LOADF
#undef MMAS
#undef GLDS_STAGE
    epi(acc, brow + wr * 128 + fr, bcol + wc * (BN / 4) + fq * 4);
  }
  __syncthreads();
}

struct EpiSqRelu {
  bf16_t* O;
  template <int NF> __device__ __forceinline__ void operator()(const f32x4 (&acc)[8][NF], int row0, int col0) const {
#pragma unroll
    for (int m = 0; m < 8; ++m)
#pragma unroll
      for (int n = 0; n < NF; ++n) {
        f32x4 v = acc[m][n];
        float a0 = fmaxf(v[0], 0.f), a1 = fmaxf(v[1], 0.f), a2 = fmaxf(v[2], 0.f), a3 = fmaxf(v[3], 0.f);
        uint2 pk; pk.x = cvt_pk_bf16(a0 * a0, a1 * a1); pk.y = cvt_pk_bf16(a2 * a2, a3 * a3);
        *(uint2*)(O + (size_t)(row0 + 16 * m) * DFF + col0 + 16 * n) = pk;
      }
  }
};
struct EpiResid {
  float* X; const float* gate;
  template <int NF> __device__ __forceinline__ void operator()(const f32x4 (&acc)[8][NF], int row0, int col0) const {
    const float* gp = gate + cond_of_row(row0) * 6144;
#pragma unroll
    for (int n = 0; n < NF; ++n) {
      const f32x4 gv = *(const f32x4*)(gp + col0 + 16 * n);
#pragma unroll
      for (int m = 0; m < 8; ++m) {
        float* xp = X + (size_t)(row0 + 16 * m) * D + col0 + 16 * n;
        f32x4 o = *(f32x4*)xp; o += acc[m][n] * gv; *(f32x4*)xp = o;
      }
    }
  }
};
struct EpiGlu {
  float* X; const float* gate; const float* bias;
  template <int NF> __device__ __forceinline__ void operator()(const f32x4 (&acc)[8][NF], int row0, int col0) const {
    const float* gp = gate + cond_of_row(row0) * 6144;
    const int col = (col0 >> 7) * 64 + ((col0 >> 5) & 3) * 16 + (col0 & 15);
    const f32x4 gv = *(const f32x4*)(gp + col);
    const f32x4 ba = *(const f32x4*)(bias + col), bg = *(const f32x4*)(bias + 1024 + col);
#pragma unroll
    for (int m = 0; m < 8; ++m) {
      float* xp = X + (size_t)(row0 + 16 * m) * D + col;
      f32x4 a = acc[m][0] + ba, g = acc[m][1] + bg;
      f32x4 o = *(f32x4*)xp;
#pragma unroll
      for (int i = 0; i < 4; ++i) { float s = 1.f / (1.f + __expf(-g[i])); o[i] += gv[i] * a[i] * s; }
      *(f32x4*)xp = o;
    }
  }
};
struct EpiQkv {
  bf16_t* QK; int nqk; bf16_t* VT; int C; float* newv;
  template <int NF> __device__ __forceinline__ void operator()(const f32x4 (&acc)[8][NF], int row0, int col0) const {
    if (col0 < nqk) {
#pragma unroll
      for (int m = 0; m < 8; ++m)
#pragma unroll
        for (int n = 0; n < NF; ++n) {
          f32x4 v = acc[m][n];
          uint2 pk; pk.x = cvt_pk_bf16(v[0], v[1]); pk.y = cvt_pk_bf16(v[2], v[3]);
          *(uint2*)(QK + (size_t)(row0 + 16 * m) * nqk + col0 + 16 * n) = pk;
        }
    } else {
      const int vc0 = col0 - nqk;
#pragma unroll
      for (int m = 0; m < 8; ++m) {
        const int row = row0 + 16 * m;
        size_t vbase; int ldv;
        if (row < 4096) { vbase = (size_t)(row >> 8) * C * 256 + (row & 255); ldv = 256; }
        else { const int r2 = row - 4096; vbase = (size_t)4096 * C + (size_t)(r2 >> 10) * C * 1024 + (r2 & 1023); ldv = 1024; }
#pragma unroll
        for (int n = 0; n < NF; ++n) {
          const int col = vc0 + 16 * n;
          f32x4 v = acc[m][n];
#pragma unroll
          for (int i = 0; i < 4; ++i) VT[vbase + (size_t)(col + i) * ldv] = f2bf(v[i]);
          if (row < 4096) *(f32x4*)(newv + (size_t)row * C + col) = v;
        }
      }
    }
  }
};

__device__ void conv_job(const Params& p, int job, const float*& src, bf16_t*& dst, int& K, int& N, int& perm) {
  unsigned char* ws = p.ws; perm = 0;
  if (job < 4) { src = p.in[12] + (size_t)job * 1024 * 4096; dst = (bf16_t*)(ws + WS_W1T) + (size_t)job * 4096 * 1024; K = 1024; N = 4096; }
  else if (job < 8) { int l = job - 4; src = p.in[13] + (size_t)l * 4096 * 1024; dst = (bf16_t*)(ws + WS_W2T) + (size_t)l * 1024 * 4096; K = 4096; N = 1024; }
  else if (job < 10) { int s = job - 8; src = p.in[22] + (size_t)s * 1024 * 2048; dst = (bf16_t*)(ws + WS_GLUT) + (size_t)s * 2048 * 1024; K = 1024; N = 2048; perm = 1; }
  else if (job == 10) { src = p.in[24]; dst = (bf16_t*)(ws + WS_NAQKVT); K = 1024; N = 3072; }
  else if (job == 11) { src = p.in[28]; dst = (bf16_t*)(ws + WS_NAOT); K = 1024; N = 1024; }
  else if (job == 12) { src = p.in[29]; dst = (bf16_t*)(ws + WS_GQAQKVT); K = 1024; N = 1536; }
  else if (job == 13) { src = p.in[32]; dst = (bf16_t*)(ws + WS_GQAOT); K = 1024; N = 1024; }
  else if (job < 18) { int b = job - 14; src = p.in[4] + (size_t)b * 512 * 1024; dst = (bf16_t*)(ws + WS_CVTNA) + (size_t)b * 1024 * 512; K = 512; N = 1024; }
  else { int b = job - 18; src = p.in[6] + (size_t)b * 512 * 256; dst = (bf16_t*)(ws + WS_CVTGQA) + (size_t)b * 256 * 512; K = 512; N = 256; }
}

__device__ void do_transposes(const Params& p, int job_lo, int job_hi);
__device__ void phase_prologue(const Params& p) {
  const int tid = opaque_tid(), G = gridDim.x;
  unsigned char* ws = p.ws;
  float* MOD = (float*)(ws + WS_MOD);
  {
    float* sl = (float*)smem;
    float* red = (float*)smem + 5 * 1024;
    bool have = false;
    for (int it = blockIdx.x; it < 192; it += G) {
      if (!have) {
        for (int i = tid; i < 5 * 1024; i += NT) {
          int c = i >> 10, k = i & 1023;
          float v = (c == 0) ? p.in[8][k] : p.in[7][(c - 1) * 1024 + k];
          sl[i] = v / (1.f + __expf(-v));
        }
        have = true;
      }
      __syncthreads();
      const int layer = it / 48, col0 = (it % 48) * 128;
      const int cg4 = tid & 31, ksl = tid >> 5;
      const float* wp = p.in[10] + (size_t)layer * 1024 * 6144 + col0 + cg4 * 4;
      f32x4 a[5];
      for (int c = 0; c < 5; ++c) a[c] = (f32x4){0.f, 0.f, 0.f, 0.f};
#pragma unroll 8
      for (int kk = 0; kk < 64; ++kk) {
        const int k = ksl * 64 + kk;
        const f32x4 w = *(const f32x4*)(wp + (size_t)k * 6144);
        for (int c = 0; c < 5; ++c) a[c] += w * sl[c * 1024 + k];
      }
      for (int c = 0; c < 5; ++c) *(f32x4*)(red + (ksl * 5 + c) * 128 + cg4 * 4) = a[c];
      __syncthreads();
      for (int o = tid; o < 640; o += NT) {
        const int c = o >> 7, col = o & 127;
        float s = p.in[11][layer * 6144 + col0 + col];
        for (int k2 = 0; k2 < 16; ++k2) s += red[(k2 * 5 + c) * 128 + col];
        MOD[(layer * 5 + c) * 6144 + col0 + col] = s;
      }
      __syncthreads();
    }
    __syncthreads();
  }
  {
    float* S5A = (float*)(ws + WS_S5A);
    bf16_t* BB = (bf16_t*)(ws + WS_S5BB);
    bf16_t* CM = (bf16_t*)(ws + WS_S5CM);
    for (int it = (blockIdx.x + 64) % G; it < 256; it += G) {
      const int sdg = it;
      const int g = it & 63;
      const float dt = expf(p.in[16][sdg]);
      for (int idx = tid; idx < 1024; idx += NT) {
        const int pp = idx >> 4, ch = idx & 15;
        const float lr = p.in[14][sdg * 64 + pp], li = p.in[15][sdg * 64 + pp];
        const float ar = lr * dt, ai = li * dt;
        const float mag = expf(ar), cs = cosf(ai), sn = sinf(ai), sh = sinf(0.5f * ai);
        const float abr = mag * cs, abi = mag * sn;
        const float nr = expm1f(ar) * cs - 2.f * sh * sh, ni = abi;
        const float den = lr * lr + li * li;
        const float fre = (nr * lr + ni * li) / den, fim = (ni * lr - nr * li) / den;
        const float br = p.in[17][(sdg * 64 + pp) * 16 + ch], bi = p.in[18][(sdg * 64 + pp) * 16 + ch];
        const float bbr = fre * br - fim * bi, bbi = fre * bi + fim * br;
        BB[((size_t)sdg * 128 + pp) * 16 + ch] = f2bf(bbr);
        BB[((size_t)sdg * 128 + 64 + pp) * 16 + ch] = f2bf(bbi);
        const float cr = p.in[19][(sdg * 16 + ch) * 64 + pp], ci = p.in[20][(sdg * 16 + ch) * 64 + pp];
        const int q = pp & 31, s2 = (pp >> 5) * 2;
        CM[((size_t)sdg * 16 + ch) * 128 + 4 * q + s2] = f2bf(cr);
        CM[((size_t)sdg * 16 + ch) * 128 + 4 * q + s2 + 1] = f2bf(-ci);
        if (ch == 0) { S5A[(sdg * 64 + pp) * 2] = abr; S5A[(sdg * 64 + pp) * 2 + 1] = abi; }
      }
      (void)g;
    }
  }
  {
    const size_t n1 = 4 * 512 * 1024 / 4, n2 = 4 * 512 * 256 / 4;
    uint2* d1 = (uint2*)(ws + WS_CKNA); uint2* d2 = (uint2*)(ws + WS_CKGQA);
    const f32x4* s1 = (const f32x4*)p.in[3]; const f32x4* s2 = (const f32x4*)p.in[5];
    for (size_t i = (size_t)blockIdx.x * NT + tid; i < n1 + n2; i += (size_t)G * NT) {
      f32x4 v = (i < n1) ? s1[i] : s2[i - n1];
      uint2 pk; pk.x = cvt_pk_bf16(v[0], v[1]); pk.y = cvt_pk_bf16(v[2], v[3]);
      if (i < n1) d1[i] = pk; else d2[i - n1] = pk;
    }
  }
  do_transposes(p, 0, 22);
}

__device__ void do_transposes(const Params& p, int job_lo, int job_hi) {
  const int tid = opaque_tid(), G = gridDim.x;
  {
    bf16_t* T = (bf16_t*)smem;
    int base = 0;
    for (int job = job_lo; job < job_hi; ++job) {
      const float* src; bf16_t* dst; int K, N, perm;
      conv_job(p, job, src, dst, K, N, perm);
      const int tn = N >> 8, ntile = (K >> 6) * tn;
      const int start = (int)(((long)blockIdx.x - (base % G) + G) % G);
      const int n4 = tid & 63, kr0 = tid >> 6;
      f32x4 v[8];
      if (start < ntile) {
        const int k0 = (start / tn) << 6, n0 = (start % tn) << 8;
#pragma unroll
        for (int ps = 0; ps < 8; ++ps) v[ps] = *(const f32x4*)(src + (size_t)(k0 + 8 * kr0 + ps) * N + n0 + n4 * 4);
      }
      for (int tile = start; tile < ntile; tile += G) {
        const int k0 = (tile / tn) << 6, n0 = (tile % tn) << 8;
        __syncthreads();
#pragma unroll
        for (int i = 0; i < 4; ++i) {
          uint4 w;
          w.x = cvt_pk_bf16(v[0][i], v[1][i]); w.y = cvt_pk_bf16(v[2][i], v[3][i]);
          w.z = cvt_pk_bf16(v[4][i], v[5][i]); w.w = cvt_pk_bf16(v[6][i], v[7][i]);
          *(uint4*)(T + (n4 * 4 + i) * 72 + 8 * kr0) = w;
        }
        if (tile + G < ntile) {
          const int k1 = ((tile + G) / tn) << 6, n1 = ((tile + G) % tn) << 8;
#pragma unroll
          for (int ps = 0; ps < 8; ++ps) v[ps] = *(const f32x4*)(src + (size_t)(k1 + 8 * kr0 + ps) * N + n1 + n4 * 4);
        }
        __syncthreads();
#pragma unroll
        for (int q = 0; q < 4; ++q) {
          const int n = (tid >> 3) + 64 * q, kc = tid & 7;
          const uint4 o = *(const uint4*)(T + n * 72 + kc * 8);
          int dr = n0 + n;
          if (perm) { const int isg = dr >= 1024, c1 = dr & 1023; dr = (c1 >> 6) * 128 + ((c1 >> 4) & 3) * 32 + (c1 & 15) + isg * 16; }
          *(uint4*)(dst + (size_t)dr * K + k0 + kc * 8) = o;
        }
      }
      base += ntile;
    }
    __syncthreads();
  }
}

__device__ void phase_norm(const Params& p, int layer, int which, bool first) {
  const int tid_ = opaque_tid(); const int lane = tid_ & 63, wave = tid_ >> 6;
  const float* MOD = (const float*)(p.ws + WS_MOD);
  bf16_t* HB = (bf16_t*)(p.ws + WS_HB);
  const float* gw = p.in[9] + (layer * 2 + which) * 1024;
  for (int row0 = (blockIdx.x * 8 + wave) * 4; row0 < NTOK; row0 += gridDim.x * 32) {
    f32x4 v[4][4]; float ss[4];
#pragma unroll
    for (int r = 0; r < 4; ++r) {
      const int row = row0 + r;
      const float* xr = first ? (row < 4096 ? p.in[0] + (size_t)row * D : p.in[1] + (size_t)(row - 4096) * D) : p.out + (size_t)row * D;
#pragma unroll
      for (int i = 0; i < 4; ++i) v[r][i] = *(const f32x4*)(xr + i * 256 + lane * 4);
    }
#pragma unroll
    for (int r = 0; r < 4; ++r) {
      float s = 0.f;
#pragma unroll
      for (int i = 0; i < 4; ++i) s += v[r][i][0] * v[r][i][0] + v[r][i][1] * v[r][i][1] + v[r][i][2] * v[r][i][2] + v[r][i][3] * v[r][i][3];
      ss[r] = s;
    }
#pragma unroll
    for (int o = 32; o > 0; o >>= 1) {
#pragma unroll
      for (int r = 0; r < 4; ++r) ss[r] += __shfl_xor(ss[r], o);
    }
    const float* mp = MOD + (layer * 5 + cond_of_row(row0)) * 6144 + which * 3072;
#pragma unroll
    for (int i = 0; i < 4; ++i) {
      const int col = i * 256 + lane * 4;
      const f32x4 gv = *(const f32x4*)(gw + col), sh = *(const f32x4*)(mp + col), sc = *(const f32x4*)(mp + 1024 + col);
#pragma unroll
      for (int r = 0; r < 4; ++r) {
        const int row = row0 + r;
        const float rstd = rsqrtf(ss[r] * (1.f / 1024.f) + 1e-6f);
        if (first) *(f32x4*)(p.out + (size_t)row * D + col) = v[r][i];
        float o[4];
#pragma unroll
        for (int j = 0; j < 4; ++j) o[j] = v[r][i][j] * rstd * gv[j] * (1.f + sc[j]) + sh[j];
        uint2 pk; pk.x = cvt_pk_bf16(o[0], o[1]); pk.y = cvt_pk_bf16(o[2], o[3]);
        *(uint2*)(HB + (size_t)row * D + col) = pk;
      }
    }
  }
}

__device__ __forceinline__ int s5_tok(int rho) { return 16 * ((rho >> 2) & 1) + (rho & 3) + 4 * (rho >> 3); }
__device__ __forceinline__ cplx shfl_c(cplx v, int src) { cplx r; r.re = __shfl(v.re, src); r.im = __shfl(v.im, src); return r; }

__device__ void phase_s5_pass1(const Params& p, int slot) {
  const int tid_ = opaque_tid(); const int lane = tid_ & 63, wave = tid_ >> 6, r = lane & 31, H = lane >> 5;
  const bf16_t* HB = (const bf16_t*)(p.ws + WS_HB);
  const float* S5A = (const float*)(p.ws + WS_S5A);
  const bf16_t* BB = (const bf16_t*)(p.ws + WS_S5BB);
  float* E = (float*)(p.ws + WS_S5E);
  const int tokr = s5_tok(r);
  for (int it = blockIdx.x * 8 + wave; it < 128 * 64; it += gridDim.x * 8) {
    const int ck = it >> 6, g = it & 63, tok0 = ck * 64;
    bf16x8 uf[2];
    _Pragma("unroll") for (int tt = 0; tt < 2; ++tt) uf[tt] = *(const bf16x8*)(HB + (size_t)(tok0 + 32 * tt + tokr) * D + g * 16 + 8 * H);
    _Pragma("unroll") for (int dir = 0; dir < 2; ++dir) {
      const int sdg = (slot * 2 + dir) * 64 + g;
      cplx a0 = {S5A[(sdg * 64 + r) * 2], S5A[(sdg * 64 + r) * 2 + 1]};
      cplx a1 = {S5A[(sdg * 64 + r + 32) * 2], S5A[(sdg * 64 + r + 32) * 2 + 1]};
      cplx a0_16 = a0, a1_16 = a1;
      _Pragma("unroll") for (int i = 0; i < 4; ++i) { a0_16 = cmul(a0_16, a0_16); a1_16 = cmul(a1_16, a1_16); }
      const cplx a0_32 = cmul(a0_16, a0_16), a1_32 = cmul(a1_16, a1_16);
      bf16x8 bfr[4];
      _Pragma("unroll") for (int ct = 0; ct < 4; ++ct) bfr[ct] = *(const bf16x8*)(BB + ((size_t)sdg * 128 + 32 * ct + r) * 16 + 8 * H);
      cplx E0 = {0.f, 0.f}, E1 = {0.f, 0.f};
      _Pragma("unroll") for (int t2 = 0; t2 < 2; ++t2) {
        const int tt = dir ? 1 - t2 : t2;
        f32x16 acc[4];
        bu_mfma4(acc[0], acc[1], acc[2], acc[3], uf[tt], bfr[0], bfr[1], bfr[2], bfr[3]);
        cplx e0 = {0.f, 0.f}, e1 = {0.f, 0.f};
        if (dir == 0) {
          _Pragma("unroll") for (int i = 0; i < 16; ++i) { e0 = cfma(a0, e0, (cplx){acc[0][i], acc[2][i]}); e1 = cfma(a1, e1, (cplx){acc[1][i], acc[3][i]}); }
        } else {
          _Pragma("unroll") for (int i = 15; i >= 0; --i) { e0 = cfma(a0, e0, (cplx){acc[0][i], acc[2][i]}); e1 = cfma(a1, e1, (cplx){acc[1][i], acc[3][i]}); }
        }
        const cplx o0 = shfl_c(e0, lane ^ 32), o1 = shfl_c(e1, lane ^ 32);
        const cplx eL0 = H ? o0 : e0, eU0 = H ? e0 : o0, eL1 = H ? o1 : e1, eU1 = H ? e1 : o1;
        cplx t0, t1;
        if (dir == 0) { t0 = cfma(a0_16, eL0, eU0); t1 = cfma(a1_16, eL1, eU1); }
        else { t0 = cfma(a0_16, eU0, eL0); t1 = cfma(a1_16, eU1, eL1); }
        E0 = cfma(a0_32, E0, t0); E1 = cfma(a1_32, E1, t1);
      }
      const int pp = H ? r + 32 : r;
      const cplx Ev = H ? E1 : E0;
      *(float2*)(E + ((size_t)((ck * 64 + g) * 2 + dir) * 64 + pp) * 2) = make_float2(Ev.re, Ev.im);
    }
  }
}

__device__ void phase_s5_pass2(const Params& p, int slot) {
  const int tid_ = opaque_tid(); const int lane = tid_ & 63, wave = tid_ >> 6, r = lane & 31, H = lane >> 5;
  bf16_t* HB = (bf16_t*)(p.ws + WS_HB);
  const float* S5A = (const float*)(p.ws + WS_S5A);
  const bf16_t* BB = (const bf16_t*)(p.ws + WS_S5BB);
  const bf16_t* CM = (const bf16_t*)(p.ws + WS_S5CM);
  const float* E = (const float*)(p.ws + WS_S5E);
  const float* Dsk = p.in[21] + slot * 1024;
  unsigned char* ldsw = smem + wave * 8704;
  const int tokr = s5_tok(r);
  for (int it = blockIdx.x * 8 + wave; it < 128 * 64; it += gridDim.x * 8) {
    const int ck = it >> 6, g = it & 63, tok0 = ck * 64;
    int c, nc, bq; bool sample;
    if (tok0 < 4096) { bq = tok0 >> 8; c = (tok0 >> 6) & 3; nc = 4; sample = false; }
    else { const int t2 = tok0 - 4096; bq = t2 >> 10; c = (t2 >> 6) & 15; nc = 16; sample = true; }
    const int ck0 = ck - c;
    bf16x8 uf[2];
    _Pragma("unroll") for (int tt = 0; tt < 2; ++tt) uf[tt] = *(const bf16x8*)(HB + (size_t)(tok0 + 32 * tt + tokr) * D + g * 16 + 8 * H);
    f32x4 yacc[2][2];
    _Pragma("unroll") for (int a = 0; a < 2; ++a) _Pragma("unroll") for (int b = 0; b < 2; ++b) yacc[a][b] = (f32x4){0.f, 0.f, 0.f, 0.f};
    _Pragma("unroll") for (int dir = 0; dir < 2; ++dir) {
      const int sdg = (slot * 2 + dir) * 64 + g;
      const cplx a0 = {S5A[(sdg * 64 + r) * 2], S5A[(sdg * 64 + r) * 2 + 1]};
      const cplx a1 = {S5A[(sdg * 64 + r + 32) * 2], S5A[(sdg * 64 + r + 32) * 2 + 1]};
      cplx a0_64 = a0, a1_64 = a1;
      _Pragma("unroll") for (int i = 0; i < 6; ++i) { a0_64 = cmul(a0_64, a0_64); a1_64 = cmul(a1_64, a1_64); }
      cplx c0 = {0.f, 0.f}, c1 = {0.f, 0.f};
      if (sample) {
        const float* h0 = p.in[2] + ((size_t)((bq * 2 + slot) * 2 + dir) * 2) * 4096 + g * 64;
        c0.re = h0[r]; c0.im = h0[4096 + r]; c1.re = h0[r + 32]; c1.im = h0[4096 + r + 32];
      }
      {
        const int ncar = dir ? nc - 1 - c : c;
        for (int j0 = 0; j0 < ncar; j0 += 8) {
          float2 va[8], vb[8];
#pragma unroll
          for (int j = 0; j < 8; ++j) {
            const int jj = min(j0 + j, ncar - 1);
            const int cc = dir ? nc - 1 - jj : jj;
            const float* ep = E + ((size_t)(((ck0 + cc) * 64 + g) * 2 + dir) * 64) * 2;
            va[j] = *(const float2*)(ep + r * 2); vb[j] = *(const float2*)(ep + (r + 32) * 2);
          }
#pragma unroll
          for (int j = 0; j < 8; ++j) if (j0 + j < ncar) {
            c0 = cfma(a0_64, c0, (cplx){va[j].x, va[j].y}); c1 = cfma(a1_64, c1, (cplx){vb[j].x, vb[j].y});
          }
        }
      }
      bf16x8 bfr[4], cfr[4];
      _Pragma("unroll") for (int ct = 0; ct < 4; ++ct) bfr[ct] = *(const bf16x8*)(BB + ((size_t)sdg * 128 + 32 * ct + r) * 16 + 8 * H);
      _Pragma("unroll") for (int ks = 0; ks < 4; ++ks) cfr[ks] = *(const bf16x8*)(CM + ((size_t)sdg * 16 + (lane & 15)) * 128 + 32 * ks + 8 * (lane >> 4));
      _Pragma("unroll") for (int t2 = 0; t2 < 2; ++t2) {
        const int tt = dir ? 1 - t2 : t2;
        f32x16 acc[4];
        bu_mfma4(acc[0], acc[1], acc[2], acc[3], uf[tt], bfr[0], bfr[1], bfr[2], bfr[3]);
        const int firstH = dir;
        cplx h0 = c0, h1 = c1;
        if (H == firstH) {
          if (dir == 0) { _Pragma("unroll") for (int i = 0; i < 16; ++i) { h0 = cfma(a0, h0, (cplx){acc[0][i], acc[2][i]}); h1 = cfma(a1, h1, (cplx){acc[1][i], acc[3][i]});
                            acc[0][i] = h0.re; acc[2][i] = h0.im; acc[1][i] = h1.re; acc[3][i] = h1.im; } }
          else { _Pragma("unroll") for (int i = 15; i >= 0; --i) { h0 = cfma(a0, h0, (cplx){acc[0][i], acc[2][i]}); h1 = cfma(a1, h1, (cplx){acc[1][i], acc[3][i]});
                            acc[0][i] = h0.re; acc[2][i] = h0.im; acc[1][i] = h1.re; acc[3][i] = h1.im; } }
        }
        h0 = shfl_c(h0, r + 32 * firstH); h1 = shfl_c(h1, r + 32 * firstH);
        if (H != firstH) {
          if (dir == 0) { _Pragma("unroll") for (int i = 0; i < 16; ++i) { h0 = cfma(a0, h0, (cplx){acc[0][i], acc[2][i]}); h1 = cfma(a1, h1, (cplx){acc[1][i], acc[3][i]});
                            acc[0][i] = h0.re; acc[2][i] = h0.im; acc[1][i] = h1.re; acc[3][i] = h1.im; } }
          else { _Pragma("unroll") for (int i = 15; i >= 0; --i) { h0 = cfma(a0, h0, (cplx){acc[0][i], acc[2][i]}); h1 = cfma(a1, h1, (cplx){acc[1][i], acc[3][i]});
                            acc[0][i] = h0.re; acc[2][i] = h0.im; acc[1][i] = h1.re; acc[3][i] = h1.im; } }
        }
        if (!sample && t2 == 1 && ((dir == 0 && c == nc - 1) || (dir == 1 && c == 0)) && H != firstH) {
          float* so = p.out + OUT_S5 + ((size_t)((bq * 2 + slot) * 2 + dir) * 2) * 4096 + g * 64;
          so[r] = h0.re; so[4096 + r] = h0.im; so[r + 32] = h1.re; so[4096 + r + 32] = h1.im;
        }
        c0 = shfl_c(h0, r + 32 * (1 - firstH)); c1 = shfl_c(h1, r + 32 * (1 - firstH));
        _Pragma("unroll") for (int i = 0; i < 16; ++i) {
          uint2 pk; pk.x = cvt_pk_bf16(acc[0][i], acc[2][i]); pk.y = cvt_pk_bf16(acc[1][i], acc[3][i]);
          *(uint2*)(ldsw + (16 * H + i) * 272 + 8 * r) = pk;
        }
        asm volatile("s_waitcnt lgkmcnt(0)" ::: "memory");
        _Pragma("unroll") for (int rt = 0; rt < 2; ++rt) _Pragma("unroll") for (int ks = 0; ks < 4; ++ks) {
          const bf16x8 af = *(const bf16x8*)(ldsw + (16 * rt + (lane & 15)) * 272 + (32 * ks + 8 * (lane >> 4)) * 2);
          yacc[tt][rt] = __builtin_amdgcn_mfma_f32_16x16x32_bf16(af, cfr[ks], yacc[tt][rt], 0, 0, 0);
        }
        asm volatile("s_waitcnt lgkmcnt(0)" ::: "memory");
      }
    }
    asm volatile("s_nop 15" : "+v"(yacc[0][0]), "+v"(yacc[0][1]), "+v"(yacc[1][0]), "+v"(yacc[1][1]));
    const int ch = lane & 15, col = g * 16 + ch;
    const float dsk = Dsk[col];
    _Pragma("unroll") for (int tt = 0; tt < 2; ++tt) _Pragma("unroll") for (int rt = 0; rt < 2; ++rt) _Pragma("unroll") for (int j = 0; j < 4; ++j) {
      const int token = tok0 + 32 * tt + 16 * rt + 4 * (lane >> 4) + j;
      bf16_t* hp = HB + (size_t)token * D + col;
      const float u = bf2f(*hp);
      const float y = yacc[tt][rt][j] + u * dsk;
      const float z = 0.7978845608028654f * (y + 0.044715f * y * y * y);
      const float th = 1.f - 2.f / (__expf(2.f * z) + 1.f);
      *hp = f2bf(0.5f * y * (1.f + th));
    }
  }
}

constexpr float LOG2E = 1.4426950408889634f;

__device__ void phase_post_na(const Params& p) {
  const int tid_ = opaque_tid(); const int lane = tid_ & 63, wave = tid_ >> 6;
  bf16_t* QK = (bf16_t*)(p.ws + WS_QK);
  const float* qn = p.in[25]; const float* kn = p.in[26];
  const float qs = 0.125f * LOG2E;
  const int d0 = (lane & 3) * 16;
  for (int row = blockIdx.x * 8 + wave; row < NTOK; row += gridDim.x * 8) {
    _Pragma("unroll") for (int part = 0; part < 2; ++part) {
      bf16_t* ptr = QK + (size_t)row * 2048 + part * 1024 + lane * 16;
      uint4 a = *(uint4*)ptr, b = *(uint4*)(ptr + 8);
      unsigned w[8] = {a.x, a.y, a.z, a.w, b.x, b.y, b.z, b.w};
      float v[16]; float ss = 0.f;
      _Pragma("unroll") for (int i = 0; i < 8; ++i) { v[2 * i] = bflo(w[i]); v[2 * i + 1] = bfhi(w[i]); }
      _Pragma("unroll") for (int i = 0; i < 16; ++i) ss += v[i] * v[i];
      ss += __shfl_xor(ss, 1); ss += __shfl_xor(ss, 2);
      const float rstd = rsqrtf(ss * (1.f / 64.f) + 1e-6f);
      const float* nw = part ? kn : qn;
      const float sc = part ? 1.f : qs;
      float o[16];
      _Pragma("unroll") for (int i = 0; i < 16; ++i) o[i] = v[i] * rstd * nw[d0 + i];
      if (part == 1 && row < 4096) {
        float* op = p.out + OUT_NAK + (size_t)row * 1024 + lane * 16;
        _Pragma("unroll") for (int i = 0; i < 4; ++i) *(f32x4*)(op + 4 * i) = (f32x4){o[4 * i], o[4 * i + 1], o[4 * i + 2], o[4 * i + 3]};
      }
      _Pragma("unroll") for (int i = 0; i < 8; ++i) w[i] = cvt_pk_bf16(o[2 * i] * sc, o[2 * i + 1] * sc);
      *(uint4*)ptr = make_uint4(w[0], w[1], w[2], w[3]); *(uint4*)(ptr + 8) = make_uint4(w[4], w[5], w[6], w[7]);
    }
  }
}

__device__ void phase_post_gqa(const Params& p) {
  const int tid_ = opaque_tid(); const int lane = tid_ & 63, wave = tid_ >> 6;
  bf16_t* QK = (bf16_t*)(p.ws + WS_QK);
  const float* qn = p.in[30]; const float* kn = p.in[31];
  const float qs = 0.08838834764831845f * LOG2E;
  for (int row = blockIdx.x * 8 + wave; row < NTOK; row += gridDim.x * 8) {
    const bool sample = row >= 4096;
    const int t = (row - 4096) & 1023;
    const float prow = (float)(t >> 6), pcol = (float)(t & 63);
    {
      const int i0 = (lane & 7) * 8;
      bf16_t* ptr = QK + (size_t)row * 1280 + (lane >> 3) * 128 + i0;
      uint4 a = *(uint4*)ptr, b = *(uint4*)(ptr + 64);
      unsigned wa[4] = {a.x, a.y, a.z, a.w}, wb[4] = {b.x, b.y, b.z, b.w};
      float x1[8], x2[8]; float ss = 0.f;
      _Pragma("unroll") for (int i = 0; i < 4; ++i) { x1[2 * i] = bflo(wa[i]); x1[2 * i + 1] = bfhi(wa[i]); x2[2 * i] = bflo(wb[i]); x2[2 * i + 1] = bfhi(wb[i]); }
      _Pragma("unroll") for (int i = 0; i < 8; ++i) ss += x1[i] * x1[i] + x2[i] * x2[i];
      ss += __shfl_xor(ss, 1); ss += __shfl_xor(ss, 2); ss += __shfl_xor(ss, 4);
      const float rstd = rsqrtf(ss * (1.f / 128.f) + 1e-6f);
      _Pragma("unroll") for (int i = 0; i < 8; ++i) { x1[i] *= rstd * qn[i0 + i]; x2[i] *= rstd * qn[64 + i0 + i]; }
      if (sample) {
        _Pragma("unroll") for (int i = 0; i < 8; ++i) {
          const int pi = i0 + i;
          const float inv = exp2f(-(float)(pi & 31) * (13.287712379549449f / 32.f));
          const float ang = (pi < 32 ? prow : pcol) * inv;
          const float cs = cosf(ang), sn = sinf(ang);
          const float y1 = x1[i] * cs - x2[i] * sn, y2 = x1[i] * sn + x2[i] * cs;
          x1[i] = y1; x2[i] = y2;
        }
      }
      _Pragma("unroll") for (int i = 0; i < 4; ++i) { wa[i] = cvt_pk_bf16(x1[2 * i] * qs, x1[2 * i + 1] * qs); wb[i] = cvt_pk_bf16(x2[2 * i] * qs, x2[2 * i + 1] * qs); }
      *(uint4*)ptr = make_uint4(wa[0], wa[1], wa[2], wa[3]); *(uint4*)(ptr + 64) = make_uint4(wb[0], wb[1], wb[2], wb[3]);
    }
    {
      const int i0 = (lane & 31) * 2;
      bf16_t* ptr = QK + (size_t)row * 1280 + 1024 + (lane >> 5) * 128 + i0;
      unsigned wa = *(unsigned*)ptr, wb = *(unsigned*)(ptr + 64);
      float x1[2] = {bflo(wa), bfhi(wa)}, x2[2] = {bflo(wb), bfhi(wb)};
      float ss = x1[0] * x1[0] + x1[1] * x1[1] + x2[0] * x2[0] + x2[1] * x2[1];
      _Pragma("unroll") for (int o = 1; o < 32; o <<= 1) ss += __shfl_xor(ss, o);
      const float rstd = rsqrtf(ss * (1.f / 128.f) + 1e-6f);
      _Pragma("unroll") for (int i = 0; i < 2; ++i) { x1[i] *= rstd * kn[i0 + i]; x2[i] *= rstd * kn[64 + i0 + i]; }
      if (!sample) {
        float* op = p.out + OUT_GQAK + (size_t)row * 256 + (lane >> 5) * 128 + i0;
        *(float2*)op = make_float2(x1[0], x1[1]); *(float2*)(op + 64) = make_float2(x2[0], x2[1]);
      } else {
        _Pragma("unroll") for (int i = 0; i < 2; ++i) {
          const int pi = i0 + i;
          const float inv = exp2f(-(float)(pi & 31) * (13.287712379549449f / 32.f));
          const float ang = (pi < 32 ? prow : pcol) * inv;
          const float cs = cosf(ang), sn = sinf(ang);
          const float y1 = x1[i] * cs - x2[i] * sn, y2 = x1[i] * sn + x2[i] * cs;
          x1[i] = y1; x2[i] = y2;
        }
      }
      *(unsigned*)ptr = cvt_pk_bf16(x1[0], x1[1]); *(unsigned*)(ptr + 64) = cvt_pk_bf16(x2[0], x2[1]);
    }
  }
}

template <int DH, bool NAL>
__device__ __forceinline__ void attn_wave(const bf16_t* Q, int ldq,
                                          const bf16_t* K0, int ldk0, const bf16_t* V0, int ldv0, int n0,
                                          const bf16_t* K1, int ldk1, const bf16_t* V1, int ldv1, int n1,
                                          bf16_t* O, int ldo, const float* rpb_h, int rr, int rs, int qc0) {
  constexpr int KS = DH / 32, DT = DH / 16;
  const int lane = opaque_tid() & 63, fr = lane & 15, g = lane >> 4;
  bf16x8 qf[2][KS];
  _Pragma("unroll") for (int qg = 0; qg < 2; ++qg) _Pragma("unroll") for (int ks = 0; ks < KS; ++ks) qf[qg][ks] = *(const bf16x8*)(Q + (size_t)(qg * 16 + fr) * ldq + ks * 32 + 8 * g);
  f32x4 o[2][DT];
  _Pragma("unroll") for (int qg = 0; qg < 2; ++qg) _Pragma("unroll") for (int dt = 0; dt < DT; ++dt) o[qg][dt] = (f32x4){0.f, 0.f, 0.f, 0.f};
  float lsum[2] = {0.f, 0.f};
  const int krow_in = 8 * (fr >> 2) + (fr & 3);
  const int nch = (n0 + n1) >> 5;
  for (int c = 0; c < nch; ++c) {
    const bool s1 = (c * 32 >= n0);
    const int kc = s1 ? c * 32 - n0 : c * 32;
    const bf16_t* K = s1 ? K1 : K0; const int ldk = s1 ? ldk1 : ldk0;
    const bf16_t* V = s1 ? V1 : V0; const int ldv = s1 ? ldv1 : ldv0;
    bf16x8 kf[2][KS], vf[DT];
    _Pragma("unroll") for (int t = 0; t < 2; ++t) _Pragma("unroll") for (int ks = 0; ks < KS; ++ks) kf[t][ks] = *(const bf16x8*)(K + (size_t)(kc + krow_in + 4 * t) * ldk + ks * 32 + 8 * g);
    _Pragma("unroll") for (int dt = 0; dt < DT; ++dt) vf[dt] = *(const bf16x8*)(V + (size_t)(16 * dt + fr) * ldv + kc + 8 * g);
    f32x4 s[2][2];
    _Pragma("unroll") for (int qg = 0; qg < 2; ++qg) _Pragma("unroll") for (int t = 0; t < 2; ++t) {
      s[qg][t] = (f32x4){0.f, 0.f, 0.f, 0.f};
      _Pragma("unroll") for (int ks = 0; ks < KS; ++ks) s[qg][t] = __builtin_amdgcn_mfma_f32_16x16x32_bf16(kf[t][ks], qf[qg][ks], s[qg][t], 0, 0, 0);
    }
    asm volatile("s_nop 15" : "+v"(s[0][0]), "+v"(s[0][1]), "+v"(s[1][0]), "+v"(s[1][1]));
    bf16x8 pf[2];
    _Pragma("unroll") for (int qg = 0; qg < 2; ++qg) {
      float pv[8];
      _Pragma("unroll") for (int i = 0; i < 8; ++i) {
        float sv = s[qg][i >> 2][i & 3];
        if (NAL && !s1) {
          const int krow = rs + (kc >> 6), kcol = (kc & 63) + 8 * g + i;
          const int qc = qc0 + qg * 16 + fr;
          const int cs = min(max(qc - 8, 0), 48);
          const bool valid = (kcol >= cs) && (kcol < cs + 16);
          const int bi = valid ? (krow - rr + 7) * 31 + (kcol - qc + 15) : 0;
          const float bias = rpb_h[bi];
          pv[i] = valid ? __builtin_amdgcn_exp2f(sv + bias * LOG2E) : 0.f;
        } else {
          pv[i] = __builtin_amdgcn_exp2f(sv);
        }
        lsum[qg] += pv[i];
      }
      union { bf16x8 v; unsigned u[4]; } pk;
      _Pragma("unroll") for (int i = 0; i < 4; ++i) pk.u[i] = cvt_pk_bf16(pv[2 * i], pv[2 * i + 1]);
      pf[qg] = pk.v;
    }
    asm volatile("s_nop 3" : "+v"(pf[0]), "+v"(pf[1]));
    _Pragma("unroll") for (int qg = 0; qg < 2; ++qg) _Pragma("unroll") for (int dt = 0; dt < DT; ++dt)
      o[qg][dt] = __builtin_amdgcn_mfma_f32_16x16x32_bf16(vf[dt], pf[qg], o[qg][dt], 0, 0, 0);
  }
  _Pragma("unroll") for (int qg = 0; qg < 2; ++qg) _Pragma("unroll") for (int dt = 0; dt < DT; ++dt) asm volatile("s_nop 7" : "+v"(o[qg][dt]));
  _Pragma("unroll") for (int qg = 0; qg < 2; ++qg) {
    float l = lsum[qg];
    l += __shfl_xor(l, 16); l += __shfl_xor(l, 32);
    const float inv = 1.f / l;
    _Pragma("unroll") for (int dt = 0; dt < DT; ++dt) {
      uint2 pk; pk.x = cvt_pk_bf16(o[qg][dt][0] * inv, o[qg][dt][1] * inv); pk.y = cvt_pk_bf16(o[qg][dt][2] * inv, o[qg][dt][3] * inv);
      *(uint2*)(O + (size_t)(qg * 16 + fr) * ldo + 16 * dt + 4 * g) = pk;
    }
  }
}

template <bool NAL>
__device__ __forceinline__ void attn_block_na(const bf16_t* Qw, bf16_t* Ow, const bf16_t* K0, const bf16_t* V0, int ldv0, int nloc,
                                              const bf16_t* K1, const bf16_t* V1, int nctx, const float* rpb_h, int rr, int rs, int urow0, int qc0) {
  constexpr int KS = 2, DT = 4, KROW = 144, VROW = 80, KBUF = 32 * KROW, VBUF = 64 * VROW;
  const int tid = opaque_tid(), lane = tid & 63, fr = lane & 15, g = lane >> 4;
  unsigned char* kS = smem;
  unsigned char* vS = smem + 2 * KBUF;
  bf16x8 qf[2][KS];
  _Pragma("unroll") for (int qg = 0; qg < 2; ++qg) _Pragma("unroll") for (int ks = 0; ks < KS; ++ks) qf[qg][ks] = *(const bf16x8*)(Qw + (size_t)(qg * 16 + fr) * 2048 + ks * 32 + 8 * g);
  f32x4 o[2][DT];
  _Pragma("unroll") for (int qg = 0; qg < 2; ++qg) _Pragma("unroll") for (int dt = 0; dt < DT; ++dt) o[qg][dt] = (f32x4){0.f, 0.f, 0.f, 0.f};
  float lsum[2] = {0.f, 0.f};
  const int krow_in = 8 * (fr >> 2) + (fr & 3);
  const bool isk = tid < 256; const int t2 = tid & 255;
  const int sa = isk ? (t2 >> 3) : (t2 >> 2), sp = isk ? (t2 & 7) : (t2 & 3);
  const int nch = nloc + nctx;
  uint4 rg;
#define LD_CHUNK(c_) do { const int c__ = (c_); const bool loc_ = c__ < nloc; const int cc_ = loc_ ? c__ : c__ - nloc; \
    const bf16_t* kp_ = (loc_ ? K0 + (size_t)(cc_ * 32 + sa) * 2048 : K1 + (size_t)(cc_ * 32 + sa) * 1024) + sp * 8; \
    const bf16_t* vp_ = (loc_ ? V0 + (size_t)sa * ldv0 : V1 + (size_t)sa * 512) + cc_ * 32 + sp * 8; \
    rg = *(const uint4*)(isk ? kp_ : vp_); } while (0)
#define ST_CHUNK(buf_) do { if (isk) *(uint4*)(kS + (buf_) * KBUF + sa * KROW + sp * 16) = rg; else *(uint4*)(vS + (buf_) * VBUF + sa * VROW + sp * 16) = rg; } while (0)
  __syncthreads();
  LD_CHUNK(0); ST_CHUNK(0);
  __syncthreads();
  for (int c = 0; c < nch; ++c) {
    const int buf = c & 1;
    if (c + 1 < nch) LD_CHUNK(c + 1);
    const unsigned char* kb = kS + buf * KBUF; const unsigned char* vb = vS + buf * VBUF;
    bf16x8 kf[2][KS], vf[DT];
    _Pragma("unroll") for (int t = 0; t < 2; ++t) _Pragma("unroll") for (int ks = 0; ks < KS; ++ks) kf[t][ks] = *(const bf16x8*)(kb + (krow_in + 4 * t) * KROW + (ks * 32 + 8 * g) * 2);
    _Pragma("unroll") for (int dt = 0; dt < DT; ++dt) vf[dt] = *(const bf16x8*)(vb + (16 * dt + fr) * VROW + 16 * g);
    f32x4 s[2][2];
    _Pragma("unroll") for (int qg = 0; qg < 2; ++qg) _Pragma("unroll") for (int t = 0; t < 2; ++t) {
      s[qg][t] = (f32x4){0.f, 0.f, 0.f, 0.f};
      _Pragma("unroll") for (int ks = 0; ks < KS; ++ks) s[qg][t] = __builtin_amdgcn_mfma_f32_16x16x32_bf16(kf[t][ks], qf[qg][ks], s[qg][t], 0, 0, 0);
    }
    asm volatile("s_nop 15" : "+v"(s[0][0]), "+v"(s[0][1]), "+v"(s[1][0]), "+v"(s[1][1]));
    bf16x8 pf[2];
    _Pragma("unroll") for (int qg = 0; qg < 2; ++qg) {
      float pv[8];
      _Pragma("unroll") for (int i = 0; i < 8; ++i) {
        const float sv = s[qg][i >> 2][i & 3];
        if (NAL && c < nloc) {
          const int krow = urow0 + (c >> 1), kcol = (c & 1) * 32 + 8 * g + i;
          const int qc = qc0 + qg * 16 + fr;
          const int cs = min(max(qc - 8, 0), 48);
          const bool valid = (krow >= rs) && (krow < rs + 8) && (kcol >= cs) && (kcol < cs + 16);
          const int bi = valid ? (krow - rr + 7) * 31 + (kcol - qc + 15) : 0;
          const float bias = rpb_h[bi];
          pv[i] = valid ? __builtin_amdgcn_exp2f(sv + bias * LOG2E) : 0.f;
        } else {
          pv[i] = __builtin_amdgcn_exp2f(sv);
        }
        lsum[qg] += pv[i];
      }
      union { bf16x8 v; unsigned u[4]; } pk;
      _Pragma("unroll") for (int i = 0; i < 4; ++i) pk.u[i] = cvt_pk_bf16(pv[2 * i], pv[2 * i + 1]);
      pf[qg] = pk.v;
    }
    asm volatile("s_nop 3" : "+v"(pf[0]), "+v"(pf[1]));
    _Pragma("unroll") for (int qg = 0; qg < 2; ++qg) _Pragma("unroll") for (int dt = 0; dt < DT; ++dt)
      o[qg][dt] = __builtin_amdgcn_mfma_f32_16x16x32_bf16(vf[dt], pf[qg], o[qg][dt], 0, 0, 0);
    if (c + 1 < nch) ST_CHUNK(buf ^ 1);
    __syncthreads();
  }
#undef LD_CHUNK
#undef ST_CHUNK
  _Pragma("unroll") for (int qg = 0; qg < 2; ++qg) _Pragma("unroll") for (int dt = 0; dt < DT; ++dt) asm volatile("s_nop 7" : "+v"(o[qg][dt]));
  _Pragma("unroll") for (int qg = 0; qg < 2; ++qg) {
    float l = lsum[qg];
    l += __shfl_xor(l, 16); l += __shfl_xor(l, 32);
    const float inv = 1.f / l;
    _Pragma("unroll") for (int dt = 0; dt < DT; ++dt) {
      uint2 pk; pk.x = cvt_pk_bf16(o[qg][dt][0] * inv, o[qg][dt][1] * inv); pk.y = cvt_pk_bf16(o[qg][dt][2] * inv, o[qg][dt][3] * inv);
      *(uint2*)(Ow + (size_t)(qg * 16 + fr) * 1024 + 16 * dt + 4 * g) = pk;
    }
  }
}

__device__ void phase_attn_na(const Params& p) {
  const int wave = opaque_tid() >> 6;
  const bf16_t* QK = (const bf16_t*)(p.ws + WS_QK);
  const bf16_t* VT = (const bf16_t*)(p.ws + WS_VT);
  const bf16_t* CK = (const bf16_t*)(p.ws + WS_CKNA);
  const bf16_t* CVT = (const bf16_t*)(p.ws + WS_CVTNA);
  bf16_t* AO = (bf16_t*)(p.ws + WS_AO);
  for (int id = blockIdx.x; id < 256; id += gridDim.x) {
    const int k4 = id & 3, h = (id >> 2) & 15, b = id >> 6;
    const int r = k4 * 4 + (wave >> 1), wq = wave & 1;
    const int rs = min(max(r - 4, 0), 8);
    const int urow0 = min(max(k4 * 4 - 4, 0), 8), urow1 = min(max(k4 * 4 + 3 - 4, 0), 8) + 8;
    const int tokq = 4096 + b * 1024 + r * 64 + wq * 32;
    const int tokk = 4096 + b * 1024 + urow0 * 64;
    attn_block_na<true>(QK + (size_t)tokq * 2048 + h * 64, AO + (size_t)tokq * 1024 + h * 64,
                        QK + (size_t)tokk * 2048 + 1024 + h * 64,
                        VT + (size_t)4096 * 1024 + ((size_t)b * 1024 + h * 64) * 1024 + urow0 * 64, 1024, (urow1 - urow0) * 2,
                        CK + (size_t)b * 512 * 1024 + h * 64, CVT + ((size_t)b * 1024 + h * 64) * 512, 16,
                        p.in[27] + h * 15 * 31, r, rs, urow0, wq * 32);
  }
  for (int id = blockIdx.x * 8 + wave; id < 2048; id += gridDim.x * 8) {
    const int qb = id & 7, h = (id >> 3) & 15, b = id >> 7;
    const int tokq = b * 256 + qb * 32;
    attn_wave<64, false>(QK + (size_t)tokq * 2048 + h * 64, 2048,
                         QK + (size_t)(b * 256) * 2048 + 1024 + h * 64, 2048,
                         VT + ((size_t)b * 1024 + h * 64) * 256, 256, 256,
                         nullptr, 0, nullptr, 0, 0,
                         AO + (size_t)tokq * 1024 + h * 64, 1024, nullptr, 0, 0, 0);
  }
}

__device__ __forceinline__ void attn_block_gqa_latent(const bf16_t* Q, const bf16_t* K0, const bf16_t* V0, const bf16_t* K1, const bf16_t* V1, bf16_t* O) {
  constexpr int DH = 128, KS = 4, DT = 8, KROW = 272, VROW = 80, KBUF = 32 * KROW, VBUF = 128 * VROW, NCH = 48;
  const int tid = opaque_tid(), lane = tid & 63, wave = tid >> 6, fr = lane & 15, g = lane >> 4;
  unsigned char* kS = smem;
  unsigned char* vS = smem + 2 * KBUF;
  const bf16_t* Qw = Q + (size_t)(wave * 32) * 1280;
  bf16x8 qf[2][KS];
  _Pragma("unroll") for (int qg = 0; qg < 2; ++qg) _Pragma("unroll") for (int ks = 0; ks < KS; ++ks) qf[qg][ks] = *(const bf16x8*)(Qw + (size_t)(qg * 16 + fr) * 1280 + ks * 32 + 8 * g);
  f32x4 o[2][DT];
  _Pragma("unroll") for (int qg = 0; qg < 2; ++qg) _Pragma("unroll") for (int dt = 0; dt < DT; ++dt) o[qg][dt] = (f32x4){0.f, 0.f, 0.f, 0.f};
  float lsum[2] = {0.f, 0.f};
  const int krow_in = 8 * (fr >> 2) + (fr & 3);
  const int skey = tid >> 4, skp = tid & 15, sd = tid >> 2, svp = tid & 3;
  uint4 rk, rv;
#define LD_CHUNK(c_) do { const int kc_ = (c_) * 32; \
    if (kc_ < 1024) { rk = *(const uint4*)(K0 + (size_t)(kc_ + skey) * 1280 + skp * 8); rv = *(const uint4*)(V0 + (size_t)sd * 1024 + kc_ + svp * 8); } \
    else { rk = *(const uint4*)(K1 + (size_t)(kc_ - 1024 + skey) * 256 + skp * 8); rv = *(const uint4*)(V1 + (size_t)sd * 512 + (kc_ - 1024) + svp * 8); } } while (0)
#define ST_CHUNK(buf_) do { *(uint4*)(kS + (buf_) * KBUF + skey * KROW + skp * 16) = rk; *(uint4*)(vS + (buf_) * VBUF + sd * VROW + svp * 16) = rv; } while (0)
  __syncthreads();
  LD_CHUNK(0); ST_CHUNK(0);
  __syncthreads();
  for (int c = 0; c < NCH; ++c) {
    const int buf = c & 1;
    if (c + 1 < NCH) LD_CHUNK(c + 1);
    const unsigned char* kb = kS + buf * KBUF; const unsigned char* vb = vS + buf * VBUF;
    bf16x8 kf[2][KS], vf[DT];
    _Pragma("unroll") for (int t = 0; t < 2; ++t) _Pragma("unroll") for (int ks = 0; ks < KS; ++ks) kf[t][ks] = *(const bf16x8*)(kb + (krow_in + 4 * t) * KROW + (ks * 32 + 8 * g) * 2);
    _Pragma("unroll") for (int dt = 0; dt < DT; ++dt) vf[dt] = *(const bf16x8*)(vb + (16 * dt + fr) * VROW + 16 * g);
    f32x4 s[2][2];
    _Pragma("unroll") for (int qg = 0; qg < 2; ++qg) _Pragma("unroll") for (int t = 0; t < 2; ++t) {
      s[qg][t] = (f32x4){0.f, 0.f, 0.f, 0.f};
      _Pragma("unroll") for (int ks = 0; ks < KS; ++ks) s[qg][t] = __builtin_amdgcn_mfma_f32_16x16x32_bf16(kf[t][ks], qf[qg][ks], s[qg][t], 0, 0, 0);
    }
    asm volatile("s_nop 15" : "+v"(s[0][0]), "+v"(s[0][1]), "+v"(s[1][0]), "+v"(s[1][1]));
    bf16x8 pf[2];
    _Pragma("unroll") for (int qg = 0; qg < 2; ++qg) {
      float pv[8];
      _Pragma("unroll") for (int i = 0; i < 8; ++i) { pv[i] = __builtin_amdgcn_exp2f(s[qg][i >> 2][i & 3]); lsum[qg] += pv[i]; }
      union { bf16x8 v; unsigned u[4]; } pk;
      _Pragma("unroll") for (int i = 0; i < 4; ++i) pk.u[i] = cvt_pk_bf16(pv[2 * i], pv[2 * i + 1]);
      pf[qg] = pk.v;
    }
    asm volatile("s_nop 3" : "+v"(pf[0]), "+v"(pf[1]));
    _Pragma("unroll") for (int qg = 0; qg < 2; ++qg) _Pragma("unroll") for (int dt = 0; dt < DT; ++dt)
      o[qg][dt] = __builtin_amdgcn_mfma_f32_16x16x32_bf16(vf[dt], pf[qg], o[qg][dt], 0, 0, 0);
    if (c + 1 < NCH) ST_CHUNK(buf ^ 1);
    __syncthreads();
  }
#undef LD_CHUNK
#undef ST_CHUNK
  _Pragma("unroll") for (int qg = 0; qg < 2; ++qg) _Pragma("unroll") for (int dt = 0; dt < DT; ++dt) asm volatile("s_nop 7" : "+v"(o[qg][dt]));
  bf16_t* Ow = O + (size_t)(wave * 32) * 1024;
  _Pragma("unroll") for (int qg = 0; qg < 2; ++qg) {
    float l = lsum[qg];
    l += __shfl_xor(l, 16); l += __shfl_xor(l, 32);
    const float inv = 1.f / l;
    _Pragma("unroll") for (int dt = 0; dt < DT; ++dt) {
      uint2 pk; pk.x = cvt_pk_bf16(o[qg][dt][0] * inv, o[qg][dt][1] * inv); pk.y = cvt_pk_bf16(o[qg][dt][2] * inv, o[qg][dt][3] * inv);
      *(uint2*)(Ow + (size_t)(qg * 16 + fr) * 1024 + 16 * dt + 4 * g) = pk;
    }
  }
}

__device__ void phase_attn_gqa(const Params& p) {
  const int wave = opaque_tid() >> 6;
  const bf16_t* QK = (const bf16_t*)(p.ws + WS_QK);
  const bf16_t* VT = (const bf16_t*)(p.ws + WS_VT);
  const bf16_t* CK = (const bf16_t*)(p.ws + WS_CKGQA);
  const bf16_t* CVT = (const bf16_t*)(p.ws + WS_CVTGQA);
  bf16_t* AO = (bf16_t*)(p.ws + WS_AO);
  const int G = gridDim.x, nlat = G >= 256 ? 128 : G / 2;
  if ((int)blockIdx.x < nlat) {
    for (int id = blockIdx.x; id < 128; id += nlat) {
      const int qblk = id & 3, hq = (id >> 2) & 7, b = id >> 5, hk = hq >> 2;
      const int tokq = 4096 + b * 1024 + qblk * 256;
      attn_block_gqa_latent(QK + (size_t)tokq * 1280 + hq * 128,
                            QK + (size_t)(4096 + b * 1024) * 1280 + 1024 + hk * 128,
                            VT + (size_t)4096 * 256 + ((size_t)b * 256 + hk * 128) * 1024,
                            CK + (size_t)b * 512 * 256 + hk * 128,
                            CVT + ((size_t)b * 256 + hk * 128) * 512,
                            AO + (size_t)tokq * 1024 + hq * 128);
    }
  } else {
    const int nw = (G - nlat) * 8;
    for (int id = ((int)blockIdx.x - nlat) * 8 + wave; id < 1024; id += nw) {
      const int qb = id & 7, hq = (id >> 3) & 7, b = id >> 6, hk = hq >> 2;
      const int tokq = b * 256 + qb * 32;
      attn_wave<128, false>(QK + (size_t)tokq * 1280 + hq * 128, 1280,
                            QK + (size_t)(b * 256) * 1280 + 1024 + hk * 128, 1280,
                            VT + ((size_t)b * 256 + hk * 128) * 256, 256, 256,
                            nullptr, 0, nullptr, 0, 0,
                            AO + (size_t)tokq * 1024 + hq * 128, 1024, nullptr, 0, 0, 0);
    }
  }
}

#define XB_TMO      128
#define XB_XCNT(j)  (256  + 64 * (j))
#define XB_XSUB(j)  (1280 + 64 * (j))
#define XB_XGEN(j)  (2304 + 64 * (j))
#define XB_TOP      3328
#define XB_TOPGEN   3392
#define XCD_BAR_WORDS 3456
#define XB_SPIN_CAP (1u << 18)
#define LAS __attribute__((address_space(3)))

__device__ __forceinline__ unsigned xb_ld(unsigned* p)              { return __hip_atomic_load(p, __ATOMIC_RELAXED, __HIP_MEMORY_SCOPE_AGENT); }
__device__ __forceinline__ unsigned xb_add(unsigned* p, unsigned v) { return __hip_atomic_fetch_add(p, v, __ATOMIC_RELAXED, __HIP_MEMORY_SCOPE_AGENT); }
__device__ __forceinline__ unsigned xb_xcc_id() { return (unsigned)__builtin_amdgcn_s_getreg((3 << 11) | 20) & 0xFu; }
#define XB_SPIN(cond, bar) do { unsigned _sp = 0; while (cond) { __builtin_amdgcn_s_sleep(1); \
    if ((++_sp & 255u) == 0u) { if (xb_ld(&(bar)[XB_TMO])) break; if (_sp > XB_SPIN_CAP) { atomicAdd(&(bar)[XB_TMO], 1u); break; } } } } while (0)

struct XcdBarrier {
    unsigned* bar; unsigned x;
    volatile LAS unsigned* st;
};

__device__ __forceinline__ XcdBarrier xcd_barrier_post(unsigned* bar, volatile LAS unsigned* st) {
    XcdBarrier b; b.bar = bar; b.x = xb_xcc_id(); b.st = st;
    if (threadIdx.x == 0) (void)xb_add(&bar[XB_XCNT(b.x)], 1u);
    return b;
}
__device__ __forceinline__ void xcd_barrier_complete(unsigned* bar, unsigned x, unsigned& nloc, unsigned& nx) {
    const unsigned G = gridDim.x * gridDim.y * gridDim.z;
    unsigned sum, cnt, mine, sp = 0u;
    for (;;) {
        sum = 0u; cnt = 0u; mine = 0u;
#pragma unroll
        for (unsigned j = 0; j < 16; ++j) { const unsigned c = xb_ld(&bar[XB_XCNT(j)]); sum += c; cnt += (c > 0u) ? 1u : 0u; mine = (j == x) ? c : mine; }
        if (sum == G) break;
        __builtin_amdgcn_s_sleep(1);
        if ((++sp & 255u) == 0u) { if (xb_ld(&bar[XB_TMO])) break; if (sp > XB_SPIN_CAP) { atomicAdd(&bar[XB_TMO], 1u); break; } }
    }
    nloc = mine > 0u ? mine : 1u; nx = cnt > 0u ? cnt : 1u;
}

__device__ __forceinline__ void xcd_barrier(const XcdBarrier& b) {
    asm volatile("s_waitcnt vmcnt(0)" ::: "memory");
    __syncthreads();
    if (threadIdx.x == 0) {
        unsigned* bar = b.bar; unsigned xb_probe = 0u;
        __builtin_amdgcn_s_waitcnt(0);
        unsigned nloc = b.st[0], nx = b.st[1];
        if (nloc == 0u) { xcd_barrier_complete(bar, b.x, nloc, nx); b.st[0] = nloc; b.st[1] = nx; }
        const unsigned old = xb_add(&bar[XB_XSUB(b.x)], 1u);
        const unsigned gen = old / nloc;
        if (old + 1u == (gen + 1u) * nloc) {
            __builtin_amdgcn_fence(__ATOMIC_RELEASE, "agent");
            asm volatile("s_waitcnt vmcnt(0)" ::: "memory");
            const unsigned og = xb_add(&bar[XB_TOP], 1u);
            const unsigned tg = og / nx;
            if (og + 1u == (tg + 1u) * nx) xb_add(&bar[XB_TOPGEN], 1u);
            else XB_SPIN(xb_ld(&bar[XB_TOPGEN]) == tg, bar);
            __builtin_amdgcn_fence(__ATOMIC_ACQUIRE, "agent"); xb_probe = xb_ld(&bar[XB_TMO]);
            xb_add(&bar[XB_XGEN(b.x)], 1u);
            asm volatile("s_waitcnt vmcnt(0)" ::: "memory");
        } else {
            XB_SPIN(xb_ld(&bar[XB_XGEN(b.x)]) == gen, bar);
            __builtin_amdgcn_fence(__ATOMIC_ACQUIRE, "agent"); xb_probe = xb_ld(&bar[XB_TMO]);
            asm volatile("s_waitcnt vmcnt(0)" ::: "memory");
        }
        asm volatile("" :: "v"(xb_probe));
        __builtin_amdgcn_s_sleep(80);
    }
    __syncthreads();
}


__device__ void phase_fake_mlp1(const Params& p) {
  const int tid = opaque_tid();
  const uint4* HB = (const uint4*)(p.ws + WS_HB);
  uint4* ACT = (uint4*)(p.ws + WS_ACT);
  for (size_t i = (size_t)blockIdx.x * NT + tid; i < (size_t)NTOK * DFF / 8; i += (size_t)gridDim.x * NT) {
    const size_t row = i >> 9, c8 = i & 511;
    uint4 v = HB[row * 128 + (c8 & 127)];
    unsigned w[4] = {v.x, v.y, v.z, v.w};
    for (int j = 0; j < 4; ++j) { float a = bflo(w[j]), b = bfhi(w[j]); w[j] = cvt_pk_bf16(a * a, b * b); }
    ACT[i] = make_uint4(w[0], w[1], w[2], w[3]);
  }
}
__global__ void __launch_bounds__(NT) fwd_megakernel(Params p) {
  cg::grid_group grid = cg::this_grid();
  unsigned char* ws = p.ws;
  const float* MOD = (const float*)(ws + WS_MOD);
  bf16_t* HB = (bf16_t*)(ws + WS_HB);
  bf16_t* AO = (bf16_t*)(ws + WS_AO);
  bf16_t* QK = (bf16_t*)(ws + WS_QK);
  bf16_t* VT = (bf16_t*)(ws + WS_VT);
  bf16_t* ACT = (bf16_t*)(ws + WS_ACT);
  int ph = 0;
#ifdef CHK_INPUT
  { float* chk = (float*)(ws + WS_END);
    const int t = opaque_tid();
    const float* sp = p.in[CHK_INPUT];
    const size_t per = (size_t)CHK_COUNT / gridDim.x;
    float s = 0.f;
    for (size_t i = t; i < per; i += NT) { float v = sp[(size_t)blockIdx.x * per + i]; s += v * (1.f + (float)(i & 15)); }
    float* red = (float*)smem; red[t] = s; __syncthreads();
    if (t == 0) { float a = 0.f; for (int i = 0; i < NT; ++i) a += red[i]; chk[blockIdx.x] = a; }
    __syncthreads(); }
#endif
#ifdef START_DELAY_TICKS
  { const unsigned long long t0 = __builtin_amdgcn_s_memrealtime(); while (__builtin_amdgcn_s_memrealtime() - t0 < START_DELAY_TICKS) __builtin_amdgcn_s_sleep(8); }
#endif
  volatile LAS unsigned* xb_st = (volatile LAS unsigned*)(smem + 131072);
  if (threadIdx.x < 2) xb_st[threadIdx.x] = 0u;
  __syncthreads();
  XcdBarrier xbar = xcd_barrier_post((unsigned*)(ws + WS_BAR), xb_st);
  if (p.ph_hi - p.ph_lo > 1) grid.sync();
#ifdef EXTRA_SYNCS
  for (int i_ = 0; i_ < EXTRA_SYNCS; ++i_) grid.sync();
#endif
#ifndef EN_GEMM
#define EN_GEMM 15
#endif
#ifndef EN_ATTN
#define EN_ATTN 1
#endif
#ifndef EN_S5
#define EN_S5 1
#endif
#ifndef EN_MISC
#define EN_MISC 1
#endif
#define RUN(body) do { if (p.ph_lo <= ph && ph < p.ph_hi) { body; if (ph + 1 < p.ph_hi) xcd_barrier(xbar); } ++ph; } while (0)

  RUN(if (EN_MISC) phase_prologue(p));
  for (int layer = 0; layer < 4; ++layer) {
    const int kind = layer % 3, slot = layer / 3;
    RUN(if (EN_MISC) phase_norm(p, layer, 0, layer == 0));
    if (kind == 0) {
      RUN(if (EN_S5) phase_s5_pass1(p, slot));
      RUN(if (EN_S5) phase_s5_pass2(p, slot));
      { GemmArgs ga{HB, D, (const bf16_t*)(ws + WS_GLUT) + (size_t)slot * 2048 * 1024, D, 32, 16, 1024, 0xffff};
        EpiGlu e{p.out, MOD + layer * 5 * 6144 + 2 * 1024, p.in[23] + slot * 2048};
        RUN(if (EN_GEMM & 1) gemm_phase<128>(ga, e)); }
    } else if (kind == 1) {
      { GemmArgs ga{HB, D, (const bf16_t*)(ws + WS_NAQKVT), D, 32, 24, 1024, 0xffff};
        EpiQkv e{QK, 2048, VT, 1024, p.out + OUT_NAV};
        RUN(if (EN_GEMM & 2) gemm_phase<128>(ga, e)); }
      RUN(if (EN_MISC) phase_post_na(p));
      RUN(if (EN_ATTN) phase_attn_na(p));
      { GemmArgs ga{AO, D, (const bf16_t*)(ws + WS_NAOT), D, 32, 8, 1024, 0xffff};
        EpiResid e{p.out, MOD + layer * 5 * 6144 + 2 * 1024};
        RUN(if (EN_GEMM & 4) gemm_phase<128>(ga, e)); }
    } else {
      { GemmArgs ga{HB, D, (const bf16_t*)(ws + WS_GQAQKVT), D, 32, 12, 1024, 0xffff};
        EpiQkv e{QK, 1280, VT, 256, p.out + OUT_GQAV};
        RUN(if (EN_GEMM & 2) gemm_phase<128>(ga, e)); }
      RUN(if (EN_MISC) phase_post_gqa(p));
      RUN(if (EN_ATTN) phase_attn_gqa(p));
      { GemmArgs ga{AO, D, (const bf16_t*)(ws + WS_GQAOT), D, 32, 8, 1024, 0xffff};
        EpiResid e{p.out, MOD + layer * 5 * 6144 + 2 * 1024};
        RUN(if (EN_GEMM & 4) gemm_phase<128>(ga, e)); }
    }
    RUN(if (EN_MISC) phase_norm(p, layer, 1, false));
    { GemmArgs ga{HB, D, (const bf16_t*)(ws + WS_W1T) + (size_t)layer * 4096 * 1024, D, 32, 16, 1024, 0xffff};
      EpiSqRelu e{ACT};
      RUN(if (EN_GEMM & 8) gemm_phase<256>(ga, e)); }
    { GemmArgs ga{ACT, DFF, (const bf16_t*)(ws + WS_W2T) + (size_t)layer * 1024 * 4096, DFF, 32, 8, 4096, 0xffff};
      EpiResid e{p.out, MOD + layer * 5 * 6144 + 5 * 1024};
      RUN(if (EN_GEMM & 4) gemm_phase<128>(ga, e)); }
  }
#ifdef FINAL_SYNC
  if (p.ph_hi - p.ph_lo > 1) { grid.sync(); { const unsigned long long t0 = __builtin_amdgcn_s_memrealtime(); while (__builtin_amdgcn_s_memrealtime() - t0 < 2000ull) __builtin_amdgcn_s_sleep(8); } grid.sync(); }
#endif
#ifdef DUMP_S5P
  if (p.ph_hi - p.ph_lo > 1) {
    grid.sync();
    const float* sa = (const float*)(ws + WS_S5A);
    const unsigned* sb = (const unsigned*)(ws + WS_S5BB);
    const unsigned* sc = (const unsigned*)(ws + WS_S5CM);
    for (size_t i = (size_t)blockIdx.x * NT + opaque_tid(); i < 524288; i += (size_t)gridDim.x * NT) {
      if (i < 32768) p.out[i] = sa[i];
      unsigned w = sb[i]; p.out[65536 + 2 * i] = bflo(w); p.out[65536 + 2 * i + 1] = bfhi(w);
      unsigned w2 = sc[i]; p.out[2097152 + 2 * i] = bflo(w2); p.out[2097152 + 2 * i + 1] = bfhi(w2);
    }
  }
#endif
#ifdef DUMP_E
  if (p.ph_hi - p.ph_lo > 1) {
    grid.sync();
    const float* sp = (const float*)(ws + WS_S5E);
    for (size_t i = (size_t)blockIdx.x * NT + opaque_tid(); i < 2097152; i += (size_t)gridDim.x * NT) p.out[i] = sp[i];
  }
#endif
#ifdef DUMP_HB
  if (p.ph_hi - p.ph_lo > 1) {
    grid.sync();
    const unsigned* sp = (const unsigned*)(ws + WS_HB);
    for (size_t i = (size_t)blockIdx.x * NT + opaque_tid(); i < 4194304; i += (size_t)gridDim.x * NT) {
      unsigned w = sp[i]; p.out[2 * i] = bflo(w); p.out[2 * i + 1] = bfhi(w);
    }
  }
#endif
#ifdef DUMP_W2T
  if (p.ph_lo == 100) {
    const unsigned* sp = (const unsigned*)(ws + WS_W2T);
    for (size_t i = (size_t)blockIdx.x * NT + opaque_tid(); i < 19398656 / 2; i += (size_t)gridDim.x * NT) {
      float a = 0.f, b = 0.f;
      if (i < 2097152) { unsigned w = sp[i]; a = bflo(w); b = bfhi(w); }
      p.out[2 * i] = a; p.out[2 * i + 1] = b;
    }
  }
#endif
#undef RUN
#ifdef CHK_W2T
  grid.sync();
  { float* chk = (float*)(ws + WS_END);
    const int t = opaque_tid();
    const unsigned* sp = (const unsigned*)(ws + WS_W2T);
    const size_t per = (size_t)(33554432 / 4) / gridDim.x;
    float s = 0.f;
    for (size_t i = t; i < per; i += NT) { unsigned w = sp[(size_t)blockIdx.x * per + i]; s += (bflo(w) + 2.f * bfhi(w)) * (1.f + (float)(i & 15)); }
    float* red = (float*)smem; red[t] = s; __syncthreads();
    if (t == 0) { float a = 0.f; for (int i = 0; i < NT; ++i) a += red[i]; chk[blockIdx.x] = a; }
    __syncthreads(); }
  grid.sync();
  { const float* chk = (const float*)(ws + WS_END);
    for (size_t i = (size_t)blockIdx.x * NT + opaque_tid(); i < 19398656; i += (size_t)gridDim.x * NT) p.out[i] = chk[(i >> 10) & 255]; }
#endif
#ifdef CHK_INPUT
  grid.sync();
  { const float* chk = (const float*)(ws + WS_END);
    for (size_t i = (size_t)blockIdx.x * NT + opaque_tid(); i < 19398656; i += (size_t)gridDim.x * NT) p.out[i] = chk[(i >> 10) & 255]; }
#endif
}

extern "C" void kernel_launch(void* const* d_in, const int* in_sizes, int n_in, void* d_out, int out_size, void* d_ws, size_t ws_size, hipStream_t stream) {
  static int grid_blocks = 0;
  if (grid_blocks == 0) {
    if (n_in != 33 || ws_size < WS_END) { fprintf(stderr, "kernel_launch: unexpected n_in %d or ws_size %zu (< %zu)\n", n_in, ws_size, (size_t)WS_END); grid_blocks = -1; return; }
    int dev = 0, cus = 0, per_cu = 0;
    (void)hipGetDevice(&dev);
    (void)hipDeviceGetAttribute(&cus, hipDeviceAttributeMultiprocessorCount, dev);
    if (hipFuncSetAttribute((const void*)fwd_megakernel, hipFuncAttributeMaxDynamicSharedMemorySize, LDS_BYTES) != hipSuccess) { fprintf(stderr, "hipFuncSetAttribute failed\n"); grid_blocks = -1; return; }
    if (hipOccupancyMaxActiveBlocksPerMultiprocessor(&per_cu, (const void*)fwd_megakernel, NT, LDS_BYTES) != hipSuccess || per_cu < 1) { fprintf(stderr, "occupancy query failed (%d)\n", per_cu); (void)hipGetLastError(); per_cu = 1; }
    grid_blocks = cus * 1;
    fprintf(stderr, "kernel_launch: cus %d per_cu %d grid %d\n", cus, per_cu, grid_blocks);
  }
  if (grid_blocks < 0) return;
  (void)hipMemsetAsync((unsigned char*)d_ws + WS_BAR, 0, 16384, stream);
  Params p{};
  for (int i = 0; i < 33; ++i) p.in[i] = (const float*)d_in[i];
  p.out = (float*)d_out; p.ws = (unsigned char*)d_ws;
#if N_LAUNCH_MODE == 1
  #ifndef PH_HI
#define PH_HI NPHASE
#endif
  p.ph_lo = 0; p.ph_hi = PH_HI;
  void* args[] = {&p};
  hipError_t e = hipLaunchCooperativeKernel((void*)fwd_megakernel, dim3(grid_blocks), dim3(NT), args, LDS_BYTES, stream);
  if (e != hipSuccess) fprintf(stderr, "cooperative launch failed: %s (grid %d)\n", hipGetErrorString(e), grid_blocks);
#else
#ifndef PH_HI
#define PH_HI NPHASE
#endif
  for (int ph = 0; ph < PH_HI; ++ph) {
    p.ph_lo = ph; p.ph_hi = ph + 1;
    hipLaunchKernelGGL(fwd_megakernel, dim3(grid_blocks), dim3(NT), LDS_BYTES, stream, p);
  }
#ifdef DUMP_W2T
  p.ph_lo = 100; p.ph_hi = 101;
  hipLaunchKernelGGL(fwd_megakernel, dim3(grid_blocks), dim3(NT), LDS_BYTES, stream, p);
#endif
#endif
}
```

```cpp
#include <hip/hip_runtime.h>
#include <hip/hip_bf16.h>
#include <hip/hip_cooperative_groups.h>
#include <cstdio>
namespace cg = cooperative_groups;

typedef unsigned short bf16_t;
using bf16 = __hip_bfloat16;
using bf16x8 = __attribute__((ext_vector_type(8))) short;
using f32x4 = __attribute__((ext_vector_type(4))) float;
using f32x16 = __attribute__((ext_vector_type(16))) float;

#define B_AUX 0
#ifndef USE_GLDS
#define USE_GLDS 1
#endif
#ifndef N_LAUNCH_MODE
#define N_LAUNCH_MODE 1
#endif

constexpr int NT = 512;
constexpr int D = 1024, NTOK = 8192, DFF = 4096;
constexpr int LDS_BYTES = 131072 + 64;
constexpr int NPHASE = 31;

constexpr size_t WS_W1T = 0;
constexpr size_t WS_W2T = WS_W1T + 33554432;
constexpr size_t WS_GLUT = WS_W2T + 33554432;
constexpr size_t WS_NAQKVT = WS_GLUT + 8388608;
constexpr size_t WS_NAOT = WS_NAQKVT + 6291456;
constexpr size_t WS_GQAQKVT = WS_NAOT + 2097152;
constexpr size_t WS_GQAOT = WS_GQAQKVT + 3145728;
constexpr size_t WS_MOD = WS_GQAOT + 2097152;
constexpr size_t WS_S5A = WS_MOD + 491520;
constexpr size_t WS_S5BB = WS_S5A + 131072;
constexpr size_t WS_S5CM = WS_S5BB + 1048576;
constexpr size_t WS_S5E = WS_S5CM + 1048576;
constexpr size_t WS_CKNA = WS_S5E + 8388608;
constexpr size_t WS_CVTNA = WS_CKNA + 4194304;
constexpr size_t WS_CKGQA = WS_CVTNA + 4194304;
constexpr size_t WS_CVTGQA = WS_CKGQA + 1048576;
constexpr size_t WS_HB = WS_CVTGQA + 1048576;
constexpr size_t WS_AO = WS_HB + 16777216;
constexpr size_t WS_QK = WS_AO + 16777216;
constexpr size_t WS_VT = WS_QK + 33554432;
constexpr size_t WS_ACT = WS_VT + 16777216;
constexpr size_t WS_BAR = WS_ACT + 67108864;
constexpr size_t WS_END = WS_BAR + 16384;

constexpr size_t OUT_YS = 4194304, OUT_S5 = 8388608, OUT_NAK = 8912896, OUT_NAV = 13107200, OUT_GQAK = 17301504, OUT_GQAV = 18350080;

struct Params {
  const float* in[33];
  float* out;
  unsigned char* ws;
  int ph_lo, ph_hi;
};

extern __shared__ __attribute__((aligned(16))) unsigned char smem[];

__device__ __forceinline__ unsigned cvt_pk_bf16(float lo, float hi) {
  unsigned r; asm("v_cvt_pk_bf16_f32 %0, %1, %2" : "=v"(r) : "v"(lo), "v"(hi)); return r;
}
__device__ __forceinline__ bf16_t f2bf(float f) { return (bf16_t)(cvt_pk_bf16(f, 0.f) & 0xffffu); }
__device__ __forceinline__ float bf2f(bf16_t b) { return __uint_as_float(((unsigned)b) << 16); }
__device__ __forceinline__ float bflo(unsigned u) { return __uint_as_float(u << 16); }
__device__ __forceinline__ float bfhi(unsigned u) { return __uint_as_float(u & 0xffff0000u); }
__device__ __forceinline__ int cond_of_row(int row) { return row < 4096 ? 0 : 1 + ((row - 4096) >> 10); }

__device__ __forceinline__ int opaque_tid() { int t = threadIdx.x; asm volatile("" : "+v"(t)); return t; }
#define MFMA_SETTLE() asm volatile("s_nop 15\n\ts_nop 15" ::: "memory")
__device__ __forceinline__ void bu_mfma4(f32x16& c0, f32x16& c1, f32x16& c2, f32x16& c3, bf16x8 a, bf16x8 b0, bf16x8 b1, bf16x8 b2, bf16x8 b3) {
  asm volatile("v_mfma_f32_32x32x16_bf16 %0, %4, %5, 0\n\t"
               "v_mfma_f32_32x32x16_bf16 %1, %4, %6, 0\n\t"
               "v_mfma_f32_32x32x16_bf16 %2, %4, %7, 0\n\t"
               "v_mfma_f32_32x32x16_bf16 %3, %4, %8, 0\n\t"
               "s_nop 15\n\ts_nop 15"
               : "=&v"(c0), "=&v"(c1), "=&v"(c2), "=&v"(c3) : "v"(a), "v"(b0), "v"(b1), "v"(b2), "v"(b3));
}
struct cplx { float re, im; };
__device__ __forceinline__ cplx cmul(cplx a, cplx b) { return {a.re * b.re - a.im * b.im, a.re * b.im + a.im * b.re}; }
__device__ __forceinline__ cplx cfma(cplx a, cplx h, cplx b) {
  cplx r; r.re = fmaf(a.re, h.re, fmaf(-a.im, h.im, b.re)); r.im = fmaf(a.re, h.im, fmaf(a.im, h.re, b.im)); return r;
}

constexpr int BM = 256, BK = 64, NXCD = 8, WGM = 8;

__device__ __forceinline__ int lds_byte(int r, int c) {
  int st = (r >> 4) * 2 + (c >> 5), ob = (r & 15) * 64 + (c & 31) * 2;
  return st * 1024 + (ob ^ (((ob >> 9) & 1) << 5));
}
__device__ __forceinline__ void stage_rc(int b, int& R, int& C) {
  int st = b >> 10, sb = b & 1023, swz = sb ^ (((sb >> 9) & 1) << 5);
  R = (st / 2) * 16 + swz / 64; C = (st % 2) * 32 + (swz % 64) / 2;
}

struct GemmArgs { const bf16_t* A; int lda; const bf16_t* Bt; int ldb; int nM, nN, K; int kmask; };

template <int BN, class Epi>
__device__ __forceinline__ void gemm_phase(const GemmArgs ga, const Epi epi) {
  constexpr int TILE_A = BM * BK * 2, TILE_B = BN * BK * 2, STAGE_B = TILE_A + TILE_B, GLA = TILE_A / 8192, GLB = TILE_B / 8192, NF = BN / 64;
  unsigned char* shm = smem;
  const int tid = opaque_tid(), wid = tid >> 6, lane = tid & 63, wr = wid >> 2, wc = wid & 3, fr = lane & 15, fq = lane >> 4;
  unsigned voA[GLA], voB[GLB];
#pragma unroll
  for (int i = 0; i < GLA; ++i) { int r_, c_; stage_rc(wid * 1024 + i * 8192 + lane * 16, r_, c_); voA[i] = (unsigned)(r_ * ga.lda + c_) * 2u; }
#pragma unroll
  for (int i = 0; i < GLB; ++i) { int r_, c_; stage_rc(wid * 1024 + i * 8192 + lane * 16, r_, c_); voB[i] = (unsigned)(r_ * ga.ldb + c_) * 2u; }
  int offA[8], offB[NF];
#pragma unroll
  for (int m = 0; m < 8; ++m) offA[m] = lds_byte(wr * 128 + m * 16 + fr, fq * 8);
#pragma unroll
  for (int n = 0; n < NF; ++n) offB[n] = TILE_A + lds_byte(wc * (BN / 4) + n * 16 + fr, fq * 8);
  const int nwg = ga.nM * ga.nN, nt = ga.K / BK;
  for (int u = blockIdx.x; u < nwg; u += gridDim.x) {
    int wgid = u;
    { int q = nwg / NXCD, r = nwg % NXCD, xcd = wgid % NXCD, off = wgid / NXCD;
      wgid = (xcd < r ? xcd * (q + 1) : r * (q + 1) + (xcd - r) * q) + off; }
    constexpr int WG_ = (BN == 128) ? 4 : WGM;
    const int nig = WG_ * ga.nN, gid = wgid / nig, fm = gid * WG_, gsz = min(ga.nM - fm, WG_);
    const int pm = fm + ((wgid % nig) % gsz), pn = (wgid % nig) / gsz, brow = pm * BM, bcol = pn * BN;
    const bf16_t* Ab = ga.A + (long)brow * ga.lda;
    const bf16_t* Bb = ga.Bt + (long)bcol * ga.ldb;
#define GLDS_STAGE(buf, kt) do { \
    _Pragma("unroll") for (int i = 0; i < GLA; ++i) \
      __builtin_amdgcn_global_load_lds((const unsigned*)((const char*)(Ab + ((kt) & ga.kmask) * BK) + voA[i]), \
        (__attribute__((address_space(3))) unsigned*)(shm + (buf) * STAGE_B + wid * 1024 + i * 8192), 16, 0, 0); \
    _Pragma("unroll") for (int i = 0; i < GLB; ++i) \
      __builtin_amdgcn_global_load_lds((const unsigned*)((const char*)(Bb + ((kt) & ga.kmask) * BK) + voB[i]), \
        (__attribute__((address_space(3))) unsigned*)(shm + (buf) * STAGE_B + TILE_A + wid * 1024 + i * 8192), 16, 0, B_AUX); } while (0)
    f32x4 acc[8][NF];
#pragma unroll
    for (int m = 0; m < 8; ++m)
#pragma unroll
      for (int n = 0; n < NF; ++n) acc[m][n] = (f32x4){0.f, 0.f, 0.f, 0.f};
#define LOADF(A_, B_, ks_) do { \
      _Pragma("unroll") for (int m = 0; m < 8; ++m) A_[m] = *(const bf16x8*)(sb + offA[m] + (ks_) * 1024); \
      _Pragma("unroll") for (int n = 0; n < NF; ++n) B_[n] = *(const bf16x8*)(sb + offB[n] + (ks_) * 1024); } while (0)
#define MMAS(A_, B_) do { \
      _Pragma("unroll") for (int m = 0; m < 8; ++m) \
        _Pragma("unroll") for (int n = 0; n < NF; ++n) acc[m][n] = __builtin_amdgcn_mfma_f32_16x16x32_bf16(B_[n], A_[m], acc[m][n], 0, 0, 0); } while (0)
#define COMPUTE(cur_) do { const unsigned char* sb = shm + (cur_) * STAGE_B; \
      if constexpr (NF == 2) { \
        bf16x8 A0[8], B0[NF], A1[8], B1[NF]; \
        LOADF(A0, B0, 0); LOADF(A1, B1, 1); \
        __builtin_amdgcn_sched_barrier(0); \
        MMAS(A0, B0); MMAS(A1, B1); \
        __builtin_amdgcn_sched_barrier(0); \
      } else { \
        bf16x8 A0[8], B0[NF]; \
        LOADF(A0, B0, 0); __builtin_amdgcn_sched_barrier(0); MMAS(A0, B0); __builtin_amdgcn_sched_barrier(0); \
        LOADF(A0, B0, 1); __builtin_amdgcn_sched_barrier(0); MMAS(A0, B0); __builtin_amdgcn_sched_barrier(0); \
      } } while (0)
#if USE_GLDS
    GLDS_STAGE(0, 0);
    asm volatile("s_waitcnt vmcnt(0)" ::: "memory"); __syncthreads();
    for (int t = 0; t < nt; ++t) {
      const int cur = t & 1;
      if (t + 1 < nt) GLDS_STAGE(cur ^ 1, t + 1);
      COMPUTE(cur);
      asm volatile("s_waitcnt vmcnt(0)" ::: "memory"); __syncthreads();
    }
#else
    uint4 sa0, sa1, sa2, sa3, sb0, sb1, sb2, sb3;
    static_assert(GLA == 4 && (GLB == 2 || GLB == 4), "staging shape");
#define GSRC_A(kt, i) (*(const uint4*)((const char*)(Ab + ((kt) & ga.kmask) * BK) + voA[i]))
#define GSRC_B(kt, i) (*(const uint4*)((const char*)(Bb + ((kt) & ga.kmask) * BK) + voB[i]))
#define LDST_A(buf, i) (*(uint4*)(shm + (buf) * STAGE_B + wid * 1024 + (i) * 8192 + lane * 16))
#define LDST_B(buf, i) (*(uint4*)(shm + (buf) * STAGE_B + TILE_A + wid * 1024 + (i) * 8192 + lane * 16))
#define REG_ISSUE(kt) do { sa0 = GSRC_A(kt, 0); sa1 = GSRC_A(kt, 1); sa2 = GSRC_A(kt, 2); sa3 = GSRC_A(kt, 3); \
      sb0 = GSRC_B(kt, 0); sb1 = GSRC_B(kt, 1); if constexpr (GLB == 4) { sb2 = GSRC_B(kt, 2); sb3 = GSRC_B(kt, 3); } } while (0)
#define REG_WRITE(buf) do { LDST_A(buf, 0) = sa0; LDST_A(buf, 1) = sa1; LDST_A(buf, 2) = sa2; LDST_A(buf, 3) = sa3; \
      LDST_B(buf, 0) = sb0; LDST_B(buf, 1) = sb1; if constexpr (GLB == 4) { LDST_B(buf, 2) = sb2; LDST_B(buf, 3) = sb3; } } while (0)
    REG_ISSUE(0); REG_WRITE(0); REG_ISSUE(1); __syncthreads();
    for (int t = 0; t < nt; ++t) {
      const int cur = t & 1;
      if (t + 1 < nt) REG_WRITE(cur ^ 1);
      if (t + 2 < nt) REG_ISSUE(t + 2);
      COMPUTE(cur);
      __syncthreads();
    }
#undef REG_ISSUE
#undef REG_WRITE
#endif
#undef COMPUTE
#undef LOADF
#undef MMAS
#undef GLDS_STAGE
    epi(acc, brow + wr * 128 + fr, bcol + wc * (BN / 4) + fq * 4);
  }
  __syncthreads();
}

struct EpiSqRelu {
  bf16_t* O;
  template <int NF> __device__ __forceinline__ void operator()(const f32x4 (&acc)[8][NF], int row0, int col0) const {
#pragma unroll
    for (int m = 0; m < 8; ++m)
#pragma unroll
      for (int n = 0; n < NF; ++n) {
        f32x4 v = acc[m][n];
        float a0 = fmaxf(v[0], 0.f), a1 = fmaxf(v[1], 0.f), a2 = fmaxf(v[2], 0.f), a3 = fmaxf(v[3], 0.f);
        uint2 pk; pk.x = cvt_pk_bf16(a0 * a0, a1 * a1); pk.y = cvt_pk_bf16(a2 * a2, a3 * a3);
        *(uint2*)(O + (size_t)(row0 + 16 * m) * DFF + col0 + 16 * n) = pk;
      }
  }
};
struct EpiResid {
  float* X; const float* gate;
  template <int NF> __device__ __forceinline__ void operator()(const f32x4 (&acc)[8][NF], int row0, int col0) const {
    const float* gp = gate + cond_of_row(row0) * 6144;
#pragma unroll
    for (int n = 0; n < NF; ++n) {
      const f32x4 gv = *(const f32x4*)(gp + col0 + 16 * n);
#pragma unroll
      for (int m = 0; m < 8; ++m) {
        float* xp = X + (size_t)(row0 + 16 * m) * D + col0 + 16 * n;
        f32x4 o = *(f32x4*)xp; o += acc[m][n] * gv; *(f32x4*)xp = o;
      }
    }
  }
};
struct EpiGlu {
  float* X; const float* gate; const float* bias;
  template <int NF> __device__ __forceinline__ void operator()(const f32x4 (&acc)[8][NF], int row0, int col0) const {
    const float* gp = gate + cond_of_row(row0) * 6144;
    const int col = (col0 >> 7) * 64 + ((col0 >> 5) & 3) * 16 + (col0 & 15);
    const f32x4 gv = *(const f32x4*)(gp + col);
    const f32x4 ba = *(const f32x4*)(bias + col), bg = *(const f32x4*)(bias + 1024 + col);
#pragma unroll
    for (int m = 0; m < 8; ++m) {
      float* xp = X + (size_t)(row0 + 16 * m) * D + col;
      f32x4 a = acc[m][0] + ba, g = acc[m][1] + bg;
      f32x4 o = *(f32x4*)xp;
#pragma unroll
      for (int i = 0; i < 4; ++i) { float s = 1.f / (1.f + __expf(-g[i])); o[i] += gv[i] * a[i] * s; }
      *(f32x4*)xp = o;
    }
  }
};
struct EpiQkv {
  bf16_t* QK; int nqk; bf16_t* VT; int C; float* newv;
  template <int NF> __device__ __forceinline__ void operator()(const f32x4 (&acc)[8][NF], int row0, int col0) const {
    if (col0 < nqk) {
#pragma unroll
      for (int m = 0; m < 8; ++m)
#pragma unroll
        for (int n = 0; n < NF; ++n) {
          f32x4 v = acc[m][n];
          uint2 pk; pk.x = cvt_pk_bf16(v[0], v[1]); pk.y = cvt_pk_bf16(v[2], v[3]);
          *(uint2*)(QK + (size_t)(row0 + 16 * m) * nqk + col0 + 16 * n) = pk;
        }
    } else {
      const int vc0 = col0 - nqk;
#pragma unroll
      for (int m = 0; m < 8; ++m) {
        const int row = row0 + 16 * m;
        size_t vbase; int ldv;
        if (row < 4096) { vbase = (size_t)(row >> 8) * C * 256 + (row & 255); ldv = 256; }
        else { const int r2 = row - 4096; vbase = (size_t)4096 * C + (size_t)(r2 >> 10) * C * 1024 + (r2 & 1023); ldv = 1024; }
#pragma unroll
        for (int n = 0; n < NF; ++n) {
          const int col = vc0 + 16 * n;
          f32x4 v = acc[m][n];
#pragma unroll
          for (int i = 0; i < 4; ++i) VT[vbase + (size_t)(col + i) * ldv] = f2bf(v[i]);
          if (row < 4096) *(f32x4*)(newv + (size_t)row * C + col) = v;
        }
      }
    }
  }
};

__device__ void conv_job(const Params& p, int job, const float*& src, bf16_t*& dst, int& K, int& N, int& perm) {
  unsigned char* ws = p.ws; perm = 0;
  if (job < 4) { src = p.in[12] + (size_t)job * 1024 * 4096; dst = (bf16_t*)(ws + WS_W1T) + (size_t)job * 4096 * 1024; K = 1024; N = 4096; }
  else if (job < 8) { int l = job - 4; src = p.in[13] + (size_t)l * 4096 * 1024; dst = (bf16_t*)(ws + WS_W2T) + (size_t)l * 1024 * 4096; K = 4096; N = 1024; }
  else if (job < 10) { int s = job - 8; src = p.in[22] + (size_t)s * 1024 * 2048; dst = (bf16_t*)(ws + WS_GLUT) + (size_t)s * 2048 * 1024; K = 1024; N = 2048; perm = 1; }
  else if (job == 10) { src = p.in[24]; dst = (bf16_t*)(ws + WS_NAQKVT); K = 1024; N = 3072; }
  else if (job == 11) { src = p.in[28]; dst = (bf16_t*)(ws + WS_NAOT); K = 1024; N = 1024; }
  else if (job == 12) { src = p.in[29]; dst = (bf16_t*)(ws + WS_GQAQKVT); K = 1024; N = 1536; }
  else if (job == 13) { src = p.in[32]; dst = (bf16_t*)(ws + WS_GQAOT); K = 1024; N = 1024; }
  else if (job < 18) { int b = job - 14; src = p.in[4] + (size_t)b * 512 * 1024; dst = (bf16_t*)(ws + WS_CVTNA) + (size_t)b * 1024 * 512; K = 512; N = 1024; }
  else { int b = job - 18; src = p.in[6] + (size_t)b * 512 * 256; dst = (bf16_t*)(ws + WS_CVTGQA) + (size_t)b * 256 * 512; K = 512; N = 256; }
}

__device__ void do_transposes(const Params& p, int job_lo, int job_hi);
__device__ void phase_prologue(const Params& p) {
  const int tid = opaque_tid(), G = gridDim.x;
  unsigned char* ws = p.ws;
  float* MOD = (float*)(ws + WS_MOD);
  {
    float* sl = (float*)smem;
    float* red = (float*)smem + 5 * 1024;
    bool have = false;
    for (int it = blockIdx.x; it < 192; it += G) {
      if (!have) {
        for (int i = tid; i < 5 * 1024; i += NT) {
          int c = i >> 10, k = i & 1023;
          float v = (c == 0) ? p.in[8][k] : p.in[7][(c - 1) * 1024 + k];
          sl[i] = v / (1.f + __expf(-v));
        }
        have = true;
      }
      __syncthreads();
      const int layer = it / 48, col0 = (it % 48) * 128;
      const int cg4 = tid & 31, ksl = tid >> 5;
      const float* wp = p.in[10] + (size_t)layer * 1024 * 6144 + col0 + cg4 * 4;
      f32x4 a[5];
      for (int c = 0; c < 5; ++c) a[c] = (f32x4){0.f, 0.f, 0.f, 0.f};
#pragma unroll 8
      for (int kk = 0; kk < 64; ++kk) {
        const int k = ksl * 64 + kk;
        const f32x4 w = __builtin_nontemporal_load((const f32x4*)(wp + (size_t)k * 6144));
        for (int c = 0; c < 5; ++c) a[c] += w * sl[c * 1024 + k];
      }
      for (int c = 0; c < 5; ++c) *(f32x4*)(red + (ksl * 5 + c) * 128 + cg4 * 4) = a[c];
      __syncthreads();
      for (int o = tid; o < 640; o += NT) {
        const int c = o >> 7, col = o & 127;
        float s = p.in[11][layer * 6144 + col0 + col];
        for (int k2 = 0; k2 < 16; ++k2) s += red[(k2 * 5 + c) * 128 + col];
        MOD[(layer * 5 + c) * 6144 + col0 + col] = s;
      }
      __syncthreads();
    }
    __syncthreads();
  }
  {
    float* S5A = (float*)(ws + WS_S5A);
    bf16_t* BB = (bf16_t*)(ws + WS_S5BB);
    bf16_t* CM = (bf16_t*)(ws + WS_S5CM);
    for (int it = (blockIdx.x + 64) % G; it < 256; it += G) {
      const int sdg = it;
      const int g = it & 63;
      const float dt = expf(p.in[16][sdg]);
      for (int idx = tid; idx < 1024; idx += NT) {
        const int pp = idx >> 4, ch = idx & 15;
        const float lr = p.in[14][sdg * 64 + pp], li = p.in[15][sdg * 64 + pp];
        const float ar = lr * dt, ai = li * dt;
        const float mag = expf(ar), cs = cosf(ai), sn = sinf(ai), sh = sinf(0.5f * ai);
        const float abr = mag * cs, abi = mag * sn;
        const float nr = expm1f(ar) * cs - 2.f * sh * sh, ni = abi;
        const float den = lr * lr + li * li;
        const float fre = (nr * lr + ni * li) / den, fim = (ni * lr - nr * li) / den;
        const float br = p.in[17][(sdg * 64 + pp) * 16 + ch], bi = p.in[18][(sdg * 64 + pp) * 16 + ch];
        const float bbr = fre * br - fim * bi, bbi = fre * bi + fim * br;
        BB[((size_t)sdg * 128 + pp) * 16 + ch] = f2bf(bbr);
        BB[((size_t)sdg * 128 + 64 + pp) * 16 + ch] = f2bf(bbi);
        const float cr = p.in[19][(sdg * 16 + ch) * 64 + pp], ci = p.in[20][(sdg * 16 + ch) * 64 + pp];
        const int q = pp & 31, s2 = (pp >> 5) * 2;
        CM[((size_t)sdg * 16 + ch) * 128 + 4 * q + s2] = f2bf(cr);
        CM[((size_t)sdg * 16 + ch) * 128 + 4 * q + s2 + 1] = f2bf(-ci);
        if (ch == 0) { S5A[(sdg * 64 + pp) * 2] = abr; S5A[(sdg * 64 + pp) * 2 + 1] = abi; }
      }
      (void)g;
    }
  }
  {
    const size_t n1 = 4 * 512 * 1024 / 4, n2 = 4 * 512 * 256 / 4;
    uint2* d1 = (uint2*)(ws + WS_CKNA); uint2* d2 = (uint2*)(ws + WS_CKGQA);
    const f32x4* s1 = (const f32x4*)p.in[3]; const f32x4* s2 = (const f32x4*)p.in[5];
    for (size_t i = (size_t)blockIdx.x * NT + tid; i < n1 + n2; i += (size_t)G * NT) {
      f32x4 v = (i < n1) ? s1[i] : s2[i - n1];
      uint2 pk; pk.x = cvt_pk_bf16(v[0], v[1]); pk.y = cvt_pk_bf16(v[2], v[3]);
      if (i < n1) d1[i] = pk; else d2[i - n1] = pk;
    }
  }
  do_transposes(p, 0, 22);
}

__device__ void do_transposes(const Params& p, int job_lo, int job_hi) {
  const int tid = opaque_tid(), G = gridDim.x;
  {
    bf16_t* T = (bf16_t*)smem;
    int base = 0;
    for (int job = job_lo; job < job_hi; ++job) {
      const float* src; bf16_t* dst; int K, N, perm;
      conv_job(p, job, src, dst, K, N, perm);
      const int tn = N >> 8, ntile = (K >> 6) * tn;
      const int start = (int)(((long)blockIdx.x - (base % G) + G) % G);
      const int n4 = tid & 63, kr0 = tid >> 6;
      f32x4 v[8];
      if (start < ntile) {
        const int k0 = (start / tn) << 6, n0 = (start % tn) << 8;
#pragma unroll
        for (int ps = 0; ps < 8; ++ps) v[ps] = __builtin_nontemporal_load((const f32x4*)(src + (size_t)(k0 + 8 * kr0 + ps) * N + n0 + n4 * 4));
      }
      for (int tile = start; tile < ntile; tile += G) {
        const int k0 = (tile / tn) << 6, n0 = (tile % tn) << 8;
        __syncthreads();
#pragma unroll
        for (int i = 0; i < 4; ++i) {
          uint4 w;
          w.x = cvt_pk_bf16(v[0][i], v[1][i]); w.y = cvt_pk_bf16(v[2][i], v[3][i]);
          w.z = cvt_pk_bf16(v[4][i], v[5][i]); w.w = cvt_pk_bf16(v[6][i], v[7][i]);
          *(uint4*)(T + (n4 * 4 + i) * 72 + 8 * kr0) = w;
        }
        if (tile + G < ntile) {
          const int k1 = ((tile + G) / tn) << 6, n1 = ((tile + G) % tn) << 8;
#pragma unroll
          for (int ps = 0; ps < 8; ++ps) v[ps] = __builtin_nontemporal_load((const f32x4*)(src + (size_t)(k1 + 8 * kr0 + ps) * N + n1 + n4 * 4));
        }
        __syncthreads();
#pragma unroll
        for (int q = 0; q < 4; ++q) {
          const int n = (tid >> 3) + 64 * q, kc = tid & 7;
          const uint4 o = *(const uint4*)(T + n * 72 + kc * 8);
          int dr = n0 + n;
          if (perm) { const int isg = dr >= 1024, c1 = dr & 1023; dr = (c1 >> 6) * 128 + ((c1 >> 4) & 3) * 32 + (c1 & 15) + isg * 16; }
          *(uint4*)(dst + (size_t)dr * K + k0 + kc * 8) = o;
        }
      }
      base += ntile;
    }
    __syncthreads();
  }
}

__device__ void phase_norm(const Params& p, int layer, int which, bool first) {
  const int tid_ = opaque_tid(); const int lane = tid_ & 63, wave = tid_ >> 6;
  const float* MOD = (const float*)(p.ws + WS_MOD);
  bf16_t* HB = (bf16_t*)(p.ws + WS_HB);
  const float* gw = p.in[9] + (layer * 2 + which) * 1024;
  for (int row0 = (blockIdx.x * 8 + wave) * 4; row0 < NTOK; row0 += gridDim.x * 32) {
    f32x4 v[4][4]; float ss[4];
#pragma unroll
    for (int r = 0; r < 4; ++r) {
      const int row = row0 + r;
      const float* xr = first ? (row < 4096 ? p.in[0] + (size_t)row * D : p.in[1] + (size_t)(row - 4096) * D) : p.out + (size_t)row * D;
#pragma unroll
      for (int i = 0; i < 4; ++i) v[r][i] = *(const f32x4*)(xr + i * 256 + lane * 4);
    }
#pragma unroll
    for (int r = 0; r < 4; ++r) {
      float s = 0.f;
#pragma unroll
      for (int i = 0; i < 4; ++i) s += v[r][i][0] * v[r][i][0] + v[r][i][1] * v[r][i][1] + v[r][i][2] * v[r][i][2] + v[r][i][3] * v[r][i][3];
      ss[r] = s;
    }
#pragma unroll
    for (int o = 32; o > 0; o >>= 1) {
#pragma unroll
      for (int r = 0; r < 4; ++r) ss[r] += __shfl_xor(ss[r], o);
    }
    const float* mp = MOD + (layer * 5 + cond_of_row(row0)) * 6144 + which * 3072;
#pragma unroll
    for (int i = 0; i < 4; ++i) {
      const int col = i * 256 + lane * 4;
      const f32x4 gv = *(const f32x4*)(gw + col), sh = *(const f32x4*)(mp + col), sc = *(const f32x4*)(mp + 1024 + col);
#pragma unroll
      for (int r = 0; r < 4; ++r) {
        const int row = row0 + r;
        const float rstd = rsqrtf(ss[r] * (1.f / 1024.f) + 1e-6f);
        if (first) *(f32x4*)(p.out + (size_t)row * D + col) = v[r][i];
        float o[4];
#pragma unroll
        for (int j = 0; j < 4; ++j) o[j] = v[r][i][j] * rstd * gv[j] * (1.f + sc[j]) + sh[j];
        uint2 pk; pk.x = cvt_pk_bf16(o[0], o[1]); pk.y = cvt_pk_bf16(o[2], o[3]);
        *(uint2*)(HB + (size_t)row * D + col) = pk;
      }
    }
  }
}

__device__ __forceinline__ int s5_tok(int rho) { return 16 * ((rho >> 2) & 1) + (rho & 3) + 4 * (rho >> 3); }
__device__ __forceinline__ cplx shfl_c(cplx v, int src) { cplx r; r.re = __shfl(v.re, src); r.im = __shfl(v.im, src); return r; }

__device__ void phase_s5_pass1(const Params& p, int slot) {
  const int tid_ = opaque_tid(); const int lane = tid_ & 63, wave = tid_ >> 6, r = lane & 31, H = lane >> 5;
  const bf16_t* HB = (const bf16_t*)(p.ws + WS_HB);
  const float* S5A = (const float*)(p.ws + WS_S5A);
  const bf16_t* BB = (const bf16_t*)(p.ws + WS_S5BB);
  float* E = (float*)(p.ws + WS_S5E);
  const int tokr = s5_tok(r);
  for (int it = blockIdx.x * 8 + wave; it < 128 * 64; it += gridDim.x * 8) {
    const int ck = it >> 6, g = it & 63, tok0 = ck * 64;
    bf16x8 uf[2];
    _Pragma("unroll") for (int tt = 0; tt < 2; ++tt) uf[tt] = *(const bf16x8*)(HB + (size_t)(tok0 + 32 * tt + tokr) * D + g * 16 + 8 * H);
    _Pragma("unroll") for (int dir = 0; dir < 2; ++dir) {
      const int sdg = (slot * 2 + dir) * 64 + g;
      cplx a0 = {S5A[(sdg * 64 + r) * 2], S5A[(sdg * 64 + r) * 2 + 1]};
      cplx a1 = {S5A[(sdg * 64 + r + 32) * 2], S5A[(sdg * 64 + r + 32) * 2 + 1]};
      cplx a0_16 = a0, a1_16 = a1;
      _Pragma("unroll") for (int i = 0; i < 4; ++i) { a0_16 = cmul(a0_16, a0_16); a1_16 = cmul(a1_16, a1_16); }
      const cplx a0_32 = cmul(a0_16, a0_16), a1_32 = cmul(a1_16, a1_16);
      bf16x8 bfr[4];
      _Pragma("unroll") for (int ct = 0; ct < 4; ++ct) bfr[ct] = *(const bf16x8*)(BB + ((size_t)sdg * 128 + 32 * ct + r) * 16 + 8 * H);
      cplx E0 = {0.f, 0.f}, E1 = {0.f, 0.f};
      _Pragma("unroll") for (int t2 = 0; t2 < 2; ++t2) {
        const int tt = dir ? 1 - t2 : t2;
        f32x16 acc[4];
        bu_mfma4(acc[0], acc[1], acc[2], acc[3], uf[tt], bfr[0], bfr[1], bfr[2], bfr[3]);
        cplx e0 = {0.f, 0.f}, e1 = {0.f, 0.f};
        if (dir == 0) {
          _Pragma("unroll") for (int i = 0; i < 16; ++i) { e0 = cfma(a0, e0, (cplx){acc[0][i], acc[2][i]}); e1 = cfma(a1, e1, (cplx){acc[1][i], acc[3][i]}); }
        } else {
          _Pragma("unroll") for (int i = 15; i >= 0; --i) { e0 = cfma(a0, e0, (cplx){acc[0][i], acc[2][i]}); e1 = cfma(a1, e1, (cplx){acc[1][i], acc[3][i]}); }
        }
        const cplx o0 = shfl_c(e0, lane ^ 32), o1 = shfl_c(e1, lane ^ 32);
        const cplx eL0 = H ? o0 : e0, eU0 = H ? e0 : o0, eL1 = H ? o1 : e1, eU1 = H ? e1 : o1;
        cplx t0, t1;
        if (dir == 0) { t0 = cfma(a0_16, eL0, eU0); t1 = cfma(a1_16, eL1, eU1); }
        else { t0 = cfma(a0_16, eU0, eL0); t1 = cfma(a1_16, eU1, eL1); }
        E0 = cfma(a0_32, E0, t0); E1 = cfma(a1_32, E1, t1);
      }
      const int pp = H ? r + 32 : r;
      const cplx Ev = H ? E1 : E0;
      *(float2*)(E + ((size_t)((ck * 64 + g) * 2 + dir) * 64 + pp) * 2) = make_float2(Ev.re, Ev.im);
    }
  }
}

__device__ void phase_s5_pass2(const Params& p, int slot) {
  const int tid_ = opaque_tid(); const int lane = tid_ & 63, wave = tid_ >> 6, r = lane & 31, H = lane >> 5;
  bf16_t* HB = (bf16_t*)(p.ws + WS_HB);
  const float* S5A = (const float*)(p.ws + WS_S5A);
  const bf16_t* BB = (const bf16_t*)(p.ws + WS_S5BB);
  const bf16_t* CM = (const bf16_t*)(p.ws + WS_S5CM);
  const float* E = (const float*)(p.ws + WS_S5E);
  const float* Dsk = p.in[21] + slot * 1024;
  unsigned char* ldsw = smem + wave * 8704;
  const int tokr = s5_tok(r);
  for (int it = blockIdx.x * 8 + wave; it < 128 * 64; it += gridDim.x * 8) {
    const int ck = it >> 6, g = it & 63, tok0 = ck * 64;
    int c, nc, bq; bool sample;
    if (tok0 < 4096) { bq = tok0 >> 8; c = (tok0 >> 6) & 3; nc = 4; sample = false; }
    else { const int t2 = tok0 - 4096; bq = t2 >> 10; c = (t2 >> 6) & 15; nc = 16; sample = true; }
    const int ck0 = ck - c;
    bf16x8 uf[2];
    _Pragma("unroll") for (int tt = 0; tt < 2; ++tt) uf[tt] = *(const bf16x8*)(HB + (size_t)(tok0 + 32 * tt + tokr) * D + g * 16 + 8 * H);
    f32x4 yacc[2][2];
    _Pragma("unroll") for (int a = 0; a < 2; ++a) _Pragma("unroll") for (int b = 0; b < 2; ++b) yacc[a][b] = (f32x4){0.f, 0.f, 0.f, 0.f};
    _Pragma("unroll") for (int dir = 0; dir < 2; ++dir) {
      const int sdg = (slot * 2 + dir) * 64 + g;
      const cplx a0 = {S5A[(sdg * 64 + r) * 2], S5A[(sdg * 64 + r) * 2 + 1]};
      const cplx a1 = {S5A[(sdg * 64 + r + 32) * 2], S5A[(sdg * 64 + r + 32) * 2 + 1]};
      cplx a0_64 = a0, a1_64 = a1;
      _Pragma("unroll") for (int i = 0; i < 6; ++i) { a0_64 = cmul(a0_64, a0_64); a1_64 = cmul(a1_64, a1_64); }
      cplx c0 = {0.f, 0.f}, c1 = {0.f, 0.f};
      if (sample) {
        const float* h0 = p.in[2] + ((size_t)((bq * 2 + slot) * 2 + dir) * 2) * 4096 + g * 64;
        c0.re = h0[r]; c0.im = h0[4096 + r]; c1.re = h0[r + 32]; c1.im = h0[4096 + r + 32];
      }
      {
        const int ncar = dir ? nc - 1 - c : c;
        for (int j0 = 0; j0 < ncar; j0 += 8) {
          float2 va[8], vb[8];
#pragma unroll
          for (int j = 0; j < 8; ++j) {
            const int jj = min(j0 + j, ncar - 1);
            const int cc = dir ? nc - 1 - jj : jj;
            const float* ep = E + ((size_t)(((ck0 + cc) * 64 + g) * 2 + dir) * 64) * 2;
            va[j] = *(const float2*)(ep + r * 2); vb[j] = *(const float2*)(ep + (r + 32) * 2);
          }
#pragma unroll
          for (int j = 0; j < 8; ++j) if (j0 + j < ncar) {
            c0 = cfma(a0_64, c0, (cplx){va[j].x, va[j].y}); c1 = cfma(a1_64, c1, (cplx){vb[j].x, vb[j].y});
          }
        }
      }
      bf16x8 bfr[4], cfr[4];
      _Pragma("unroll") for (int ct = 0; ct < 4; ++ct) bfr[ct] = *(const bf16x8*)(BB + ((size_t)sdg * 128 + 32 * ct + r) * 16 + 8 * H);
      _Pragma("unroll") for (int ks = 0; ks < 4; ++ks) cfr[ks] = *(const bf16x8*)(CM + ((size_t)sdg * 16 + (lane & 15)) * 128 + 32 * ks + 8 * (lane >> 4));
      _Pragma("unroll") for (int t2 = 0; t2 < 2; ++t2) {
        const int tt = dir ? 1 - t2 : t2;
        f32x16 acc[4];
        bu_mfma4(acc[0], acc[1], acc[2], acc[3], uf[tt], bfr[0], bfr[1], bfr[2], bfr[3]);
        const int firstH = dir;
        cplx h0 = c0, h1 = c1;
        if (H == firstH) {
          if (dir == 0) { _Pragma("unroll") for (int i = 0; i < 16; ++i) { h0 = cfma(a0, h0, (cplx){acc[0][i], acc[2][i]}); h1 = cfma(a1, h1, (cplx){acc[1][i], acc[3][i]});
                            acc[0][i] = h0.re; acc[2][i] = h0.im; acc[1][i] = h1.re; acc[3][i] = h1.im; } }
          else { _Pragma("unroll") for (int i = 15; i >= 0; --i) { h0 = cfma(a0, h0, (cplx){acc[0][i], acc[2][i]}); h1 = cfma(a1, h1, (cplx){acc[1][i], acc[3][i]});
                            acc[0][i] = h0.re; acc[2][i] = h0.im; acc[1][i] = h1.re; acc[3][i] = h1.im; } }
        }
        h0 = shfl_c(h0, r + 32 * firstH); h1 = shfl_c(h1, r + 32 * firstH);
        if (H != firstH) {
          if (dir == 0) { _Pragma("unroll") for (int i = 0; i < 16; ++i) { h0 = cfma(a0, h0, (cplx){acc[0][i], acc[2][i]}); h1 = cfma(a1, h1, (cplx){acc[1][i], acc[3][i]});
                            acc[0][i] = h0.re; acc[2][i] = h0.im; acc[1][i] = h1.re; acc[3][i] = h1.im; } }
          else { _Pragma("unroll") for (int i = 15; i >= 0; --i) { h0 = cfma(a0, h0, (cplx){acc[0][i], acc[2][i]}); h1 = cfma(a1, h1, (cplx){acc[1][i], acc[3][i]});
                            acc[0][i] = h0.re; acc[2][i] = h0.im; acc[1][i] = h1.re; acc[3][i] = h1.im; } }
        }
        if (!sample && t2 == 1 && ((dir == 0 && c == nc - 1) || (dir == 1 && c == 0)) && H != firstH) {
          float* so = p.out + OUT_S5 + ((size_t)((bq * 2 + slot) * 2 + dir) * 2) * 4096 + g * 64;
          so[r] = h0.re; so[4096 + r] = h0.im; so[r + 32] = h1.re; so[4096 + r + 32] = h1.im;
        }
        c0 = shfl_c(h0, r + 32 * (1 - firstH)); c1 = shfl_c(h1, r + 32 * (1 - firstH));
        _Pragma("unroll") for (int i = 0; i < 16; ++i) {
          uint2 pk; pk.x = cvt_pk_bf16(acc[0][i], acc[2][i]); pk.y = cvt_pk_bf16(acc[1][i], acc[3][i]);
          *(uint2*)(ldsw + (16 * H + i) * 272 + 8 * r) = pk;
        }
        asm volatile("s_waitcnt lgkmcnt(0)" ::: "memory");
        _Pragma("unroll") for (int rt = 0; rt < 2; ++rt) _Pragma("unroll") for (int ks = 0; ks < 4; ++ks) {
          const bf16x8 af = *(const bf16x8*)(ldsw + (16 * rt + (lane & 15)) * 272 + (32 * ks + 8 * (lane >> 4)) * 2);
          yacc[tt][rt] = __builtin_amdgcn_mfma_f32_16x16x32_bf16(af, cfr[ks], yacc[tt][rt], 0, 0, 0);
        }
        asm volatile("s_waitcnt lgkmcnt(0)" ::: "memory");
      }
    }
    asm volatile("s_nop 15" : "+v"(yacc[0][0]), "+v"(yacc[0][1]), "+v"(yacc[1][0]), "+v"(yacc[1][1]));
    const int ch = lane & 15, col = g * 16 + ch;
    const float dsk = Dsk[col];
    _Pragma("unroll") for (int tt = 0; tt < 2; ++tt) _Pragma("unroll") for (int rt = 0; rt < 2; ++rt) _Pragma("unroll") for (int j = 0; j < 4; ++j) {
      const int token = tok0 + 32 * tt + 16 * rt + 4 * (lane >> 4) + j;
      bf16_t* hp = HB + (size_t)token * D + col;
      const float u = bf2f(*hp);
      const float y = yacc[tt][rt][j] + u * dsk;
      const float z = 0.7978845608028654f * (y + 0.044715f * y * y * y);
      const float th = 1.f - 2.f / (__expf(2.f * z) + 1.f);
      *hp = f2bf(0.5f * y * (1.f + th));
    }
  }
}

constexpr float LOG2E = 1.4426950408889634f;

__device__ void phase_post_na(const Params& p) {
  const int tid_ = opaque_tid(); const int lane = tid_ & 63, wave = tid_ >> 6;
  bf16_t* QK = (bf16_t*)(p.ws + WS_QK);
  const float* qn = p.in[25]; const float* kn = p.in[26];
  const float qs = 0.125f * LOG2E;
  const int d0 = (lane & 3) * 16;
  for (int row = blockIdx.x * 8 + wave; row < NTOK; row += gridDim.x * 8) {
    _Pragma("unroll") for (int part = 0; part < 2; ++part) {
      bf16_t* ptr = QK + (size_t)row * 2048 + part * 1024 + lane * 16;
      uint4 a = *(uint4*)ptr, b = *(uint4*)(ptr + 8);
      unsigned w[8] = {a.x, a.y, a.z, a.w, b.x, b.y, b.z, b.w};
      float v[16]; float ss = 0.f;
      _Pragma("unroll") for (int i = 0; i < 8; ++i) { v[2 * i] = bflo(w[i]); v[2 * i + 1] = bfhi(w[i]); }
      _Pragma("unroll") for (int i = 0; i < 16; ++i) ss += v[i] * v[i];
      ss += __shfl_xor(ss, 1); ss += __shfl_xor(ss, 2);
      const float rstd = rsqrtf(ss * (1.f / 64.f) + 1e-6f);
      const float* nw = part ? kn : qn;
      const float sc = part ? 1.f : qs;
      float o[16];
      _Pragma("unroll") for (int i = 0; i < 16; ++i) o[i] = v[i] * rstd * nw[d0 + i];
      if (part == 1 && row < 4096) {
        float* op = p.out + OUT_NAK + (size_t)row * 1024 + lane * 16;
        _Pragma("unroll") for (int i = 0; i < 4; ++i) *(f32x4*)(op + 4 * i) = (f32x4){o[4 * i], o[4 * i + 1], o[4 * i + 2], o[4 * i + 3]};
      }
      _Pragma("unroll") for (int i = 0; i < 8; ++i) w[i] = cvt_pk_bf16(o[2 * i] * sc, o[2 * i + 1] * sc);
      *(uint4*)ptr = make_uint4(w[0], w[1], w[2], w[3]); *(uint4*)(ptr + 8) = make_uint4(w[4], w[5], w[6], w[7]);
    }
  }
}

__device__ void phase_post_gqa(const Params& p) {
  const int tid_ = opaque_tid(); const int lane = tid_ & 63, wave = tid_ >> 6;
  bf16_t* QK = (bf16_t*)(p.ws + WS_QK);
  const float* qn = p.in[30]; const float* kn = p.in[31];
  const float qs = 0.08838834764831845f * LOG2E;
  for (int row = blockIdx.x * 8 + wave; row < NTOK; row += gridDim.x * 8) {
    const bool sample = row >= 4096;
    const int t = (row - 4096) & 1023;
    const float prow = (float)(t >> 6), pcol = (float)(t & 63);
    {
      const int i0 = (lane & 7) * 8;
      bf16_t* ptr = QK + (size_t)row * 1280 + (lane >> 3) * 128 + i0;
      uint4 a = *(uint4*)ptr, b = *(uint4*)(ptr + 64);
      unsigned wa[4] = {a.x, a.y, a.z, a.w}, wb[4] = {b.x, b.y, b.z, b.w};
      float x1[8], x2[8]; float ss = 0.f;
      _Pragma("unroll") for (int i = 0; i < 4; ++i) { x1[2 * i] = bflo(wa[i]); x1[2 * i + 1] = bfhi(wa[i]); x2[2 * i] = bflo(wb[i]); x2[2 * i + 1] = bfhi(wb[i]); }
      _Pragma("unroll") for (int i = 0; i < 8; ++i) ss += x1[i] * x1[i] + x2[i] * x2[i];
      ss += __shfl_xor(ss, 1); ss += __shfl_xor(ss, 2); ss += __shfl_xor(ss, 4);
      const float rstd = rsqrtf(ss * (1.f / 128.f) + 1e-6f);
      _Pragma("unroll") for (int i = 0; i < 8; ++i) { x1[i] *= rstd * qn[i0 + i]; x2[i] *= rstd * qn[64 + i0 + i]; }
      if (sample) {
        _Pragma("unroll") for (int i = 0; i < 8; ++i) {
          const int pi = i0 + i;
          const float inv = exp2f(-(float)(pi & 31) * (13.287712379549449f / 32.f));
          const float ang = (pi < 32 ? prow : pcol) * inv;
          const float cs = cosf(ang), sn = sinf(ang);
          const float y1 = x1[i] * cs - x2[i] * sn, y2 = x1[i] * sn + x2[i] * cs;
          x1[i] = y1; x2[i] = y2;
        }
      }
      _Pragma("unroll") for (int i = 0; i < 4; ++i) { wa[i] = cvt_pk_bf16(x1[2 * i] * qs, x1[2 * i + 1] * qs); wb[i] = cvt_pk_bf16(x2[2 * i] * qs, x2[2 * i + 1] * qs); }
      *(uint4*)ptr = make_uint4(wa[0], wa[1], wa[2], wa[3]); *(uint4*)(ptr + 64) = make_uint4(wb[0], wb[1], wb[2], wb[3]);
    }
    {
      const int i0 = (lane & 31) * 2;
      bf16_t* ptr = QK + (size_t)row * 1280 + 1024 + (lane >> 5) * 128 + i0;
      unsigned wa = *(unsigned*)ptr, wb = *(unsigned*)(ptr + 64);
      float x1[2] = {bflo(wa), bfhi(wa)}, x2[2] = {bflo(wb), bfhi(wb)};
      float ss = x1[0] * x1[0] + x1[1] * x1[1] + x2[0] * x2[0] + x2[1] * x2[1];
      _Pragma("unroll") for (int o = 1; o < 32; o <<= 1) ss += __shfl_xor(ss, o);
      const float rstd = rsqrtf(ss * (1.f / 128.f) + 1e-6f);
      _Pragma("unroll") for (int i = 0; i < 2; ++i) { x1[i] *= rstd * kn[i0 + i]; x2[i] *= rstd * kn[64 + i0 + i]; }
      if (!sample) {
        float* op = p.out + OUT_GQAK + (size_t)row * 256 + (lane >> 5) * 128 + i0;
        *(float2*)op = make_float2(x1[0], x1[1]); *(float2*)(op + 64) = make_float2(x2[0], x2[1]);
      } else {
        _Pragma("unroll") for (int i = 0; i < 2; ++i) {
          const int pi = i0 + i;
          const float inv = exp2f(-(float)(pi & 31) * (13.287712379549449f / 32.f));
          const float ang = (pi < 32 ? prow : pcol) * inv;
          const float cs = cosf(ang), sn = sinf(ang);
          const float y1 = x1[i] * cs - x2[i] * sn, y2 = x1[i] * sn + x2[i] * cs;
          x1[i] = y1; x2[i] = y2;
        }
      }
      *(unsigned*)ptr = cvt_pk_bf16(x1[0], x1[1]); *(unsigned*)(ptr + 64) = cvt_pk_bf16(x2[0], x2[1]);
    }
  }
}

template <int DH, bool NAL>
__device__ __forceinline__ void attn_wave(const bf16_t* Q, int ldq,
                                          const bf16_t* K0, int ldk0, const bf16_t* V0, int ldv0, int n0,
                                          const bf16_t* K1, int ldk1, const bf16_t* V1, int ldv1, int n1,
                                          bf16_t* O, int ldo, const float* rpb_h, int rr, int rs, int qc0) {
  constexpr int KS = DH / 32, DT = DH / 16;
  const int lane = opaque_tid() & 63, fr = lane & 15, g = lane >> 4;
  bf16x8 qf[2][KS];
  _Pragma("unroll") for (int qg = 0; qg < 2; ++qg) _Pragma("unroll") for (int ks = 0; ks < KS; ++ks) qf[qg][ks] = *(const bf16x8*)(Q + (size_t)(qg * 16 + fr) * ldq + ks * 32 + 8 * g);
  f32x4 o[2][DT];
  _Pragma("unroll") for (int qg = 0; qg < 2; ++qg) _Pragma("unroll") for (int dt = 0; dt < DT; ++dt) o[qg][dt] = (f32x4){0.f, 0.f, 0.f, 0.f};
  float lsum[2] = {0.f, 0.f};
  const int krow_in = 8 * (fr >> 2) + (fr & 3);
  const int nch = (n0 + n1) >> 5;
  for (int c = 0; c < nch; ++c) {
    const bool s1 = (c * 32 >= n0);
    const int kc = s1 ? c * 32 - n0 : c * 32;
    const bf16_t* K = s1 ? K1 : K0; const int ldk = s1 ? ldk1 : ldk0;
    const bf16_t* V = s1 ? V1 : V0; const int ldv = s1 ? ldv1 : ldv0;
    bf16x8 kf[2][KS], vf[DT];
    _Pragma("unroll") for (int t = 0; t < 2; ++t) _Pragma("unroll") for (int ks = 0; ks < KS; ++ks) kf[t][ks] = *(const bf16x8*)(K + (size_t)(kc + krow_in + 4 * t) * ldk + ks * 32 + 8 * g);
    _Pragma("unroll") for (int dt = 0; dt < DT; ++dt) vf[dt] = *(const bf16x8*)(V + (size_t)(16 * dt + fr) * ldv + kc + 8 * g);
    f32x4 s[2][2];
    _Pragma("unroll") for (int qg = 0; qg < 2; ++qg) _Pragma("unroll") for (int t = 0; t < 2; ++t) {
      s[qg][t] = (f32x4){0.f, 0.f, 0.f, 0.f};
      _Pragma("unroll") for (int ks = 0; ks < KS; ++ks) s[qg][t] = __builtin_amdgcn_mfma_f32_16x16x32_bf16(kf[t][ks], qf[qg][ks], s[qg][t], 0, 0, 0);
    }
    asm volatile("s_nop 15" : "+v"(s[0][0]), "+v"(s[0][1]), "+v"(s[1][0]), "+v"(s[1][1]));
    bf16x8 pf[2];
    _Pragma("unroll") for (int qg = 0; qg < 2; ++qg) {
      float pv[8];
      _Pragma("unroll") for (int i = 0; i < 8; ++i) {
        float sv = s[qg][i >> 2][i & 3];
        if (NAL && !s1) {
          const int krow = rs + (kc >> 6), kcol = (kc & 63) + 8 * g + i;
          const int qc = qc0 + qg * 16 + fr;
          const int cs = min(max(qc - 8, 0), 48);
          const bool valid = (kcol >= cs) && (kcol < cs + 16);
          const int bi = valid ? (krow - rr + 7) * 31 + (kcol - qc + 15) : 0;
          const float bias = rpb_h[bi];
          pv[i] = valid ? __builtin_amdgcn_exp2f(sv + bias * LOG2E) : 0.f;
        } else {
          pv[i] = __builtin_amdgcn_exp2f(sv);
        }
        lsum[qg] += pv[i];
      }
      union { bf16x8 v; unsigned u[4]; } pk;
      _Pragma("unroll") for (int i = 0; i < 4; ++i) pk.u[i] = cvt_pk_bf16(pv[2 * i], pv[2 * i + 1]);
      pf[qg] = pk.v;
    }
    asm volatile("s_nop 3" : "+v"(pf[0]), "+v"(pf[1]));
    _Pragma("unroll") for (int qg = 0; qg < 2; ++qg) _Pragma("unroll") for (int dt = 0; dt < DT; ++dt)
      o[qg][dt] = __builtin_amdgcn_mfma_f32_16x16x32_bf16(vf[dt], pf[qg], o[qg][dt], 0, 0, 0);
  }
  _Pragma("unroll") for (int qg = 0; qg < 2; ++qg) _Pragma("unroll") for (int dt = 0; dt < DT; ++dt) asm volatile("s_nop 7" : "+v"(o[qg][dt]));
  _Pragma("unroll") for (int qg = 0; qg < 2; ++qg) {
    float l = lsum[qg];
    l += __shfl_xor(l, 16); l += __shfl_xor(l, 32);
    const float inv = 1.f / l;
    _Pragma("unroll") for (int dt = 0; dt < DT; ++dt) {
      uint2 pk; pk.x = cvt_pk_bf16(o[qg][dt][0] * inv, o[qg][dt][1] * inv); pk.y = cvt_pk_bf16(o[qg][dt][2] * inv, o[qg][dt][3] * inv);
      *(uint2*)(O + (size_t)(qg * 16 + fr) * ldo + 16 * dt + 4 * g) = pk;
    }
  }
}

template <bool NAL>
__device__ __forceinline__ void attn_block_na(const bf16_t* Qw, bf16_t* Ow, const bf16_t* K0, const bf16_t* V0, int ldv0, int nloc,
                                              const bf16_t* K1, const bf16_t* V1, int nctx, const float* rpb_h, int rr, int rs, int urow0, int qc0) {
  constexpr int KS = 2, DT = 4, KROW = 144, VROW = 80, KBUF = 32 * KROW, VBUF = 64 * VROW;
  const int tid = opaque_tid(), lane = tid & 63, fr = lane & 15, g = lane >> 4;
  unsigned char* kS = smem;
  unsigned char* vS = smem + 2 * KBUF;
  bf16x8 qf[2][KS];
  _Pragma("unroll") for (int qg = 0; qg < 2; ++qg) _Pragma("unroll") for (int ks = 0; ks < KS; ++ks) qf[qg][ks] = *(const bf16x8*)(Qw + (size_t)(qg * 16 + fr) * 2048 + ks * 32 + 8 * g);
  f32x4 o[2][DT];
  _Pragma("unroll") for (int qg = 0; qg < 2; ++qg) _Pragma("unroll") for (int dt = 0; dt < DT; ++dt) o[qg][dt] = (f32x4){0.f, 0.f, 0.f, 0.f};
  float lsum[2] = {0.f, 0.f};
  const int krow_in = 8 * (fr >> 2) + (fr & 3);
  const bool isk = tid < 256; const int t2 = tid & 255;
  const int sa = isk ? (t2 >> 3) : (t2 >> 2), sp = isk ? (t2 & 7) : (t2 & 3);
  const int nch = nloc + nctx;
  uint4 rg;
#define LD_CHUNK(c_) do { const int c__ = (c_); const bool loc_ = c__ < nloc; const int cc_ = loc_ ? c__ : c__ - nloc; \
    const bf16_t* kp_ = (loc_ ? K0 + (size_t)(cc_ * 32 + sa) * 2048 : K1 + (size_t)(cc_ * 32 + sa) * 1024) + sp * 8; \
    const bf16_t* vp_ = (loc_ ? V0 + (size_t)sa * ldv0 : V1 + (size_t)sa * 512) + cc_ * 32 + sp * 8; \
    rg = *(const uint4*)(isk ? kp_ : vp_); } while (0)
#define ST_CHUNK(buf_) do { if (isk) *(uint4*)(kS + (buf_) * KBUF + sa * KROW + sp * 16) = rg; else *(uint4*)(vS + (buf_) * VBUF + sa * VROW + sp * 16) = rg; } while (0)
  __syncthreads();
  LD_CHUNK(0); ST_CHUNK(0);
  __syncthreads();
  for (int c = 0; c < nch; ++c) {
    const int buf = c & 1;
    if (c + 1 < nch) LD_CHUNK(c + 1);
    const unsigned char* kb = kS + buf * KBUF; const unsigned char* vb = vS + buf * VBUF;
    bf16x8 kf[2][KS], vf[DT];
    _Pragma("unroll") for (int t = 0; t < 2; ++t) _Pragma("unroll") for (int ks = 0; ks < KS; ++ks) kf[t][ks] = *(const bf16x8*)(kb + (krow_in + 4 * t) * KROW + (ks * 32 + 8 * g) * 2);
    _Pragma("unroll") for (int dt = 0; dt < DT; ++dt) vf[dt] = *(const bf16x8*)(vb + (16 * dt + fr) * VROW + 16 * g);
    f32x4 s[2][2];
    _Pragma("unroll") for (int qg = 0; qg < 2; ++qg) _Pragma("unroll") for (int t = 0; t < 2; ++t) {
      s[qg][t] = (f32x4){0.f, 0.f, 0.f, 0.f};
      _Pragma("unroll") for (int ks = 0; ks < KS; ++ks) s[qg][t] = __builtin_amdgcn_mfma_f32_16x16x32_bf16(kf[t][ks], qf[qg][ks], s[qg][t], 0, 0, 0);
    }
    asm volatile("s_nop 15" : "+v"(s[0][0]), "+v"(s[0][1]), "+v"(s[1][0]), "+v"(s[1][1]));
    bf16x8 pf[2];
    _Pragma("unroll") for (int qg = 0; qg < 2; ++qg) {
      float pv[8];
      _Pragma("unroll") for (int i = 0; i < 8; ++i) {
        const float sv = s[qg][i >> 2][i & 3];
        if (NAL && c < nloc) {
          const int krow = urow0 + (c >> 1), kcol = (c & 1) * 32 + 8 * g + i;
          const int qc = qc0 + qg * 16 + fr;
          const int cs = min(max(qc - 8, 0), 48);
          const bool valid = (krow >= rs) && (krow < rs + 8) && (kcol >= cs) && (kcol < cs + 16);
          const int bi = valid ? (krow - rr + 7) * 31 + (kcol - qc + 15) : 0;
          const float bias = rpb_h[bi];
          pv[i] = valid ? __builtin_amdgcn_exp2f(sv + bias * LOG2E) : 0.f;
        } else {
          pv[i] = __builtin_amdgcn_exp2f(sv);
        }
        lsum[qg] += pv[i];
      }
      union { bf16x8 v; unsigned u[4]; } pk;
      _Pragma("unroll") for (int i = 0; i < 4; ++i) pk.u[i] = cvt_pk_bf16(pv[2 * i], pv[2 * i + 1]);
      pf[qg] = pk.v;
    }
    asm volatile("s_nop 3" : "+v"(pf[0]), "+v"(pf[1]));
    _Pragma("unroll") for (int qg = 0; qg < 2; ++qg) _Pragma("unroll") for (int dt = 0; dt < DT; ++dt)
      o[qg][dt] = __builtin_amdgcn_mfma_f32_16x16x32_bf16(vf[dt], pf[qg], o[qg][dt], 0, 0, 0);
    if (c + 1 < nch) ST_CHUNK(buf ^ 1);
    __syncthreads();
  }
#undef LD_CHUNK
#undef ST_CHUNK
  _Pragma("unroll") for (int qg = 0; qg < 2; ++qg) _Pragma("unroll") for (int dt = 0; dt < DT; ++dt) asm volatile("s_nop 7" : "+v"(o[qg][dt]));
  _Pragma("unroll") for (int qg = 0; qg < 2; ++qg) {
    float l = lsum[qg];
    l += __shfl_xor(l, 16); l += __shfl_xor(l, 32);
    const float inv = 1.f / l;
    _Pragma("unroll") for (int dt = 0; dt < DT; ++dt) {
      uint2 pk; pk.x = cvt_pk_bf16(o[qg][dt][0] * inv, o[qg][dt][1] * inv); pk.y = cvt_pk_bf16(o[qg][dt][2] * inv, o[qg][dt][3] * inv);
      *(uint2*)(Ow + (size_t)(qg * 16 + fr) * 1024 + 16 * dt + 4 * g) = pk;
    }
  }
}

__device__ void phase_attn_na(const Params& p) {
  const int wave = opaque_tid() >> 6;
  const bf16_t* QK = (const bf16_t*)(p.ws + WS_QK);
  const bf16_t* VT = (const bf16_t*)(p.ws + WS_VT);
  const bf16_t* CK = (const bf16_t*)(p.ws + WS_CKNA);
  const bf16_t* CVT = (const bf16_t*)(p.ws + WS_CVTNA);
  bf16_t* AO = (bf16_t*)(p.ws + WS_AO);
  for (int id = blockIdx.x; id < 256; id += gridDim.x) {
    const int k4 = id & 3, h = (id >> 2) & 15, b = id >> 6;
    const int r = k4 * 4 + (wave >> 1), wq = wave & 1;
    const int rs = min(max(r - 4, 0), 8);
    const int urow0 = min(max(k4 * 4 - 4, 0), 8), urow1 = min(max(k4 * 4 + 3 - 4, 0), 8) + 8;
    const int tokq = 4096 + b * 1024 + r * 64 + wq * 32;
    const int tokk = 4096 + b * 1024 + urow0 * 64;
    attn_block_na<true>(QK + (size_t)tokq * 2048 + h * 64, AO + (size_t)tokq * 1024 + h * 64,
                        QK + (size_t)tokk * 2048 + 1024 + h * 64,
                        VT + (size_t)4096 * 1024 + ((size_t)b * 1024 + h * 64) * 1024 + urow0 * 64, 1024, (urow1 - urow0) * 2,
                        CK + (size_t)b * 512 * 1024 + h * 64, CVT + ((size_t)b * 1024 + h * 64) * 512, 16,
                        p.in[27] + h * 15 * 31, r, rs, urow0, wq * 32);
  }
  for (int id = blockIdx.x * 8 + wave; id < 2048; id += gridDim.x * 8) {
    const int qb = id & 7, h = (id >> 3) & 15, b = id >> 7;
    const int tokq = b * 256 + qb * 32;
    attn_wave<64, false>(QK + (size_t)tokq * 2048 + h * 64, 2048,
                         QK + (size_t)(b * 256) * 2048 + 1024 + h * 64, 2048,
                         VT + ((size_t)b * 1024 + h * 64) * 256, 256, 256,
                         nullptr, 0, nullptr, 0, 0,
                         AO + (size_t)tokq * 1024 + h * 64, 1024, nullptr, 0, 0, 0);
  }
}

__device__ __forceinline__ void attn_block_gqa_latent(const bf16_t* Q, const bf16_t* K0, const bf16_t* V0, const bf16_t* K1, const bf16_t* V1, bf16_t* O) {
  constexpr int DH = 128, KS = 4, DT = 8, KROW = 272, VROW = 80, KBUF = 32 * KROW, VBUF = 128 * VROW, NCH = 48;
  const int tid = opaque_tid(), lane = tid & 63, wave = tid >> 6, fr = lane & 15, g = lane >> 4;
  unsigned char* kS = smem;
  unsigned char* vS = smem + 2 * KBUF;
  const bf16_t* Qw = Q + (size_t)(wave * 32) * 1280;
  bf16x8 qf[2][KS];
  _Pragma("unroll") for (int qg = 0; qg < 2; ++qg) _Pragma("unroll") for (int ks = 0; ks < KS; ++ks) qf[qg][ks] = *(const bf16x8*)(Qw + (size_t)(qg * 16 + fr) * 1280 + ks * 32 + 8 * g);
  f32x4 o[2][DT];
  _Pragma("unroll") for (int qg = 0; qg < 2; ++qg) _Pragma("unroll") for (int dt = 0; dt < DT; ++dt) o[qg][dt] = (f32x4){0.f, 0.f, 0.f, 0.f};
  float lsum[2] = {0.f, 0.f};
  const int krow_in = 8 * (fr >> 2) + (fr & 3);
  const int skey = tid >> 4, skp = tid & 15, sd = tid >> 2, svp = tid & 3;
  uint4 rk, rv;
#define LD_CHUNK(c_) do { const int kc_ = (c_) * 32; \
    if (kc_ < 1024) { rk = *(const uint4*)(K0 + (size_t)(kc_ + skey) * 1280 + skp * 8); rv = *(const uint4*)(V0 + (size_t)sd * 1024 + kc_ + svp * 8); } \
    else { rk = *(const uint4*)(K1 + (size_t)(kc_ - 1024 + skey) * 256 + skp * 8); rv = *(const uint4*)(V1 + (size_t)sd * 512 + (kc_ - 1024) + svp * 8); } } while (0)
#define ST_CHUNK(buf_) do { *(uint4*)(kS + (buf_) * KBUF + skey * KROW + skp * 16) = rk; *(uint4*)(vS + (buf_) * VBUF + sd * VROW + svp * 16) = rv; } while (0)
  __syncthreads();
  LD_CHUNK(0); ST_CHUNK(0);
  __syncthreads();
  for (int c = 0; c < NCH; ++c) {
    const int buf = c & 1;
    if (c + 1 < NCH) LD_CHUNK(c + 1);
    const unsigned char* kb = kS + buf * KBUF; const unsigned char* vb = vS + buf * VBUF;
    bf16x8 kf[2][KS], vf[DT];
    _Pragma("unroll") for (int t = 0; t < 2; ++t) _Pragma("unroll") for (int ks = 0; ks < KS; ++ks) kf[t][ks] = *(const bf16x8*)(kb + (krow_in + 4 * t) * KROW + (ks * 32 + 8 * g) * 2);
    _Pragma("unroll") for (int dt = 0; dt < DT; ++dt) vf[dt] = *(const bf16x8*)(vb + (16 * dt + fr) * VROW + 16 * g);
    f32x4 s[2][2];
    _Pragma("unroll") for (int qg = 0; qg < 2; ++qg) _Pragma("unroll") for (int t = 0; t < 2; ++t) {
      s[qg][t] = (f32x4){0.f, 0.f, 0.f, 0.f};
      _Pragma("unroll") for (int ks = 0; ks < KS; ++ks) s[qg][t] = __builtin_amdgcn_mfma_f32_16x16x32_bf16(kf[t][ks], qf[qg][ks], s[qg][t], 0, 0, 0);
    }
    asm volatile("s_nop 15" : "+v"(s[0][0]), "+v"(s[0][1]), "+v"(s[1][0]), "+v"(s[1][1]));
    bf16x8 pf[2];
    _Pragma("unroll") for (int qg = 0; qg < 2; ++qg) {
      float pv[8];
      _Pragma("unroll") for (int i = 0; i < 8; ++i) { pv[i] = __builtin_amdgcn_exp2f(s[qg][i >> 2][i & 3]); lsum[qg] += pv[i]; }
      union { bf16x8 v; unsigned u[4]; } pk;
      _Pragma("unroll") for (int i = 0; i < 4; ++i) pk.u[i] = cvt_pk_bf16(pv[2 * i], pv[2 * i + 1]);
      pf[qg] = pk.v;
    }
    asm volatile("s_nop 3" : "+v"(pf[0]), "+v"(pf[1]));
    _Pragma("unroll") for (int qg = 0; qg < 2; ++qg) _Pragma("unroll") for (int dt = 0; dt < DT; ++dt)
      o[qg][dt] = __builtin_amdgcn_mfma_f32_16x16x32_bf16(vf[dt], pf[qg], o[qg][dt], 0, 0, 0);
    if (c + 1 < NCH) ST_CHUNK(buf ^ 1);
    __syncthreads();
  }
#undef LD_CHUNK
#undef ST_CHUNK
  _Pragma("unroll") for (int qg = 0; qg < 2; ++qg) _Pragma("unroll") for (int dt = 0; dt < DT; ++dt) asm volatile("s_nop 7" : "+v"(o[qg][dt]));
  bf16_t* Ow = O + (size_t)(wave * 32) * 1024;
  _Pragma("unroll") for (int qg = 0; qg < 2; ++qg) {
    float l = lsum[qg];
    l += __shfl_xor(l, 16); l += __shfl_xor(l, 32);
    const float inv = 1.f / l;
    _Pragma("unroll") for (int dt = 0; dt < DT; ++dt) {
      uint2 pk; pk.x = cvt_pk_bf16(o[qg][dt][0] * inv, o[qg][dt][1] * inv); pk.y = cvt_pk_bf16(o[qg][dt][2] * inv, o[qg][dt][3] * inv);
      *(uint2*)(Ow + (size_t)(qg * 16 + fr) * 1024 + 16 * dt + 4 * g) = pk;
    }
  }
}

__device__ void phase_attn_gqa(const Params& p) {
  const int wave = opaque_tid() >> 6;
  const bf16_t* QK = (const bf16_t*)(p.ws + WS_QK);
  const bf16_t* VT = (const bf16_t*)(p.ws + WS_VT);
  const bf16_t* CK = (const bf16_t*)(p.ws + WS_CKGQA);
  const bf16_t* CVT = (const bf16_t*)(p.ws + WS_CVTGQA);
  bf16_t* AO = (bf16_t*)(p.ws + WS_AO);
  const int G = gridDim.x, nlat = G >= 256 ? 128 : G / 2;
  if ((int)blockIdx.x < nlat) {
    for (int id = blockIdx.x; id < 128; id += nlat) {
      const int qblk = id & 3, hq = (id >> 2) & 7, b = id >> 5, hk = hq >> 2;
      const int tokq = 4096 + b * 1024 + qblk * 256;
      attn_block_gqa_latent(QK + (size_t)tokq * 1280 + hq * 128,
                            QK + (size_t)(4096 + b * 1024) * 1280 + 1024 + hk * 128,
                            VT + (size_t)4096 * 256 + ((size_t)b * 256 + hk * 128) * 1024,
                            CK + (size_t)b * 512 * 256 + hk * 128,
                            CVT + ((size_t)b * 256 + hk * 128) * 512,
                            AO + (size_t)tokq * 1024 + hq * 128);
    }
  } else {
    const int nw = (G - nlat) * 8;
    for (int id = ((int)blockIdx.x - nlat) * 8 + wave; id < 1024; id += nw) {
      const int qb = id & 7, hq = (id >> 3) & 7, b = id >> 6, hk = hq >> 2;
      const int tokq = b * 256 + qb * 32;
      attn_wave<128, false>(QK + (size_t)tokq * 1280 + hq * 128, 1280,
                            QK + (size_t)(b * 256) * 1280 + 1024 + hk * 128, 1280,
                            VT + ((size_t)b * 256 + hk * 128) * 256, 256, 256,
                            nullptr, 0, nullptr, 0, 0,
                            AO + (size_t)tokq * 1024 + hq * 128, 1024, nullptr, 0, 0, 0);
    }
  }
}

#define XB_TMO      128
#define XB_XCNT(j)  (256  + 64 * (j))
#define XB_XSUB(j)  (1280 + 64 * (j))
#define XB_XGEN(j)  (2304 + 64 * (j))
#define XB_TOP      3328
#define XB_TOPGEN   3392
#define XCD_BAR_WORDS 3456
#define XB_SPIN_CAP (1u << 18)
#define LAS __attribute__((address_space(3)))

__device__ __forceinline__ unsigned xb_ld(unsigned* p)              { return __hip_atomic_load(p, __ATOMIC_RELAXED, __HIP_MEMORY_SCOPE_AGENT); }
__device__ __forceinline__ unsigned xb_add(unsigned* p, unsigned v) { return __hip_atomic_fetch_add(p, v, __ATOMIC_RELAXED, __HIP_MEMORY_SCOPE_AGENT); }
__device__ __forceinline__ unsigned xb_xcc_id() { return (unsigned)__builtin_amdgcn_s_getreg((3 << 11) | 20) & 0xFu; }
#define XB_SPIN(cond, bar) do { unsigned _sp = 0; while (cond) { __builtin_amdgcn_s_sleep(1); \
    if ((++_sp & 255u) == 0u) { if (xb_ld(&(bar)[XB_TMO])) break; if (_sp > XB_SPIN_CAP) { atomicAdd(&(bar)[XB_TMO], 1u); break; } } } } while (0)

struct XcdBarrier {
    unsigned* bar; unsigned x;
    volatile LAS unsigned* st;
};

__device__ __forceinline__ XcdBarrier xcd_barrier_post(unsigned* bar, volatile LAS unsigned* st) {
    XcdBarrier b; b.bar = bar; b.x = xb_xcc_id(); b.st = st;
    if (threadIdx.x == 0) (void)xb_add(&bar[XB_XCNT(b.x)], 1u);
    return b;
}
__device__ __forceinline__ void xcd_barrier_complete(unsigned* bar, unsigned x, unsigned& nloc, unsigned& nx) {
    const unsigned G = gridDim.x * gridDim.y * gridDim.z;
    unsigned sum, cnt, mine, sp = 0u;
    for (;;) {
        sum = 0u; cnt = 0u; mine = 0u;
#pragma unroll
        for (unsigned j = 0; j < 16; ++j) { const unsigned c = xb_ld(&bar[XB_XCNT(j)]); sum += c; cnt += (c > 0u) ? 1u : 0u; mine = (j == x) ? c : mine; }
        if (sum == G) break;
        __builtin_amdgcn_s_sleep(1);
        if ((++sp & 255u) == 0u) { if (xb_ld(&bar[XB_TMO])) break; if (sp > XB_SPIN_CAP) { atomicAdd(&bar[XB_TMO], 1u); break; } }
    }
    nloc = mine > 0u ? mine : 1u; nx = cnt > 0u ? cnt : 1u;
}

__device__ __forceinline__ void xcd_barrier(const XcdBarrier& b) {
    asm volatile("s_waitcnt vmcnt(0)" ::: "memory");
    __syncthreads();
    if (threadIdx.x == 0) {
        unsigned* bar = b.bar; unsigned xb_probe = 0u;
        __builtin_amdgcn_s_waitcnt(0);
        unsigned nloc = b.st[0], nx = b.st[1];
        if (nloc == 0u) { xcd_barrier_complete(bar, b.x, nloc, nx); b.st[0] = nloc; b.st[1] = nx; }
        const unsigned old = xb_add(&bar[XB_XSUB(b.x)], 1u);
        const unsigned gen = old / nloc;
        if (old + 1u == (gen + 1u) * nloc) {
            __builtin_amdgcn_fence(__ATOMIC_RELEASE, "agent");
            asm volatile("s_waitcnt vmcnt(0)" ::: "memory");
            const unsigned og = xb_add(&bar[XB_TOP], 1u);
            const unsigned tg = og / nx;
            if (og + 1u == (tg + 1u) * nx) xb_add(&bar[XB_TOPGEN], 1u);
            else XB_SPIN(xb_ld(&bar[XB_TOPGEN]) == tg, bar);
            __builtin_amdgcn_fence(__ATOMIC_ACQUIRE, "agent"); xb_probe = xb_ld(&bar[XB_TMO]);
            xb_add(&bar[XB_XGEN(b.x)], 1u);
            asm volatile("s_waitcnt vmcnt(0)" ::: "memory");
        } else {
            XB_SPIN(xb_ld(&bar[XB_XGEN(b.x)]) == gen, bar);
            __builtin_amdgcn_fence(__ATOMIC_ACQUIRE, "agent"); xb_probe = xb_ld(&bar[XB_TMO]);
            asm volatile("s_waitcnt vmcnt(0)" ::: "memory");
        }
        asm volatile("" :: "v"(xb_probe));
        __builtin_amdgcn_s_sleep(80);
    }
    __syncthreads();
}


__device__ void phase_fake_mlp1(const Params& p) {
  const int tid = opaque_tid();
  const uint4* HB = (const uint4*)(p.ws + WS_HB);
  uint4* ACT = (uint4*)(p.ws + WS_ACT);
  for (size_t i = (size_t)blockIdx.x * NT + tid; i < (size_t)NTOK * DFF / 8; i += (size_t)gridDim.x * NT) {
    const size_t row = i >> 9, c8 = i & 511;
    uint4 v = HB[row * 128 + (c8 & 127)];
    unsigned w[4] = {v.x, v.y, v.z, v.w};
    for (int j = 0; j < 4; ++j) { float a = bflo(w[j]), b = bfhi(w[j]); w[j] = cvt_pk_bf16(a * a, b * b); }
    ACT[i] = make_uint4(w[0], w[1], w[2], w[3]);
  }
}
__global__ void __launch_bounds__(NT) fwd_megakernel(Params p) {
  cg::grid_group grid = cg::this_grid();
  unsigned char* ws = p.ws;
  const float* MOD = (const float*)(ws + WS_MOD);
  bf16_t* HB = (bf16_t*)(ws + WS_HB);
  bf16_t* AO = (bf16_t*)(ws + WS_AO);
  bf16_t* QK = (bf16_t*)(ws + WS_QK);
  bf16_t* VT = (bf16_t*)(ws + WS_VT);
  bf16_t* ACT = (bf16_t*)(ws + WS_ACT);
  int ph = 0;
#ifdef CHK_INPUT
  { float* chk = (float*)(ws + WS_END);
    const int t = opaque_tid();
    const float* sp = p.in[CHK_INPUT];
    const size_t per = (size_t)CHK_COUNT / gridDim.x;
    float s = 0.f;
    for (size_t i = t; i < per; i += NT) { float v = sp[(size_t)blockIdx.x * per + i]; s += v * (1.f + (float)(i & 15)); }
    float* red = (float*)smem; red[t] = s; __syncthreads();
    if (t == 0) { float a = 0.f; for (int i = 0; i < NT; ++i) a += red[i]; chk[blockIdx.x] = a; }
    __syncthreads(); }
#endif
#ifdef START_DELAY_TICKS
  { const unsigned long long t0 = __builtin_amdgcn_s_memrealtime(); while (__builtin_amdgcn_s_memrealtime() - t0 < START_DELAY_TICKS) __builtin_amdgcn_s_sleep(8); }
#endif
  volatile LAS unsigned* xb_st = (volatile LAS unsigned*)(smem + 131072);
  if (threadIdx.x < 2) xb_st[threadIdx.x] = 0u;
  __syncthreads();
  XcdBarrier xbar = xcd_barrier_post((unsigned*)(ws + WS_BAR), xb_st);
  if (p.ph_hi - p.ph_lo > 1) grid.sync();
#ifdef EXTRA_SYNCS
  for (int i_ = 0; i_ < EXTRA_SYNCS; ++i_) grid.sync();
#endif
#ifndef EN_GEMM
#define EN_GEMM 15
#endif
#ifndef EN_ATTN
#define EN_ATTN 1
#endif
#ifndef EN_S5
#define EN_S5 1
#endif
#ifndef EN_MISC
#define EN_MISC 1
#endif
#define RUN(body) do { if (p.ph_lo <= ph && ph < p.ph_hi) { body; if (ph + 1 < p.ph_hi) xcd_barrier(xbar); } ++ph; } while (0)

  RUN(if (EN_MISC) phase_prologue(p));
  for (int layer = 0; layer < 4; ++layer) {
    const int kind = layer % 3, slot = layer / 3;
    RUN(if (EN_MISC) phase_norm(p, layer, 0, layer == 0));
    if (kind == 0) {
      RUN(if (EN_S5) phase_s5_pass1(p, slot));
      RUN(if (EN_S5) phase_s5_pass2(p, slot));
      { GemmArgs ga{HB, D, (const bf16_t*)(ws + WS_GLUT) + (size_t)slot * 2048 * 1024, D, 32, 16, 1024, 0xffff};
        EpiGlu e{p.out, MOD + layer * 5 * 6144 + 2 * 1024, p.in[23] + slot * 2048};
        RUN(if (EN_GEMM & 1) gemm_phase<128>(ga, e)); }
    } else if (kind == 1) {
      { GemmArgs ga{HB, D, (const bf16_t*)(ws + WS_NAQKVT), D, 32, 24, 1024, 0xffff};
        EpiQkv e{QK, 2048, VT, 1024, p.out + OUT_NAV};
        RUN(if (EN_GEMM & 2) gemm_phase<128>(ga, e)); }
      RUN(if (EN_MISC) phase_post_na(p));
      RUN(if (EN_ATTN) phase_attn_na(p));
      { GemmArgs ga{AO, D, (const bf16_t*)(ws + WS_NAOT), D, 32, 8, 1024, 0xffff};
        EpiResid e{p.out, MOD + layer * 5 * 6144 + 2 * 1024};
        RUN(if (EN_GEMM & 4) gemm_phase<128>(ga, e)); }
    } else {
      { GemmArgs ga{HB, D, (const bf16_t*)(ws + WS_GQAQKVT), D, 32, 12, 1024, 0xffff};
        EpiQkv e{QK, 1280, VT, 256, p.out + OUT_GQAV};
        RUN(if (EN_GEMM & 2) gemm_phase<128>(ga, e)); }
      RUN(if (EN_MISC) phase_post_gqa(p));
      RUN(if (EN_ATTN) phase_attn_gqa(p));
      { GemmArgs ga{AO, D, (const bf16_t*)(ws + WS_GQAOT), D, 32, 8, 1024, 0xffff};
        EpiResid e{p.out, MOD + layer * 5 * 6144 + 2 * 1024};
        RUN(if (EN_GEMM & 4) gemm_phase<128>(ga, e)); }
    }
    RUN(if (EN_MISC) phase_norm(p, layer, 1, false));
    { GemmArgs ga{HB, D, (const bf16_t*)(ws + WS_W1T) + (size_t)layer * 4096 * 1024, D, 32, 16, 1024, 0xffff};
      EpiSqRelu e{ACT};
      RUN(if (EN_GEMM & 8) gemm_phase<256>(ga, e)); }
    { GemmArgs ga{ACT, DFF, (const bf16_t*)(ws + WS_W2T) + (size_t)layer * 1024 * 4096, DFF, 32, 8, 4096, 0xffff};
      EpiResid e{p.out, MOD + layer * 5 * 6144 + 5 * 1024};
      RUN(if (EN_GEMM & 4) gemm_phase<128>(ga, e)); }
  }
#ifdef FINAL_SYNC
  if (p.ph_hi - p.ph_lo > 1) { grid.sync(); { const unsigned long long t0 = __builtin_amdgcn_s_memrealtime(); while (__builtin_amdgcn_s_memrealtime() - t0 < 2000ull) __builtin_amdgcn_s_sleep(8); } grid.sync(); }
#endif
#ifdef DUMP_S5P
  if (p.ph_hi - p.ph_lo > 1) {
    grid.sync();
    const float* sa = (const float*)(ws + WS_S5A);
    const unsigned* sb = (const unsigned*)(ws + WS_S5BB);
    const unsigned* sc = (const unsigned*)(ws + WS_S5CM);
    for (size_t i = (size_t)blockIdx.x * NT + opaque_tid(); i < 524288; i += (size_t)gridDim.x * NT) {
      if (i < 32768) p.out[i] = sa[i];
      unsigned w = sb[i]; p.out[65536 + 2 * i] = bflo(w); p.out[65536 + 2 * i + 1] = bfhi(w);
      unsigned w2 = sc[i]; p.out[2097152 + 2 * i] = bflo(w2); p.out[2097152 + 2 * i + 1] = bfhi(w2);
    }
  }
#endif
#ifdef DUMP_E
  if (p.ph_hi - p.ph_lo > 1) {
    grid.sync();
    const float* sp = (const float*)(ws + WS_S5E);
    for (size_t i = (size_t)blockIdx.x * NT + opaque_tid(); i < 2097152; i += (size_t)gridDim.x * NT) p.out[i] = sp[i];
  }
#endif
#ifdef DUMP_HB
  if (p.ph_hi - p.ph_lo > 1) {
    grid.sync();
    const unsigned* sp = (const unsigned*)(ws + WS_HB);
    for (size_t i = (size_t)blockIdx.x * NT + opaque_tid(); i < 4194304; i += (size_t)gridDim.x * NT) {
      unsigned w = sp[i]; p.out[2 * i] = bflo(w); p.out[2 * i + 1] = bfhi(w);
    }
  }
#endif
#ifdef DUMP_W2T
  if (p.ph_lo == 100) {
    const unsigned* sp = (const unsigned*)(ws + WS_W2T);
    for (size_t i = (size_t)blockIdx.x * NT + opaque_tid(); i < 19398656 / 2; i += (size_t)gridDim.x * NT) {
      float a = 0.f, b = 0.f;
      if (i < 2097152) { unsigned w = sp[i]; a = bflo(w); b = bfhi(w); }
      p.out[2 * i] = a; p.out[2 * i + 1] = b;
    }
  }
#endif
#undef RUN
#ifdef CHK_W2T
  grid.sync();
  { float* chk = (float*)(ws + WS_END);
    const int t = opaque_tid();
    const unsigned* sp = (const unsigned*)(ws + WS_W2T);
    const size_t per = (size_t)(33554432 / 4) / gridDim.x;
    float s = 0.f;
    for (size_t i = t; i < per; i += NT) { unsigned w = sp[(size_t)blockIdx.x * per + i]; s += (bflo(w) + 2.f * bfhi(w)) * (1.f + (float)(i & 15)); }
    float* red = (float*)smem; red[t] = s; __syncthreads();
    if (t == 0) { float a = 0.f; for (int i = 0; i < NT; ++i) a += red[i]; chk[blockIdx.x] = a; }
    __syncthreads(); }
  grid.sync();
  { const float* chk = (const float*)(ws + WS_END);
    for (size_t i = (size_t)blockIdx.x * NT + opaque_tid(); i < 19398656; i += (size_t)gridDim.x * NT) p.out[i] = chk[(i >> 10) & 255]; }
#endif
#ifdef CHK_INPUT
  grid.sync();
  { const float* chk = (const float*)(ws + WS_END);
    for (size_t i = (size_t)blockIdx.x * NT + opaque_tid(); i < 19398656; i += (size_t)gridDim.x * NT) p.out[i] = chk[(i >> 10) & 255]; }
#endif
}

extern "C" void kernel_launch(void* const* d_in, const int* in_sizes, int n_in, void* d_out, int out_size, void* d_ws, size_t ws_size, hipStream_t stream) {
  static int grid_blocks = 0;
  if (grid_blocks == 0) {
    if (n_in != 33 || ws_size < WS_END) { fprintf(stderr, "kernel_launch: unexpected n_in %d or ws_size %zu (< %zu)\n", n_in, ws_size, (size_t)WS_END); grid_blocks = -1; return; }
    int dev = 0, cus = 0, per_cu = 0;
    (void)hipGetDevice(&dev);
    (void)hipDeviceGetAttribute(&cus, hipDeviceAttributeMultiprocessorCount, dev);
    if (hipFuncSetAttribute((const void*)fwd_megakernel, hipFuncAttributeMaxDynamicSharedMemorySize, LDS_BYTES) != hipSuccess) { fprintf(stderr, "hipFuncSetAttribute failed\n"); grid_blocks = -1; return; }
    if (hipOccupancyMaxActiveBlocksPerMultiprocessor(&per_cu, (const void*)fwd_megakernel, NT, LDS_BYTES) != hipSuccess || per_cu < 1) { fprintf(stderr, "occupancy query failed (%d)\n", per_cu); (void)hipGetLastError(); per_cu = 1; }
    grid_blocks = cus * 1;
    fprintf(stderr, "kernel_launch: cus %d per_cu %d grid %d\n", cus, per_cu, grid_blocks);
  }
  if (grid_blocks < 0) return;
  (void)hipMemsetAsync((unsigned char*)d_ws + WS_BAR, 0, 16384, stream);
  Params p{};
  for (int i = 0; i < 33; ++i) p.in[i] = (const float*)d_in[i];
  p.out = (float*)d_out; p.ws = (unsigned char*)d_ws;
#if N_LAUNCH_MODE == 1
  #ifndef PH_HI
#define PH_HI NPHASE
#endif
  p.ph_lo = 0; p.ph_hi = PH_HI;
  void* args[] = {&p};
  hipError_t e = hipLaunchCooperativeKernel((void*)fwd_megakernel, dim3(grid_blocks), dim3(NT), args, LDS_BYTES, stream);
  if (e != hipSuccess) fprintf(stderr, "cooperative launch failed: %s (grid %d)\n", hipGetErrorString(e), grid_blocks);
#else
#ifndef PH_HI
#define PH_HI NPHASE
#endif
  for (int ph = 0; ph < PH_HI; ++ph) {
    p.ph_lo = ph; p.ph_hi = ph + 1;
    hipLaunchKernelGGL(fwd_megakernel, dim3(grid_blocks), dim3(NT), LDS_BYTES, stream, p);
  }
#ifdef DUMP_W2T
  p.ph_lo = 100; p.ph_hi = 101;
  hipLaunchKernelGGL(fwd_megakernel, dim3(grid_blocks), dim3(NT), LDS_BYTES, stream, p);
#endif
#endif
}
```

```cpp
#include <hip/hip_runtime.h>
#include <hip/hip_bf16.h>
#include <hip/hip_cooperative_groups.h>
#include <cstdio>
namespace cg = cooperative_groups;

typedef unsigned short bf16_t;
using bf16 = __hip_bfloat16;
using bf16x8 = __attribute__((ext_vector_type(8))) short;
using f32x4 = __attribute__((ext_vector_type(4))) float;
using f32x16 = __attribute__((ext_vector_type(16))) float;

#define B_AUX 0
#ifndef USE_GLDS
#define USE_GLDS 1
#endif
#ifndef N_LAUNCH_MODE
#define N_LAUNCH_MODE 1
#endif

constexpr int NT = 512;
constexpr int D = 1024, NTOK = 8192, DFF = 4096;
constexpr int LDS_BYTES = 131072 + 64;
constexpr int NPHASE = 31;

constexpr size_t WS_W1T = 0;
constexpr size_t WS_W2T = WS_W1T + 33554432;
constexpr size_t WS_GLUT = WS_W2T + 33554432;
constexpr size_t WS_NAQKVT = WS_GLUT + 8388608;
constexpr size_t WS_NAOT = WS_NAQKVT + 6291456;
constexpr size_t WS_GQAQKVT = WS_NAOT + 2097152;
constexpr size_t WS_GQAOT = WS_GQAQKVT + 3145728;
constexpr size_t WS_MOD = WS_GQAOT + 2097152;
constexpr size_t WS_S5A = WS_MOD + 491520;
constexpr size_t WS_S5BB = WS_S5A + 131072;
constexpr size_t WS_S5CM = WS_S5BB + 1048576;
constexpr size_t WS_S5E = WS_S5CM + 1048576;
constexpr size_t WS_CKNA = WS_S5E + 8388608;
constexpr size_t WS_CVTNA = WS_CKNA + 4194304;
constexpr size_t WS_CKGQA = WS_CVTNA + 4194304;
constexpr size_t WS_CVTGQA = WS_CKGQA + 1048576;
constexpr size_t WS_HB = WS_CVTGQA + 1048576;
constexpr size_t WS_AO = WS_HB + 16777216;
constexpr size_t WS_QK = WS_AO + 16777216;
constexpr size_t WS_VT = WS_QK + 33554432;
constexpr size_t WS_ACT = WS_VT + 16777216;
constexpr size_t WS_BAR = WS_ACT + 67108864;
constexpr size_t WS_END = WS_BAR + 16384;

constexpr size_t OUT_YS = 4194304, OUT_S5 = 8388608, OUT_NAK = 8912896, OUT_NAV = 13107200, OUT_GQAK = 17301504, OUT_GQAV = 18350080;

struct Params {
  const float* in[33];
  float* out;
  unsigned char* ws;
  int ph_lo, ph_hi;
};

extern __shared__ __attribute__((aligned(16))) unsigned char smem[];

__device__ __forceinline__ unsigned cvt_pk_bf16(float lo, float hi) {
  unsigned r; asm("v_cvt_pk_bf16_f32 %0, %1, %2" : "=v"(r) : "v"(lo), "v"(hi)); return r;
}
__device__ __forceinline__ bf16_t f2bf(float f) { return (bf16_t)(cvt_pk_bf16(f, 0.f) & 0xffffu); }
__device__ __forceinline__ float bf2f(bf16_t b) { return __uint_as_float(((unsigned)b) << 16); }
__device__ __forceinline__ float bflo(unsigned u) { return __uint_as_float(u << 16); }
__device__ __forceinline__ float bfhi(unsigned u) { return __uint_as_float(u & 0xffff0000u); }
__device__ __forceinline__ int cond_of_row(int row) { return row < 4096 ? 0 : 1 + ((row - 4096) >> 10); }

__device__ __forceinline__ int opaque_tid() { int t = threadIdx.x; asm volatile("" : "+v"(t)); return t; }
#define MFMA_SETTLE() asm volatile("s_nop 15\n\ts_nop 15" ::: "memory")
__device__ __forceinline__ void bu_mfma4(f32x16& c0, f32x16& c1, f32x16& c2, f32x16& c3, bf16x8 a, bf16x8 b0, bf16x8 b1, bf16x8 b2, bf16x8 b3) {
  asm volatile("v_mfma_f32_32x32x16_bf16 %0, %4, %5, 0\n\t"
               "v_mfma_f32_32x32x16_bf16 %1, %4, %6, 0\n\t"
               "v_mfma_f32_32x32x16_bf16 %2, %4, %7, 0\n\t"
               "v_mfma_f32_32x32x16_bf16 %3, %4, %8, 0\n\t"
               "s_nop 15\n\ts_nop 15"
               : "=&v"(c0), "=&v"(c1), "=&v"(c2), "=&v"(c3) : "v"(a), "v"(b0), "v"(b1), "v"(b2), "v"(b3));
}
struct cplx { float re, im; };
__device__ __forceinline__ cplx cmul(cplx a, cplx b) { return {a.re * b.re - a.im * b.im, a.re * b.im + a.im * b.re}; }
__device__ __forceinline__ cplx cfma(cplx a, cplx h, cplx b) {
  cplx r; r.re = fmaf(a.re, h.re, fmaf(-a.im, h.im, b.re)); r.im = fmaf(a.re, h.im, fmaf(a.im, h.re, b.im)); return r;
}

constexpr int BM = 256, BK = 64, NXCD = 8, WGM = 8;

__device__ __forceinline__ int lds_byte(int r, int c) {
  int st = (r >> 4) * 2 + (c >> 5), ob = (r & 15) * 64 + (c & 31) * 2;
  return st * 1024 + (ob ^ (((ob >> 9) & 1) << 5));
}
__device__ __forceinline__ void stage_rc(int b, int& R, int& C) {
  int st = b >> 10, sb = b & 1023, swz = sb ^ (((sb >> 9) & 1) << 5);
  R = (st / 2) * 16 + swz / 64; C = (st % 2) * 32 + (swz % 64) / 2;
}

struct GemmArgs { const bf16_t* A; int lda; const bf16_t* Bt; int ldb; int nM, nN, K; int kmask; };

template <int BN, class Epi>
__device__ __forceinline__ void gemm_phase(const GemmArgs ga, const Epi epi) {
  constexpr int TILE_A = BM * BK * 2, TILE_B = BN * BK * 2, STAGE_B = TILE_A + TILE_B, GLA = TILE_A / 8192, GLB = TILE_B / 8192, NF = BN / 64;
  unsigned char* shm = smem;
  const int tid = opaque_tid(), wid = tid >> 6, lane = tid & 63, wr = wid >> 2, wc = wid & 3, fr = lane & 15, fq = lane >> 4;
  unsigned voA[GLA], voB[GLB];
#pragma unroll
  for (int i = 0; i < GLA; ++i) { int r_, c_; stage_rc(wid * 1024 + i * 8192 + lane * 16, r_, c_); voA[i] = (unsigned)(r_ * ga.lda + c_) * 2u; }
#pragma unroll
  for (int i = 0; i < GLB; ++i) { int r_, c_; stage_rc(wid * 1024 + i * 8192 + lane * 16, r_, c_); voB[i] = (unsigned)(r_ * ga.ldb + c_) * 2u; }
  int offA[8], offB[NF];
#pragma unroll
  for (int m = 0; m < 8; ++m) offA[m] = lds_byte(wr * 128 + m * 16 + fr, fq * 8);
#pragma unroll
  for (int n = 0; n < NF; ++n) offB[n] = TILE_A + lds_byte(wc * (BN / 4) + n * 16 + fr, fq * 8);
  const int nwg = ga.nM * ga.nN, nt = ga.K / BK;
  for (int u = blockIdx.x; u < nwg; u += gridDim.x) {
    int wgid = u;
    { int q = nwg / NXCD, r = nwg % NXCD, xcd = wgid % NXCD, off = wgid / NXCD;
      wgid = (xcd < r ? xcd * (q + 1) : r * (q + 1) + (xcd - r) * q) + off; }
    constexpr int WG_ = (BN == 128) ? 4 : WGM;
    const int nig = WG_ * ga.nN, gid = wgid / nig, fm = gid * WG_, gsz = min(ga.nM - fm, WG_);
    const int pm = fm + ((wgid % nig) % gsz), pn = (wgid % nig) / gsz, brow = pm * BM, bcol = pn * BN;
    const bf16_t* Ab = ga.A + (long)brow * ga.lda;
    const bf16_t* Bb = ga.Bt + (long)bcol * ga.ldb;
#define GLDS_STAGE(buf, kt) do { \
    _Pragma("unroll") for (int i = 0; i < GLA; ++i) \
      __builtin_amdgcn_global_load_lds((const unsigned*)((const char*)(Ab + ((kt) & ga.kmask) * BK) + voA[i]), \
        (__attribute__((address_space(3))) unsigned*)(shm + (buf) * STAGE_B + wid * 1024 + i * 8192), 16, 0, 0); \
    _Pragma("unroll") for (int i = 0; i < GLB; ++i) \
      __builtin_amdgcn_global_load_lds((const unsigned*)((const char*)(Bb + ((kt) & ga.kmask) * BK) + voB[i]), \
        (__attribute__((address_space(3))) unsigned*)(shm + (buf) * STAGE_B + TILE_A + wid * 1024 + i * 8192), 16, 0, B_AUX); } while (0)
    f32x4 acc[8][NF];
#pragma unroll
    for (int m = 0; m < 8; ++m)
#pragma unroll
      for (int n = 0; n < NF; ++n) acc[m][n] = (f32x4){0.f, 0.f, 0.f, 0.f};
#define LOADF(A_, B_, ks_) do { \
      _Pragma("unroll") for (int m = 0; m < 8; ++m) A_[m] = *(const bf16x8*)(sb + offA[m] + (ks_) * 1024); \
      _Pragma("unroll") for (int n = 0; n < NF; ++n) B_[n] = *(const bf16x8*)(sb + offB[n] + (ks_) * 1024); } while (0)
#define MMAS(A_, B_) do { \
      _Pragma("unroll") for (int m = 0; m < 8; ++m) \
        _Pragma("unroll") for (int n = 0; n < NF; ++n) acc[m][n] = __builtin_amdgcn_mfma_f32_16x16x32_bf16(B_[n], A_[m], acc[m][n], 0, 0, 0); } while (0)
#define COMPUTE(cur_) do { const unsigned char* sb = shm + (cur_) * STAGE_B; \
      if constexpr (NF == 2) { \
        bf16x8 A0[8], B0[NF], A1[8], B1[NF]; \
        LOADF(A0, B0, 0); LOADF(A1, B1, 1); \
        __builtin_amdgcn_sched_barrier(0); \
        MMAS(A0, B0); MMAS(A1, B1); \
        __builtin_amdgcn_sched_barrier(0); \
      } else { \
        bf16x8 A0[8], B0[NF]; \
        LOADF(A0, B0, 0); __builtin_amdgcn_sched_barrier(0); MMAS(A0, B0); __builtin_amdgcn_sched_barrier(0); \
        LOADF(A0, B0, 1); __builtin_amdgcn_sched_barrier(0); MMAS(A0, B0); __builtin_amdgcn_sched_barrier(0); \
      } } while (0)
#if USE_GLDS
    GLDS_STAGE(0, 0);
    asm volatile("s_waitcnt vmcnt(0)" ::: "memory"); __syncthreads();
    for (int t = 0; t < nt; ++t) {
      const int cur = t & 1;
      if (t + 1 < nt) GLDS_STAGE(cur ^ 1, t + 1);
      COMPUTE(cur);
      asm volatile("s_waitcnt vmcnt(0)" ::: "memory"); __syncthreads();
    }
#else
    uint4 sa0, sa1, sa2, sa3, sb0, sb1, sb2, sb3;
    static_assert(GLA == 4 && (GLB == 2 || GLB == 4), "staging shape");
#define GSRC_A(kt, i) (*(const uint4*)((const char*)(Ab + ((kt) & ga.kmask) * BK) + voA[i]))
#define GSRC_B(kt, i) (*(const uint4*)((const char*)(Bb + ((kt) & ga.kmask) * BK) + voB[i]))
#define LDST_A(buf, i) (*(uint4*)(shm + (buf) * STAGE_B + wid * 1024 + (i) * 8192 + lane * 16))
#define LDST_B(buf, i) (*(uint4*)(shm + (buf) * STAGE_B + TILE_A + wid * 1024 + (i) * 8192 + lane * 16))
#define REG_ISSUE(kt) do { sa0 = GSRC_A(kt, 0); sa1 = GSRC_A(kt, 1); sa2 = GSRC_A(kt, 2); sa3 = GSRC_A(kt, 3); \
      sb0 = GSRC_B(kt, 0); sb1 = GSRC_B(kt, 1); if constexpr (GLB == 4) { sb2 = GSRC_B(kt, 2); sb3 = GSRC_B(kt, 3); } } while (0)
#define REG_WRITE(buf) do { LDST_A(buf, 0) = sa0; LDST_A(buf, 1) = sa1; LDST_A(buf, 2) = sa2; LDST_A(buf, 3) = sa3; \
      LDST_B(buf, 0) = sb0; LDST_B(buf, 1) = sb1; if constexpr (GLB == 4) { LDST_B(buf, 2) = sb2; LDST_B(buf, 3) = sb3; } } while (0)
    REG_ISSUE(0); REG_WRITE(0); REG_ISSUE(1); __syncthreads();
    for (int t = 0; t < nt; ++t) {
      const int cur = t & 1;
      if (t + 1 < nt) REG_WRITE(cur ^ 1);
      if (t + 2 < nt) REG_ISSUE(t + 2);
      COMPUTE(cur);
      __syncthreads();
    }
#undef REG_ISSUE
#undef REG_WRITE
#endif
#undef COMPUTE
#undef LOADF
#undef MMAS
#undef GLDS_STAGE
    epi(acc, brow + wr * 128 + fr, bcol + wc * (BN / 4) + fq * 4);
  }
  __syncthreads();
}

struct EpiSqRelu {
  bf16_t* O;
  template <int NF> __device__ __forceinline__ void operator()(const f32x4 (&acc)[8][NF], int row0, int col0) const {
#pragma unroll
    for (int m = 0; m < 8; ++m)
#pragma unroll
      for (int n = 0; n < NF; ++n) {
        f32x4 v = acc[m][n];
        float a0 = fmaxf(v[0], 0.f), a1 = fmaxf(v[1], 0.f), a2 = fmaxf(v[2], 0.f), a3 = fmaxf(v[3], 0.f);
        uint2 pk; pk.x = cvt_pk_bf16(a0 * a0, a1 * a1); pk.y = cvt_pk_bf16(a2 * a2, a3 * a3);
        *(uint2*)(O + (size_t)(row0 + 16 * m) * DFF + col0 + 16 * n) = pk;
      }
  }
};
struct EpiResid {
  float* X; const float* gate;
  template <int NF> __device__ __forceinline__ void operator()(const f32x4 (&acc)[8][NF], int row0, int col0) const {
    const float* gp = gate + cond_of_row(row0) * 6144;
#pragma unroll
    for (int n = 0; n < NF; ++n) {
      const f32x4 gv = *(const f32x4*)(gp + col0 + 16 * n);
#pragma unroll
      for (int m = 0; m < 8; ++m) {
        float* xp = X + (size_t)(row0 + 16 * m) * D + col0 + 16 * n;
        f32x4 o = *(f32x4*)xp; o += acc[m][n] * gv; *(f32x4*)xp = o;
      }
    }
  }
};
struct EpiGlu {
  float* X; const float* gate; const float* bias;
  template <int NF> __device__ __forceinline__ void operator()(const f32x4 (&acc)[8][NF], int row0, int col0) const {
    const float* gp = gate + cond_of_row(row0) * 6144;
    const int col = (col0 >> 7) * 64 + ((col0 >> 5) & 3) * 16 + (col0 & 15);
    const f32x4 gv = *(const f32x4*)(gp + col);
    const f32x4 ba = *(const f32x4*)(bias + col), bg = *(const f32x4*)(bias + 1024 + col);
#pragma unroll
    for (int m = 0; m < 8; ++m) {
      float* xp = X + (size_t)(row0 + 16 * m) * D + col;
      f32x4 a = acc[m][0] + ba, g = acc[m][1] + bg;
      f32x4 o = *(f32x4*)xp;
#pragma unroll
      for (int i = 0; i < 4; ++i) { float s = 1.f / (1.f + __expf(-g[i])); o[i] += gv[i] * a[i] * s; }
      *(f32x4*)xp = o;
    }
  }
};
struct EpiQkv {
  bf16_t* QK; int nqk; bf16_t* VT; int C; float* newv;
  template <int NF> __device__ __forceinline__ void operator()(const f32x4 (&acc)[8][NF], int row0, int col0) const {
    if (col0 < nqk) {
#pragma unroll
      for (int m = 0; m < 8; ++m)
#pragma unroll
        for (int n = 0; n < NF; ++n) {
          f32x4 v = acc[m][n];
          uint2 pk; pk.x = cvt_pk_bf16(v[0], v[1]); pk.y = cvt_pk_bf16(v[2], v[3]);
          *(uint2*)(QK + (size_t)(row0 + 16 * m) * nqk + col0 + 16 * n) = pk;
        }
    } else {
      const int vc0 = col0 - nqk;
#pragma unroll
      for (int m = 0; m < 8; ++m) {
        const int row = row0 + 16 * m;
        size_t vbase; int ldv;
        if (row < 4096) { vbase = (size_t)(row >> 8) * C * 256 + (row & 255); ldv = 256; }
        else { const int r2 = row - 4096; vbase = (size_t)4096 * C + (size_t)(r2 >> 10) * C * 1024 + (r2 & 1023); ldv = 1024; }
#pragma unroll
        for (int n = 0; n < NF; ++n) {
          const int col = vc0 + 16 * n;
          f32x4 v = acc[m][n];
#pragma unroll
          for (int i = 0; i < 4; ++i) VT[vbase + (size_t)(col + i) * ldv] = f2bf(v[i]);
          if (row < 4096) *(f32x4*)(newv + (size_t)row * C + col) = v;
        }
      }
    }
  }
};

__device__ void conv_job(const Params& p, int job, const float*& src, bf16_t*& dst, int& K, int& N, int& perm) {
  unsigned char* ws = p.ws; perm = 0;
  if (job < 4) { src = p.in[12] + (size_t)job * 1024 * 4096; dst = (bf16_t*)(ws + WS_W1T) + (size_t)job * 4096 * 1024; K = 1024; N = 4096; }
  else if (job < 8) { int l = job - 4; src = p.in[13] + (size_t)l * 4096 * 1024; dst = (bf16_t*)(ws + WS_W2T) + (size_t)l * 1024 * 4096; K = 4096; N = 1024; }
  else if (job < 10) { int s = job - 8; src = p.in[22] + (size_t)s * 1024 * 2048; dst = (bf16_t*)(ws + WS_GLUT) + (size_t)s * 2048 * 1024; K = 1024; N = 2048; perm = 1; }
  else if (job == 10) { src = p.in[24]; dst = (bf16_t*)(ws + WS_NAQKVT); K = 1024; N = 3072; }
  else if (job == 11) { src = p.in[28]; dst = (bf16_t*)(ws + WS_NAOT); K = 1024; N = 1024; }
  else if (job == 12) { src = p.in[29]; dst = (bf16_t*)(ws + WS_GQAQKVT); K = 1024; N = 1536; }
  else if (job == 13) { src = p.in[32]; dst = (bf16_t*)(ws + WS_GQAOT); K = 1024; N = 1024; }
  else if (job < 18) { int b = job - 14; src = p.in[4] + (size_t)b * 512 * 1024; dst = (bf16_t*)(ws + WS_CVTNA) + (size_t)b * 1024 * 512; K = 512; N = 1024; }
  else { int b = job - 18; src = p.in[6] + (size_t)b * 512 * 256; dst = (bf16_t*)(ws + WS_CVTGQA) + (size_t)b * 256 * 512; K = 512; N = 256; }
}

__device__ void do_transposes(const Params& p, int job_lo, int job_hi);
__device__ void phase_prologue(const Params& p) {
  const int tid = opaque_tid(), G = gridDim.x;
  unsigned char* ws = p.ws;
  float* MOD = (float*)(ws + WS_MOD);
  {
    float* sl = (float*)smem;
    float* red = (float*)smem + 5 * 1024;
    bool have = false;
    for (int it = blockIdx.x; it < 192; it += G) {
      if (!have) {
        for (int i = tid; i < 5 * 1024; i += NT) {
          int c = i >> 10, k = i & 1023;
          float v = (c == 0) ? p.in[8][k] : p.in[7][(c - 1) * 1024 + k];
          sl[i] = v / (1.f + __expf(-v));
        }
        have = true;
      }
      __syncthreads();
      const int layer = it / 48, col0 = (it % 48) * 128;
      const int cg4 = tid & 31, ksl = tid >> 5;
      const float* wp = p.in[10] + (size_t)layer * 1024 * 6144 + col0 + cg4 * 4;
      f32x4 a[5];
      for (int c = 0; c < 5; ++c) a[c] = (f32x4){0.f, 0.f, 0.f, 0.f};
#pragma unroll 8
      for (int kk = 0; kk < 64; ++kk) {
        const int k = ksl * 64 + kk;
        const f32x4 w = __builtin_nontemporal_load((const f32x4*)(wp + (size_t)k * 6144));
        for (int c = 0; c < 5; ++c) a[c] += w * sl[c * 1024 + k];
      }
      for (int c = 0; c < 5; ++c) *(f32x4*)(red + (ksl * 5 + c) * 128 + cg4 * 4) = a[c];
      __syncthreads();
      for (int o = tid; o < 640; o += NT) {
        const int c = o >> 7, col = o & 127;
        float s = p.in[11][layer * 6144 + col0 + col];
        for (int k2 = 0; k2 < 16; ++k2) s += red[(k2 * 5 + c) * 128 + col];
        MOD[(layer * 5 + c) * 6144 + col0 + col] = s;
      }
      __syncthreads();
    }
    __syncthreads();
  }
  {
    float* S5A = (float*)(ws + WS_S5A);
    bf16_t* BB = (bf16_t*)(ws + WS_S5BB);
    bf16_t* CM = (bf16_t*)(ws + WS_S5CM);
    for (int it = (blockIdx.x + 64) % G; it < 256; it += G) {
      const int sdg = it;
      const int g = it & 63;
      const float dt = expf(p.in[16][sdg]);
      for (int idx = tid; idx < 1024; idx += NT) {
        const int pp = idx >> 4, ch = idx & 15;
        const float lr = p.in[14][sdg * 64 + pp], li = p.in[15][sdg * 64 + pp];
        const float ar = lr * dt, ai = li * dt;
        const float mag = expf(ar), cs = cosf(ai), sn = sinf(ai), sh = sinf(0.5f * ai);
        const float abr = mag * cs, abi = mag * sn;
        const float nr = expm1f(ar) * cs - 2.f * sh * sh, ni = abi;
        const float den = lr * lr + li * li;
        const float fre = (nr * lr + ni * li) / den, fim = (ni * lr - nr * li) / den;
        const float br = p.in[17][(sdg * 64 + pp) * 16 + ch], bi = p.in[18][(sdg * 64 + pp) * 16 + ch];
        const float bbr = fre * br - fim * bi, bbi = fre * bi + fim * br;
        BB[((size_t)sdg * 128 + pp) * 16 + ch] = f2bf(bbr);
        BB[((size_t)sdg * 128 + 64 + pp) * 16 + ch] = f2bf(bbi);
        const float cr = p.in[19][(sdg * 16 + ch) * 64 + pp], ci = p.in[20][(sdg * 16 + ch) * 64 + pp];
        const int q = pp & 31, s2 = (pp >> 5) * 2;
        CM[((size_t)sdg * 16 + ch) * 128 + 4 * q + s2] = f2bf(cr);
        CM[((size_t)sdg * 16 + ch) * 128 + 4 * q + s2 + 1] = f2bf(-ci);
        if (ch == 0) { S5A[(sdg * 64 + pp) * 2] = abr; S5A[(sdg * 64 + pp) * 2 + 1] = abi; }
      }
      (void)g;
    }
  }
  {
    const size_t n1 = 4 * 512 * 1024 / 4, n2 = 4 * 512 * 256 / 4;
    uint2* d1 = (uint2*)(ws + WS_CKNA); uint2* d2 = (uint2*)(ws + WS_CKGQA);
    const f32x4* s1 = (const f32x4*)p.in[3]; const f32x4* s2 = (const f32x4*)p.in[5];
    for (size_t i = (size_t)blockIdx.x * NT + tid; i < n1 + n2; i += (size_t)G * NT) {
      f32x4 v = (i < n1) ? s1[i] : s2[i - n1];
      uint2 pk; pk.x = cvt_pk_bf16(v[0], v[1]); pk.y = cvt_pk_bf16(v[2], v[3]);
      if (i < n1) d1[i] = pk; else d2[i - n1] = pk;
    }
  }
  do_transposes(p, 0, 22);
}

__device__ void do_transposes(const Params& p, int job_lo, int job_hi) {
  const int tid = opaque_tid(), G = gridDim.x;
  {
    bf16_t* T = (bf16_t*)smem;
    int base = 0;
    for (int job = job_lo; job < job_hi; ++job) {
      const float* src; bf16_t* dst; int K, N, perm;
      conv_job(p, job, src, dst, K, N, perm);
      const int tn = N >> 8, ntile = (K >> 6) * tn;
      const int start = (int)(((long)blockIdx.x - (base % G) + G) % G);
      const int n4 = tid & 63, kr0 = tid >> 6;
      f32x4 v[8];
      if (start < ntile) {
        const int k0 = (start / tn) << 6, n0 = (start % tn) << 8;
#pragma unroll
        for (int ps = 0; ps < 8; ++ps) v[ps] = __builtin_nontemporal_load((const f32x4*)(src + (size_t)(k0 + 8 * kr0 + ps) * N + n0 + n4 * 4));
      }
      for (int tile = start; tile < ntile; tile += G) {
        const int k0 = (tile / tn) << 6, n0 = (tile % tn) << 8;
        __syncthreads();
#pragma unroll
        for (int i = 0; i < 4; ++i) {
          uint4 w;
          w.x = cvt_pk_bf16(v[0][i], v[1][i]); w.y = cvt_pk_bf16(v[2][i], v[3][i]);
          w.z = cvt_pk_bf16(v[4][i], v[5][i]); w.w = cvt_pk_bf16(v[6][i], v[7][i]);
          *(uint4*)(T + (n4 * 4 + i) * 72 + 8 * kr0) = w;
        }
        if (tile + G < ntile) {
          const int k1 = ((tile + G) / tn) << 6, n1 = ((tile + G) % tn) << 8;
#pragma unroll
          for (int ps = 0; ps < 8; ++ps) v[ps] = __builtin_nontemporal_load((const f32x4*)(src + (size_t)(k1 + 8 * kr0 + ps) * N + n1 + n4 * 4));
        }
        __syncthreads();
#pragma unroll
        for (int q = 0; q < 4; ++q) {
          const int n = (tid >> 3) + 64 * q, kc = tid & 7;
          const uint4 o = *(const uint4*)(T + n * 72 + kc * 8);
          int dr = n0 + n;
          if (perm) { const int isg = dr >= 1024, c1 = dr & 1023; dr = (c1 >> 6) * 128 + ((c1 >> 4) & 3) * 32 + (c1 & 15) + isg * 16; }
          *(uint4*)(dst + (size_t)dr * K + k0 + kc * 8) = o;
        }
      }
      base += ntile;
    }
    __syncthreads();
  }
}

__device__ void phase_norm(const Params& p, int layer, int which, bool first) {
  const int tid_ = opaque_tid(); const int lane = tid_ & 63, wave = tid_ >> 6;
  const float* MOD = (const float*)(p.ws + WS_MOD);
  bf16_t* HB = (bf16_t*)(p.ws + WS_HB);
  const float* gw = p.in[9] + (layer * 2 + which) * 1024;
  for (int row0 = (blockIdx.x * 8 + wave) * 4; row0 < NTOK; row0 += gridDim.x * 32) {
    f32x4 v[4][4]; float ss[4];
#pragma unroll
    for (int r = 0; r < 4; ++r) {
      const int row = row0 + r;
      const float* xr = first ? (row < 4096 ? p.in[0] + (size_t)row * D : p.in[1] + (size_t)(row - 4096) * D) : p.out + (size_t)row * D;
#pragma unroll
      for (int i = 0; i < 4; ++i) v[r][i] = *(const f32x4*)(xr + i * 256 + lane * 4);
    }
#pragma unroll
    for (int r = 0; r < 4; ++r) {
      float s = 0.f;
#pragma unroll
      for (int i = 0; i < 4; ++i) s += v[r][i][0] * v[r][i][0] + v[r][i][1] * v[r][i][1] + v[r][i][2] * v[r][i][2] + v[r][i][3] * v[r][i][3];
      ss[r] = s;
    }
#pragma unroll
    for (int o = 32; o > 0; o >>= 1) {
#pragma unroll
      for (int r = 0; r < 4; ++r) ss[r] += __shfl_xor(ss[r], o);
    }
    const float* mp = MOD + (layer * 5 + cond_of_row(row0)) * 6144 + which * 3072;
#pragma unroll
    for (int i = 0; i < 4; ++i) {
      const int col = i * 256 + lane * 4;
      const f32x4 gv = *(const f32x4*)(gw + col), sh = *(const f32x4*)(mp + col), sc = *(const f32x4*)(mp + 1024 + col);
#pragma unroll
      for (int r = 0; r < 4; ++r) {
        const int row = row0 + r;
        const float rstd = rsqrtf(ss[r] * (1.f / 1024.f) + 1e-6f);
        if (first) *(f32x4*)(p.out + (size_t)row * D + col) = v[r][i];
        float o[4];
#pragma unroll
        for (int j = 0; j < 4; ++j) o[j] = v[r][i][j] * rstd * gv[j] * (1.f + sc[j]) + sh[j];
        uint2 pk; pk.x = cvt_pk_bf16(o[0], o[1]); pk.y = cvt_pk_bf16(o[2], o[3]);
        *(uint2*)(HB + (size_t)row * D + col) = pk;
      }
    }
  }
}

__device__ __forceinline__ int s5_tok(int rho) { return 16 * ((rho >> 2) & 1) + (rho & 3) + 4 * (rho >> 3); }
__device__ __forceinline__ cplx shfl_c(cplx v, int src) { cplx r; r.re = __shfl(v.re, src); r.im = __shfl(v.im, src); return r; }

__device__ void phase_s5_pass1(const Params& p, int slot) {
  const int tid_ = opaque_tid(); const int lane = tid_ & 63, wave = tid_ >> 6, r = lane & 31, H = lane >> 5;
  const bf16_t* HB = (const bf16_t*)(p.ws + WS_HB);
  const float* S5A = (const float*)(p.ws + WS_S5A);
  const bf16_t* BB = (const bf16_t*)(p.ws + WS_S5BB);
  float* E = (float*)(p.ws + WS_S5E);
  const int tokr = s5_tok(r);
  for (int it = blockIdx.x * 8 + wave; it < 128 * 64; it += gridDim.x * 8) {
    const int ck = it >> 6, g = it & 63, tok0 = ck * 64;
    bf16x8 uf[2];
    _Pragma("unroll") for (int tt = 0; tt < 2; ++tt) uf[tt] = *(const bf16x8*)(HB + (size_t)(tok0 + 32 * tt + tokr) * D + g * 16 + 8 * H);
    _Pragma("unroll") for (int dir = 0; dir < 2; ++dir) {
      const int sdg = (slot * 2 + dir) * 64 + g;
      cplx a0 = {S5A[(sdg * 64 + r) * 2], S5A[(sdg * 64 + r) * 2 + 1]};
      cplx a1 = {S5A[(sdg * 64 + r + 32) * 2], S5A[(sdg * 64 + r + 32) * 2 + 1]};
      cplx a0_16 = a0, a1_16 = a1;
      _Pragma("unroll") for (int i = 0; i < 4; ++i) { a0_16 = cmul(a0_16, a0_16); a1_16 = cmul(a1_16, a1_16); }
      const cplx a0_32 = cmul(a0_16, a0_16), a1_32 = cmul(a1_16, a1_16);
      bf16x8 bfr[4];
      _Pragma("unroll") for (int ct = 0; ct < 4; ++ct) bfr[ct] = *(const bf16x8*)(BB + ((size_t)sdg * 128 + 32 * ct + r) * 16 + 8 * H);
      cplx E0 = {0.f, 0.f}, E1 = {0.f, 0.f};
      _Pragma("unroll") for (int t2 = 0; t2 < 2; ++t2) {
        const int tt = dir ? 1 - t2 : t2;
        f32x16 acc[4];
        bu_mfma4(acc[0], acc[1], acc[2], acc[3], uf[tt], bfr[0], bfr[1], bfr[2], bfr[3]);
        cplx e0 = {0.f, 0.f}, e1 = {0.f, 0.f};
        if (dir == 0) {
          _Pragma("unroll") for (int i = 0; i < 16; ++i) { e0 = cfma(a0, e0, (cplx){acc[0][i], acc[2][i]}); e1 = cfma(a1, e1, (cplx){acc[1][i], acc[3][i]}); }
        } else {
          _Pragma("unroll") for (int i = 15; i >= 0; --i) { e0 = cfma(a0, e0, (cplx){acc[0][i], acc[2][i]}); e1 = cfma(a1, e1, (cplx){acc[1][i], acc[3][i]}); }
        }
        const cplx o0 = shfl_c(e0, lane ^ 32), o1 = shfl_c(e1, lane ^ 32);
        const cplx eL0 = H ? o0 : e0, eU0 = H ? e0 : o0, eL1 = H ? o1 : e1, eU1 = H ? e1 : o1;
        cplx t0, t1;
        if (dir == 0) { t0 = cfma(a0_16, eL0, eU0); t1 = cfma(a1_16, eL1, eU1); }
        else { t0 = cfma(a0_16, eU0, eL0); t1 = cfma(a1_16, eU1, eL1); }
        E0 = cfma(a0_32, E0, t0); E1 = cfma(a1_32, E1, t1);
      }
      const int pp = H ? r + 32 : r;
      const cplx Ev = H ? E1 : E0;
      *(float2*)(E + ((size_t)((ck * 64 + g) * 2 + dir) * 64 + pp) * 2) = make_float2(Ev.re, Ev.im);
    }
  }
}

__device__ void phase_s5_pass2(const Params& p, int slot) {
  const int tid_ = opaque_tid(); const int lane = tid_ & 63, wave = tid_ >> 6, r = lane & 31, H = lane >> 5;
  bf16_t* HB = (bf16_t*)(p.ws + WS_HB);
  const float* S5A = (const float*)(p.ws + WS_S5A);
  const bf16_t* BB = (const bf16_t*)(p.ws + WS_S5BB);
  const bf16_t* CM = (const bf16_t*)(p.ws + WS_S5CM);
  const float* E = (const float*)(p.ws + WS_S5E);
  const float* Dsk = p.in[21] + slot * 1024;
  unsigned char* ldsw = smem + wave * 8704;
  const int tokr = s5_tok(r);
  for (int it = blockIdx.x * 8 + wave; it < 128 * 64; it += gridDim.x * 8) {
    const int ck = it >> 6, g = it & 63, tok0 = ck * 64;
    int c, nc, bq; bool sample;
    if (tok0 < 4096) { bq = tok0 >> 8; c = (tok0 >> 6) & 3; nc = 4; sample = false; }
    else { const int t2 = tok0 - 4096; bq = t2 >> 10; c = (t2 >> 6) & 15; nc = 16; sample = true; }
    const int ck0 = ck - c;
    bf16x8 uf[2];
    _Pragma("unroll") for (int tt = 0; tt < 2; ++tt) uf[tt] = *(const bf16x8*)(HB + (size_t)(tok0 + 32 * tt + tokr) * D + g * 16 + 8 * H);
    f32x4 yacc[2][2];
    _Pragma("unroll") for (int a = 0; a < 2; ++a) _Pragma("unroll") for (int b = 0; b < 2; ++b) yacc[a][b] = (f32x4){0.f, 0.f, 0.f, 0.f};
    _Pragma("unroll") for (int dir = 0; dir < 2; ++dir) {
      const int sdg = (slot * 2 + dir) * 64 + g;
      const cplx a0 = {S5A[(sdg * 64 + r) * 2], S5A[(sdg * 64 + r) * 2 + 1]};
      const cplx a1 = {S5A[(sdg * 64 + r + 32) * 2], S5A[(sdg * 64 + r + 32) * 2 + 1]};
      cplx a0_64 = a0, a1_64 = a1;
      _Pragma("unroll") for (int i = 0; i < 6; ++i) { a0_64 = cmul(a0_64, a0_64); a1_64 = cmul(a1_64, a1_64); }
      cplx c0 = {0.f, 0.f}, c1 = {0.f, 0.f};
      if (sample) {
        const float* h0 = p.in[2] + ((size_t)((bq * 2 + slot) * 2 + dir) * 2) * 4096 + g * 64;
        c0.re = h0[r]; c0.im = h0[4096 + r]; c1.re = h0[r + 32]; c1.im = h0[4096 + r + 32];
      }
      {
        const int ncar = dir ? nc - 1 - c : c;
        for (int j0 = 0; j0 < ncar; j0 += 8) {
          float2 va[8], vb[8];
#pragma unroll
          for (int j = 0; j < 8; ++j) {
            const int jj = min(j0 + j, ncar - 1);
            const int cc = dir ? nc - 1 - jj : jj;
            const float* ep = E + ((size_t)(((ck0 + cc) * 64 + g) * 2 + dir) * 64) * 2;
            va[j] = *(const float2*)(ep + r * 2); vb[j] = *(const float2*)(ep + (r + 32) * 2);
          }
#pragma unroll
          for (int j = 0; j < 8; ++j) if (j0 + j < ncar) {
            c0 = cfma(a0_64, c0, (cplx){va[j].x, va[j].y}); c1 = cfma(a1_64, c1, (cplx){vb[j].x, vb[j].y});
          }
        }
      }
      bf16x8 bfr[4], cfr[4];
      _Pragma("unroll") for (int ct = 0; ct < 4; ++ct) bfr[ct] = *(const bf16x8*)(BB + ((size_t)sdg * 128 + 32 * ct + r) * 16 + 8 * H);
      _Pragma("unroll") for (int ks = 0; ks < 4; ++ks) cfr[ks] = *(const bf16x8*)(CM + ((size_t)sdg * 16 + (lane & 15)) * 128 + 32 * ks + 8 * (lane >> 4));
      _Pragma("unroll") for (int t2 = 0; t2 < 2; ++t2) {
        const int tt = dir ? 1 - t2 : t2;
        f32x16 acc[4];
        bu_mfma4(acc[0], acc[1], acc[2], acc[3], uf[tt], bfr[0], bfr[1], bfr[2], bfr[3]);
        const int firstH = dir;
        cplx h0 = c0, h1 = c1;
        if (H == firstH) {
          if (dir == 0) { _Pragma("unroll") for (int i = 0; i < 16; ++i) { h0 = cfma(a0, h0, (cplx){acc[0][i], acc[2][i]}); h1 = cfma(a1, h1, (cplx){acc[1][i], acc[3][i]});
                            acc[0][i] = h0.re; acc[2][i] = h0.im; acc[1][i] = h1.re; acc[3][i] = h1.im; } }
          else { _Pragma("unroll") for (int i = 15; i >= 0; --i) { h0 = cfma(a0, h0, (cplx){acc[0][i], acc[2][i]}); h1 = cfma(a1, h1, (cplx){acc[1][i], acc[3][i]});
                            acc[0][i] = h0.re; acc[2][i] = h0.im; acc[1][i] = h1.re; acc[3][i] = h1.im; } }
        }
        h0 = shfl_c(h0, r + 32 * firstH); h1 = shfl_c(h1, r + 32 * firstH);
        if (H != firstH) {
          if (dir == 0) { _Pragma("unroll") for (int i = 0; i < 16; ++i) { h0 = cfma(a0, h0, (cplx){acc[0][i], acc[2][i]}); h1 = cfma(a1, h1, (cplx){acc[1][i], acc[3][i]});
                            acc[0][i] = h0.re; acc[2][i] = h0.im; acc[1][i] = h1.re; acc[3][i] = h1.im; } }
          else { _Pragma("unroll") for (int i = 15; i >= 0; --i) { h0 = cfma(a0, h0, (cplx){acc[0][i], acc[2][i]}); h1 = cfma(a1, h1, (cplx){acc[1][i], acc[3][i]});
                            acc[0][i] = h0.re; acc[2][i] = h0.im; acc[1][i] = h1.re; acc[3][i] = h1.im; } }
        }
        if (!sample && t2 == 1 && ((dir == 0 && c == nc - 1) || (dir == 1 && c == 0)) && H != firstH) {
          float* so = p.out + OUT_S5 + ((size_t)((bq * 2 + slot) * 2 + dir) * 2) * 4096 + g * 64;
          so[r] = h0.re; so[4096 + r] = h0.im; so[r + 32] = h1.re; so[4096 + r + 32] = h1.im;
        }
        c0 = shfl_c(h0, r + 32 * (1 - firstH)); c1 = shfl_c(h1, r + 32 * (1 - firstH));
        _Pragma("unroll") for (int i = 0; i < 16; ++i) {
          uint2 pk; pk.x = cvt_pk_bf16(acc[0][i], acc[2][i]); pk.y = cvt_pk_bf16(acc[1][i], acc[3][i]);
          *(uint2*)(ldsw + (16 * H + i) * 272 + 8 * r) = pk;
        }
        asm volatile("s_waitcnt lgkmcnt(0)" ::: "memory");
        _Pragma("unroll") for (int rt = 0; rt < 2; ++rt) _Pragma("unroll") for (int ks = 0; ks < 4; ++ks) {
          const bf16x8 af = *(const bf16x8*)(ldsw + (16 * rt + (lane & 15)) * 272 + (32 * ks + 8 * (lane >> 4)) * 2);
          yacc[tt][rt] = __builtin_amdgcn_mfma_f32_16x16x32_bf16(af, cfr[ks], yacc[tt][rt], 0, 0, 0);
        }
        asm volatile("s_waitcnt lgkmcnt(0)" ::: "memory");
      }
    }
    asm volatile("s_nop 15" : "+v"(yacc[0][0]), "+v"(yacc[0][1]), "+v"(yacc[1][0]), "+v"(yacc[1][1]));
    const int ch = lane & 15, col = g * 16 + ch;
    const float dsk = Dsk[col];
    _Pragma("unroll") for (int tt = 0; tt < 2; ++tt) _Pragma("unroll") for (int rt = 0; rt < 2; ++rt) _Pragma("unroll") for (int j = 0; j < 4; ++j) {
      const int token = tok0 + 32 * tt + 16 * rt + 4 * (lane >> 4) + j;
      bf16_t* hp = HB + (size_t)token * D + col;
      const float u = bf2f(*hp);
      const float y = yacc[tt][rt][j] + u * dsk;
      const float z = 0.7978845608028654f * (y + 0.044715f * y * y * y);
      const float th = 1.f - 2.f / (__expf(2.f * z) + 1.f);
      *hp = f2bf(0.5f * y * (1.f + th));
    }
  }
}

constexpr float LOG2E = 1.4426950408889634f;

__device__ void phase_post_na(const Params& p) {
  const int tid_ = opaque_tid(); const int lane = tid_ & 63, wave = tid_ >> 6;
  bf16_t* QK = (bf16_t*)(p.ws + WS_QK);
  const float* qn = p.in[25]; const float* kn = p.in[26];
  const float qs = 0.125f * LOG2E;
  const int d0 = (lane & 3) * 16;
  for (int row = blockIdx.x * 8 + wave; row < NTOK; row += gridDim.x * 8) {
    _Pragma("unroll") for (int part = 0; part < 2; ++part) {
      bf16_t* ptr = QK + (size_t)row * 2048 + part * 1024 + lane * 16;
      uint4 a = *(uint4*)ptr, b = *(uint4*)(ptr + 8);
      unsigned w[8] = {a.x, a.y, a.z, a.w, b.x, b.y, b.z, b.w};
      float v[16]; float ss = 0.f;
      _Pragma("unroll") for (int i = 0; i < 8; ++i) { v[2 * i] = bflo(w[i]); v[2 * i + 1] = bfhi(w[i]); }
      _Pragma("unroll") for (int i = 0; i < 16; ++i) ss += v[i] * v[i];
      ss += __shfl_xor(ss, 1); ss += __shfl_xor(ss, 2);
      const float rstd = rsqrtf(ss * (1.f / 64.f) + 1e-6f);
      const float* nw = part ? kn : qn;
      const float sc = part ? 1.f : qs;
      float o[16];
      _Pragma("unroll") for (int i = 0; i < 16; ++i) o[i] = v[i] * rstd * nw[d0 + i];
      if (part == 1 && row < 4096) {
        float* op = p.out + OUT_NAK + (size_t)row * 1024 + lane * 16;
        _Pragma("unroll") for (int i = 0; i < 4; ++i) *(f32x4*)(op + 4 * i) = (f32x4){o[4 * i], o[4 * i + 1], o[4 * i + 2], o[4 * i + 3]};
      }
      _Pragma("unroll") for (int i = 0; i < 8; ++i) w[i] = cvt_pk_bf16(o[2 * i] * sc, o[2 * i + 1] * sc);
      *(uint4*)ptr = make_uint4(w[0], w[1], w[2], w[3]); *(uint4*)(ptr + 8) = make_uint4(w[4], w[5], w[6], w[7]);
    }
  }
}

__device__ void phase_post_gqa(const Params& p) {
  const int tid_ = opaque_tid(); const int lane = tid_ & 63, wave = tid_ >> 6;
  bf16_t* QK = (bf16_t*)(p.ws + WS_QK);
  const float* qn = p.in[30]; const float* kn = p.in[31];
  const float qs = 0.08838834764831845f * LOG2E;
  for (int row = blockIdx.x * 8 + wave; row < NTOK; row += gridDim.x * 8) {
    const bool sample = row >= 4096;
    const int t = (row - 4096) & 1023;
    const float prow = (float)(t >> 6), pcol = (float)(t & 63);
    {
      const int i0 = (lane & 7) * 8;
      bf16_t* ptr = QK + (size_t)row * 1280 + (lane >> 3) * 128 + i0;
      uint4 a = *(uint4*)ptr, b = *(uint4*)(ptr + 64);
      unsigned wa[4] = {a.x, a.y, a.z, a.w}, wb[4] = {b.x, b.y, b.z, b.w};
      float x1[8], x2[8]; float ss = 0.f;
      _Pragma("unroll") for (int i = 0; i < 4; ++i) { x1[2 * i] = bflo(wa[i]); x1[2 * i + 1] = bfhi(wa[i]); x2[2 * i] = bflo(wb[i]); x2[2 * i + 1] = bfhi(wb[i]); }
      _Pragma("unroll") for (int i = 0; i < 8; ++i) ss += x1[i] * x1[i] + x2[i] * x2[i];
      ss += __shfl_xor(ss, 1); ss += __shfl_xor(ss, 2); ss += __shfl_xor(ss, 4);
      const float rstd = rsqrtf(ss * (1.f / 128.f) + 1e-6f);
      _Pragma("unroll") for (int i = 0; i < 8; ++i) { x1[i] *= rstd * qn[i0 + i]; x2[i] *= rstd * qn[64 + i0 + i]; }
      if (sample) {
        _Pragma("unroll") for (int i = 0; i < 8; ++i) {
          const int pi = i0 + i;
          const float inv = exp2f(-(float)(pi & 31) * (13.287712379549449f / 32.f));
          const float ang = (pi < 32 ? prow : pcol) * inv;
          const float cs = cosf(ang), sn = sinf(ang);
          const float y1 = x1[i] * cs - x2[i] * sn, y2 = x1[i] * sn + x2[i] * cs;
          x1[i] = y1; x2[i] = y2;
        }
      }
      _Pragma("unroll") for (int i = 0; i < 4; ++i) { wa[i] = cvt_pk_bf16(x1[2 * i] * qs, x1[2 * i + 1] * qs); wb[i] = cvt_pk_bf16(x2[2 * i] * qs, x2[2 * i + 1] * qs); }
      *(uint4*)ptr = make_uint4(wa[0], wa[1], wa[2], wa[3]); *(uint4*)(ptr + 64) = make_uint4(wb[0], wb[1], wb[2], wb[3]);
    }
    {
      const int i0 = (lane & 31) * 2;
      bf16_t* ptr = QK + (size_t)row * 1280 + 1024 + (lane >> 5) * 128 + i0;
      unsigned wa = *(unsigned*)ptr, wb = *(unsigned*)(ptr + 64);
      float x1[2] = {bflo(wa), bfhi(wa)}, x2[2] = {bflo(wb), bfhi(wb)};
      float ss = x1[0] * x1[0] + x1[1] * x1[1] + x2[0] * x2[0] + x2[1] * x2[1];
      _Pragma("unroll") for (int o = 1; o < 32; o <<= 1) ss += __shfl_xor(ss, o);
      const float rstd = rsqrtf(ss * (1.f / 128.f) + 1e-6f);
      _Pragma("unroll") for (int i = 0; i < 2; ++i) { x1[i] *= rstd * kn[i0 + i]; x2[i] *= rstd * kn[64 + i0 + i]; }
      if (!sample) {
        float* op = p.out + OUT_GQAK + (size_t)row * 256 + (lane >> 5) * 128 + i0;
        *(float2*)op = make_float2(x1[0], x1[1]); *(float2*)(op + 64) = make_float2(x2[0], x2[1]);
      } else {
        _Pragma("unroll") for (int i = 0; i < 2; ++i) {
          const int pi = i0 + i;
          const float inv = exp2f(-(float)(pi & 31) * (13.287712379549449f / 32.f));
          const float ang = (pi < 32 ? prow : pcol) * inv;
          const float cs = cosf(ang), sn = sinf(ang);
          const float y1 = x1[i] * cs - x2[i] * sn, y2 = x1[i] * sn + x2[i] * cs;
          x1[i] = y1; x2[i] = y2;
        }
      }
      *(unsigned*)ptr = cvt_pk_bf16(x1[0], x1[1]); *(unsigned*)(ptr + 64) = cvt_pk_bf16(x2[0], x2[1]);
    }
  }
}

template <int DH, bool NAL>
__device__ __forceinline__ void attn_wave(const bf16_t* Q, int ldq,
                                          const bf16_t* K0, int ldk0, const bf16_t* V0, int ldv0, int n0,
                                          const bf16_t* K1, int ldk1, const bf16_t* V1, int ldv1, int n1,
                                          bf16_t* O, int ldo, const float* rpb_h, int rr, int rs, int qc0) {
  constexpr int KS = DH / 32, DT = DH / 16;
  const int lane = opaque_tid() & 63, fr = lane & 15, g = lane >> 4;
  bf16x8 qf[2][KS];
  _Pragma("unroll") for (int qg = 0; qg < 2; ++qg) _Pragma("unroll") for (int ks = 0; ks < KS; ++ks) qf[qg][ks] = *(const bf16x8*)(Q + (size_t)(qg * 16 + fr) * ldq + ks * 32 + 8 * g);
  f32x4 o[2][DT];
  _Pragma("unroll") for (int qg = 0; qg < 2; ++qg) _Pragma("unroll") for (int dt = 0; dt < DT; ++dt) o[qg][dt] = (f32x4){0.f, 0.f, 0.f, 0.f};
  float lsum[2] = {0.f, 0.f};
  const int krow_in = 8 * (fr >> 2) + (fr & 3);
  const int nch = (n0 + n1) >> 5;
  for (int c = 0; c < nch; ++c) {
    const bool s1 = (c * 32 >= n0);
    const int kc = s1 ? c * 32 - n0 : c * 32;
    const bf16_t* K = s1 ? K1 : K0; const int ldk = s1 ? ldk1 : ldk0;
    const bf16_t* V = s1 ? V1 : V0; const int ldv = s1 ? ldv1 : ldv0;
    bf16x8 kf[2][KS], vf[DT];
    _Pragma("unroll") for (int t = 0; t < 2; ++t) _Pragma("unroll") for (int ks = 0; ks < KS; ++ks) kf[t][ks] = *(const bf16x8*)(K + (size_t)(kc + krow_in + 4 * t) * ldk + ks * 32 + 8 * g);
    _Pragma("unroll") for (int dt = 0; dt < DT; ++dt) vf[dt] = *(const bf16x8*)(V + (size_t)(16 * dt + fr) * ldv + kc + 8 * g);
    f32x4 s[2][2];
    _Pragma("unroll") for (int qg = 0; qg < 2; ++qg) _Pragma("unroll") for (int t = 0; t < 2; ++t) {
      s[qg][t] = (f32x4){0.f, 0.f, 0.f, 0.f};
      _Pragma("unroll") for (int ks = 0; ks < KS; ++ks) s[qg][t] = __builtin_amdgcn_mfma_f32_16x16x32_bf16(kf[t][ks], qf[qg][ks], s[qg][t], 0, 0, 0);
    }
    asm volatile("s_nop 15" : "+v"(s[0][0]), "+v"(s[0][1]), "+v"(s[1][0]), "+v"(s[1][1]));
    bf16x8 pf[2];
    _Pragma("unroll") for (int qg = 0; qg < 2; ++qg) {
      float pv[8];
      _Pragma("unroll") for (int i = 0; i < 8; ++i) {
        float sv = s[qg][i >> 2][i & 3];
        if (NAL && !s1) {
          const int krow = rs + (kc >> 6), kcol = (kc & 63) + 8 * g + i;
          const int qc = qc0 + qg * 16 + fr;
          const int cs = min(max(qc - 8, 0), 48);
          const bool valid = (kcol >= cs) && (kcol < cs + 16);
          const int bi = valid ? (krow - rr + 7) * 31 + (kcol - qc + 15) : 0;
          const float bias = rpb_h[bi];
          pv[i] = valid ? __builtin_amdgcn_exp2f(sv + bias * LOG2E) : 0.f;
        } else {
          pv[i] = __builtin_amdgcn_exp2f(sv);
        }
        lsum[qg] += pv[i];
      }
      union { bf16x8 v; unsigned u[4]; } pk;
      _Pragma("unroll") for (int i = 0; i < 4; ++i) pk.u[i] = cvt_pk_bf16(pv[2 * i], pv[2 * i + 1]);
      pf[qg] = pk.v;
    }
    asm volatile("s_nop 3" : "+v"(pf[0]), "+v"(pf[1]));
    _Pragma("unroll") for (int qg = 0; qg < 2; ++qg) _Pragma("unroll") for (int dt = 0; dt < DT; ++dt)
      o[qg][dt] = __builtin_amdgcn_mfma_f32_16x16x32_bf16(vf[dt], pf[qg], o[qg][dt], 0, 0, 0);
  }
  _Pragma("unroll") for (int qg = 0; qg < 2; ++qg) _Pragma("unroll") for (int dt = 0; dt < DT; ++dt) asm volatile("s_nop 7" : "+v"(o[qg][dt]));
  _Pragma("unroll") for (int qg = 0; qg < 2; ++qg) {
    float l = lsum[qg];
    l += __shfl_xor(l, 16); l += __shfl_xor(l, 32);
    const float inv = 1.f / l;
    _Pragma("unroll") for (int dt = 0; dt < DT; ++dt) {
      uint2 pk; pk.x = cvt_pk_bf16(o[qg][dt][0] * inv, o[qg][dt][1] * inv); pk.y = cvt_pk_bf16(o[qg][dt][2] * inv, o[qg][dt][3] * inv);
      *(uint2*)(O + (size_t)(qg * 16 + fr) * ldo + 16 * dt + 4 * g) = pk;
    }
  }
}

template <bool NAL>
__device__ __forceinline__ void attn_block_na(const bf16_t* Qw, bf16_t* Ow, const bf16_t* K0, const bf16_t* V0, int ldv0, int nloc,
                                              const bf16_t* K1, const bf16_t* V1, int nctx, const float* rpb_h, int rr, int rs, int urow0, int qc0) {
  constexpr int KS = 2, DT = 4, KROW = 144, VROW = 80, KBUF = 32 * KROW, VBUF = 64 * VROW;
  const int tid = opaque_tid(), lane = tid & 63, fr = lane & 15, g = lane >> 4;
  unsigned char* kS = smem;
  unsigned char* vS = smem + 2 * KBUF;
  bf16x8 qf[2][KS];
  _Pragma("unroll") for (int qg = 0; qg < 2; ++qg) _Pragma("unroll") for (int ks = 0; ks < KS; ++ks) qf[qg][ks] = *(const bf16x8*)(Qw + (size_t)(qg * 16 + fr) * 2048 + ks * 32 + 8 * g);
  f32x4 o[2][DT];
  _Pragma("unroll") for (int qg = 0; qg < 2; ++qg) _Pragma("unroll") for (int dt = 0; dt < DT; ++dt) o[qg][dt] = (f32x4){0.f, 0.f, 0.f, 0.f};
  float lsum[2] = {0.f, 0.f};
  const int krow_in = 8 * (fr >> 2) + (fr & 3);
  const bool isk = tid < 256; const int t2 = tid & 255;
  const int sa = isk ? (t2 >> 3) : (t2 >> 2), sp = isk ? (t2 & 7) : (t2 & 3);
  const int nch = nloc + nctx;
  uint4 rg;
#define LD_CHUNK(c_) do { const int c__ = (c_); const bool loc_ = c__ < nloc; const int cc_ = loc_ ? c__ : c__ - nloc; \
    const bf16_t* kp_ = (loc_ ? K0 + (size_t)(cc_ * 32 + sa) * 2048 : K1 + (size_t)(cc_ * 32 + sa) * 1024) + sp * 8; \
    const bf16_t* vp_ = (loc_ ? V0 + (size_t)sa * ldv0 : V1 + (size_t)sa * 512) + cc_ * 32 + sp * 8; \
    rg = *(const uint4*)(isk ? kp_ : vp_); } while (0)
#define ST_CHUNK(buf_) do { if (isk) *(uint4*)(kS + (buf_) * KBUF + sa * KROW + sp * 16) = rg; else *(uint4*)(vS + (buf_) * VBUF + sa * VROW + sp * 16) = rg; } while (0)
  __syncthreads();
  LD_CHUNK(0); ST_CHUNK(0);
  __syncthreads();
  for (int c = 0; c < nch; ++c) {
    const int buf = c & 1;
    if (c + 1 < nch) LD_CHUNK(c + 1);
    const unsigned char* kb = kS + buf * KBUF; const unsigned char* vb = vS + buf * VBUF;
    bf16x8 kf[2][KS], vf[DT];
    _Pragma("unroll") for (int t = 0; t < 2; ++t) _Pragma("unroll") for (int ks = 0; ks < KS; ++ks) kf[t][ks] = *(const bf16x8*)(kb + (krow_in + 4 * t) * KROW + (ks * 32 + 8 * g) * 2);
    _Pragma("unroll") for (int dt = 0; dt < DT; ++dt) vf[dt] = *(const bf16x8*)(vb + (16 * dt + fr) * VROW + 16 * g);
    f32x4 s[2][2];
    _Pragma("unroll") for (int qg = 0; qg < 2; ++qg) _Pragma("unroll") for (int t = 0; t < 2; ++t) {
      s[qg][t] = (f32x4){0.f, 0.f, 0.f, 0.f};
      _Pragma("unroll") for (int ks = 0; ks < KS; ++ks) s[qg][t] = __builtin_amdgcn_mfma_f32_16x16x32_bf16(kf[t][ks], qf[qg][ks], s[qg][t], 0, 0, 0);
    }
    asm volatile("s_nop 15" : "+v"(s[0][0]), "+v"(s[0][1]), "+v"(s[1][0]), "+v"(s[1][1]));
    bf16x8 pf[2];
    _Pragma("unroll") for (int qg = 0; qg < 2; ++qg) {
      float pv[8];
      _Pragma("unroll") for (int i = 0; i < 8; ++i) {
        const float sv = s[qg][i >> 2][i & 3];
        if (NAL && c < nloc) {
          const int krow = urow0 + (c >> 1), kcol = (c & 1) * 32 + 8 * g + i;
          const int qc = qc0 + qg * 16 + fr;
          const int cs = min(max(qc - 8, 0), 48);
          const bool valid = (krow >= rs) && (krow < rs + 8) && (kcol >= cs) && (kcol < cs + 16);
          const int bi = valid ? (krow - rr + 7) * 31 + (kcol - qc + 15) : 0;
          const float bias = rpb_h[bi];
          pv[i] = valid ? __builtin_amdgcn_exp2f(sv + bias * LOG2E) : 0.f;
        } else {
          pv[i] = __builtin_amdgcn_exp2f(sv);
        }
        lsum[qg] += pv[i];
      }
      union { bf16x8 v; unsigned u[4]; } pk;
      _Pragma("unroll") for (int i = 0; i < 4; ++i) pk.u[i] = cvt_pk_bf16(pv[2 * i], pv[2 * i + 1]);
      pf[qg] = pk.v;
    }
    asm volatile("s_nop 3" : "+v"(pf[0]), "+v"(pf[1]));
    _Pragma("unroll") for (int qg = 0; qg < 2; ++qg) _Pragma("unroll") for (int dt = 0; dt < DT; ++dt)
      o[qg][dt] = __builtin_amdgcn_mfma_f32_16x16x32_bf16(vf[dt], pf[qg], o[qg][dt], 0, 0, 0);
    if (c + 1 < nch) ST_CHUNK(buf ^ 1);
    __syncthreads();
  }
#undef LD_CHUNK
#undef ST_CHUNK
  _Pragma("unroll") for (int qg = 0; qg < 2; ++qg) _Pragma("unroll") for (int dt = 0; dt < DT; ++dt) asm volatile("s_nop 7" : "+v"(o[qg][dt]));
  _Pragma("unroll") for (int qg = 0; qg < 2; ++qg) {
    float l = lsum[qg];
    l += __shfl_xor(l, 16); l += __shfl_xor(l, 32);
    const float inv = 1.f / l;
    _Pragma("unroll") for (int dt = 0; dt < DT; ++dt) {
      uint2 pk; pk.x = cvt_pk_bf16(o[qg][dt][0] * inv, o[qg][dt][1] * inv); pk.y = cvt_pk_bf16(o[qg][dt][2] * inv, o[qg][dt][3] * inv);
      *(uint2*)(Ow + (size_t)(qg * 16 + fr) * 1024 + 16 * dt + 4 * g) = pk;
    }
  }
}

__device__ void phase_attn_na(const Params& p) {
  const int wave = opaque_tid() >> 6;
  const bf16_t* QK = (const bf16_t*)(p.ws + WS_QK);
  const bf16_t* VT = (const bf16_t*)(p.ws + WS_VT);
  const bf16_t* CK = (const bf16_t*)(p.ws + WS_CKNA);
  const bf16_t* CVT = (const bf16_t*)(p.ws + WS_CVTNA);
  bf16_t* AO = (bf16_t*)(p.ws + WS_AO);
  for (int id = blockIdx.x; id < 256; id += gridDim.x) {
    const int k4 = id & 3, h = (id >> 2) & 15, b = id >> 6;
    const int r = k4 * 4 + (wave >> 1), wq = wave & 1;
    const int rs = min(max(r - 4, 0), 8);
    const int urow0 = min(max(k4 * 4 - 4, 0), 8), urow1 = min(max(k4 * 4 + 3 - 4, 0), 8) + 8;
    const int tokq = 4096 + b * 1024 + r * 64 + wq * 32;
    const int tokk = 4096 + b * 1024 + urow0 * 64;
    attn_block_na<true>(QK + (size_t)tokq * 2048 + h * 64, AO + (size_t)tokq * 1024 + h * 64,
                        QK + (size_t)tokk * 2048 + 1024 + h * 64,
                        VT + (size_t)4096 * 1024 + ((size_t)b * 1024 + h * 64) * 1024 + urow0 * 64, 1024, (urow1 - urow0) * 2,
                        CK + (size_t)b * 512 * 1024 + h * 64, CVT + ((size_t)b * 1024 + h * 64) * 512, 16,
                        p.in[27] + h * 15 * 31, r, rs, urow0, wq * 32);
  }
  for (int id = blockIdx.x * 8 + wave; id < 2048; id += gridDim.x * 8) {
    const int qb = id & 7, h = (id >> 3) & 15, b = id >> 7;
    const int tokq = b * 256 + qb * 32;
    attn_wave<64, false>(QK + (size_t)tokq * 2048 + h * 64, 2048,
                         QK + (size_t)(b * 256) * 2048 + 1024 + h * 64, 2048,
                         VT + ((size_t)b * 1024 + h * 64) * 256, 256, 256,
                         nullptr, 0, nullptr, 0, 0,
                         AO + (size_t)tokq * 1024 + h * 64, 1024, nullptr, 0, 0, 0);
  }
}

__device__ __forceinline__ void attn_block_gqa_latent(const bf16_t* Q, const bf16_t* K0, const bf16_t* V0, const bf16_t* K1, const bf16_t* V1, bf16_t* O) {
  constexpr int DH = 128, KS = 4, DT = 8, KROW = 272, VROW = 80, KBUF = 32 * KROW, VBUF = 128 * VROW, NCH = 48;
  const int tid = opaque_tid(), lane = tid & 63, wave = tid >> 6, fr = lane & 15, g = lane >> 4;
  unsigned char* kS = smem;
  unsigned char* vS = smem + 2 * KBUF;
  const bf16_t* Qw = Q + (size_t)(wave * 32) * 1280;
  bf16x8 qf[2][KS];
  _Pragma("unroll") for (int qg = 0; qg < 2; ++qg) _Pragma("unroll") for (int ks = 0; ks < KS; ++ks) qf[qg][ks] = *(const bf16x8*)(Qw + (size_t)(qg * 16 + fr) * 1280 + ks * 32 + 8 * g);
  f32x4 o[2][DT];
  _Pragma("unroll") for (int qg = 0; qg < 2; ++qg) _Pragma("unroll") for (int dt = 0; dt < DT; ++dt) o[qg][dt] = (f32x4){0.f, 0.f, 0.f, 0.f};
  float lsum[2] = {0.f, 0.f};
  const int krow_in = 8 * (fr >> 2) + (fr & 3);
  const int skey = tid >> 4, skp = tid & 15, sd = tid >> 2, svp = tid & 3;
  uint4 rk, rv;
#define LD_CHUNK(c_) do { const int kc_ = (c_) * 32; \
    if (kc_ < 1024) { rk = *(const uint4*)(K0 + (size_t)(kc_ + skey) * 1280 + skp * 8); rv = *(const uint4*)(V0 + (size_t)sd * 1024 + kc_ + svp * 8); } \
    else { rk = *(const uint4*)(K1 + (size_t)(kc_ - 1024 + skey) * 256 + skp * 8); rv = *(const uint4*)(V1 + (size_t)sd * 512 + (kc_ - 1024) + svp * 8); } } while (0)
#define ST_CHUNK(buf_) do { *(uint4*)(kS + (buf_) * KBUF + skey * KROW + skp * 16) = rk; *(uint4*)(vS + (buf_) * VBUF + sd * VROW + svp * 16) = rv; } while (0)
  __syncthreads();
  LD_CHUNK(0); ST_CHUNK(0);
  __syncthreads();
  for (int c = 0; c < NCH; ++c) {
    const int buf = c & 1;
    if (c + 1 < NCH) LD_CHUNK(c + 1);
    const unsigned char* kb = kS + buf * KBUF; const unsigned char* vb = vS + buf * VBUF;
    bf16x8 kf[2][KS], vf[DT];
    _Pragma("unroll") for (int t = 0; t < 2; ++t) _Pragma("unroll") for (int ks = 0; ks < KS; ++ks) kf[t][ks] = *(const bf16x8*)(kb + (krow_in + 4 * t) * KROW + (ks * 32 + 8 * g) * 2);
    _Pragma("unroll") for (int dt = 0; dt < DT; ++dt) vf[dt] = *(const bf16x8*)(vb + (16 * dt + fr) * VROW + 16 * g);
    f32x4 s[2][2];
    _Pragma("unroll") for (int qg = 0; qg < 2; ++qg) _Pragma("unroll") for (int t = 0; t < 2; ++t) {
      s[qg][t] = (f32x4){0.f, 0.f, 0.f, 0.f};
      _Pragma("unroll") for (int ks = 0; ks < KS; ++ks) s[qg][t] = __builtin_amdgcn_mfma_f32_16x16x32_bf16(kf[t][ks], qf[qg][ks], s[qg][t], 0, 0, 0);
    }
    asm volatile("s_nop 15" : "+v"(s[0][0]), "+v"(s[0][1]), "+v"(s[1][0]), "+v"(s[1][1]));
    bf16x8 pf[2];
    _Pragma("unroll") for (int qg = 0; qg < 2; ++qg) {
      float pv[8];
      _Pragma("unroll") for (int i = 0; i < 8; ++i) { pv[i] = __builtin_amdgcn_exp2f(s[qg][i >> 2][i & 3]); lsum[qg] += pv[i]; }
      union { bf16x8 v; unsigned u[4]; } pk;
      _Pragma("unroll") for (int i = 0; i < 4; ++i) pk.u[i] = cvt_pk_bf16(pv[2 * i], pv[2 * i + 1]);
      pf[qg] = pk.v;
    }
    asm volatile("s_nop 3" : "+v"(pf[0]), "+v"(pf[1]));
    _Pragma("unroll") for (int qg = 0; qg < 2; ++qg) _Pragma("unroll") for (int dt = 0; dt < DT; ++dt)
      o[qg][dt] = __builtin_amdgcn_mfma_f32_16x16x32_bf16(vf[dt], pf[qg], o[qg][dt], 0, 0, 0);
    if (c + 1 < NCH) ST_CHUNK(buf ^ 1);
    __syncthreads();
  }
#undef LD_CHUNK
#undef ST_CHUNK
  _Pragma("unroll") for (int qg = 0; qg < 2; ++qg) _Pragma("unroll") for (int dt = 0; dt < DT; ++dt) asm volatile("s_nop 7" : "+v"(o[qg][dt]));
  bf16_t* Ow = O + (size_t)(wave * 32) * 1024;
  _Pragma("unroll") for (int qg = 0; qg < 2; ++qg) {
    float l = lsum[qg];
    l += __shfl_xor(l, 16); l += __shfl_xor(l, 32);
    const float inv = 1.f / l;
    _Pragma("unroll") for (int dt = 0; dt < DT; ++dt) {
      uint2 pk; pk.x = cvt_pk_bf16(o[qg][dt][0] * inv, o[qg][dt][1] * inv); pk.y = cvt_pk_bf16(o[qg][dt][2] * inv, o[qg][dt][3] * inv);
      *(uint2*)(Ow + (size_t)(qg * 16 + fr) * 1024 + 16 * dt + 4 * g) = pk;
    }
  }
}

__device__ void phase_attn_gqa(const Params& p) {
  const int wave = opaque_tid() >> 6;
  const bf16_t* QK = (const bf16_t*)(p.ws + WS_QK);
  const bf16_t* VT = (const bf16_t*)(p.ws + WS_VT);
  const bf16_t* CK = (const bf16_t*)(p.ws + WS_CKGQA);
  const bf16_t* CVT = (const bf16_t*)(p.ws + WS_CVTGQA);
  bf16_t* AO = (bf16_t*)(p.ws + WS_AO);
  const int G = gridDim.x, nlat = G >= 256 ? 128 : G / 2;
  if ((int)blockIdx.x < nlat) {
    for (int id = blockIdx.x; id < 128; id += nlat) {
      const int qblk = id & 3, hq = (id >> 2) & 7, b = id >> 5, hk = hq >> 2;
      const int tokq = 4096 + b * 1024 + qblk * 256;
      attn_block_gqa_latent(QK + (size_t)tokq * 1280 + hq * 128,
                            QK + (size_t)(4096 + b * 1024) * 1280 + 1024 + hk * 128,
                            VT + (size_t)4096 * 256 + ((size_t)b * 256 + hk * 128) * 1024,
                            CK + (size_t)b * 512 * 256 + hk * 128,
                            CVT + ((size_t)b * 256 + hk * 128) * 512,
                            AO + (size_t)tokq * 1024 + hq * 128);
    }
  } else {
    const int nw = (G - nlat) * 8;
    for (int id = ((int)blockIdx.x - nlat) * 8 + wave; id < 1024; id += nw) {
      const int qb = id & 7, hq = (id >> 3) & 7, b = id >> 6, hk = hq >> 2;
      const int tokq = b * 256 + qb * 32;
      attn_wave<128, false>(QK + (size_t)tokq * 1280 + hq * 128, 1280,
                            QK + (size_t)(b * 256) * 1280 + 1024 + hk * 128, 1280,
                            VT + ((size_t)b * 256 + hk * 128) * 256, 256, 256,
                            nullptr, 0, nullptr, 0, 0,
                            AO + (size_t)tokq * 1024 + hq * 128, 1024, nullptr, 0, 0, 0);
    }
  }
}

#define XB_TMO      128
#define XB_XCNT(j)  (256  + 64 * (j))
#define XB_XSUB(j)  (1280 + 64 * (j))
#define XB_XGEN(j)  (2304 + 64 * (j))
#define XB_TOP      3328
#define XB_TOPGEN   3392
#define XCD_BAR_WORDS 3456
#define XB_SPIN_CAP (1u << 18)
#define LAS __attribute__((address_space(3)))

__device__ __forceinline__ unsigned xb_ld(unsigned* p)              { return __hip_atomic_load(p, __ATOMIC_RELAXED, __HIP_MEMORY_SCOPE_AGENT); }
__device__ __forceinline__ unsigned xb_add(unsigned* p, unsigned v) { return __hip_atomic_fetch_add(p, v, __ATOMIC_RELAXED, __HIP_MEMORY_SCOPE_AGENT); }
__device__ __forceinline__ unsigned xb_xcc_id() { return (unsigned)__builtin_amdgcn_s_getreg((3 << 11) | 20) & 0xFu; }
#define XB_SPIN(cond, bar) do { unsigned _sp = 0; while (cond) { __builtin_amdgcn_s_sleep(1); \
    if ((++_sp & 255u) == 0u) { if (xb_ld(&(bar)[XB_TMO])) break; if (_sp > XB_SPIN_CAP) { atomicAdd(&(bar)[XB_TMO], 1u); break; } } } } while (0)

struct XcdBarrier {
    unsigned* bar; unsigned x;
    volatile LAS unsigned* st;
};

__device__ __forceinline__ XcdBarrier xcd_barrier_post(unsigned* bar, volatile LAS unsigned* st) {
    XcdBarrier b; b.bar = bar; b.x = xb_xcc_id(); b.st = st;
    if (threadIdx.x == 0) (void)xb_add(&bar[XB_XCNT(b.x)], 1u);
    return b;
}
__device__ __forceinline__ void xcd_barrier_complete(unsigned* bar, unsigned x, unsigned& nloc, unsigned& nx) {
    const unsigned G = gridDim.x * gridDim.y * gridDim.z;
    unsigned sum, cnt, mine, sp = 0u;
    for (;;) {
        sum = 0u; cnt = 0u; mine = 0u;
#pragma unroll
        for (unsigned j = 0; j < 16; ++j) { const unsigned c = xb_ld(&bar[XB_XCNT(j)]); sum += c; cnt += (c > 0u) ? 1u : 0u; mine = (j == x) ? c : mine; }
        if (sum == G) break;
        __builtin_amdgcn_s_sleep(1);
        if ((++sp & 255u) == 0u) { if (xb_ld(&bar[XB_TMO])) break; if (sp > XB_SPIN_CAP) { atomicAdd(&bar[XB_TMO], 1u); break; } }
    }
    nloc = mine > 0u ? mine : 1u; nx = cnt > 0u ? cnt : 1u;
}

__device__ __forceinline__ void xcd_barrier(const XcdBarrier& b) {
    asm volatile("s_waitcnt vmcnt(0)" ::: "memory");
    __syncthreads();
    if (threadIdx.x == 0) {
        unsigned* bar = b.bar; unsigned xb_probe = 0u;
        __builtin_amdgcn_s_waitcnt(0);
        unsigned nloc = b.st[0], nx = b.st[1];
        if (nloc == 0u) { xcd_barrier_complete(bar, b.x, nloc, nx); b.st[0] = nloc; b.st[1] = nx; }
        const unsigned old = xb_add(&bar[XB_XSUB(b.x)], 1u);
        const unsigned gen = old / nloc;
        if (old + 1u == (gen + 1u) * nloc) {
            __builtin_amdgcn_fence(__ATOMIC_RELEASE, "agent");
            asm volatile("s_waitcnt vmcnt(0)" ::: "memory");
            const unsigned og = xb_add(&bar[XB_TOP], 1u);
            const unsigned tg = og / nx;
            if (og + 1u == (tg + 1u) * nx) xb_add(&bar[XB_TOPGEN], 1u);
            else XB_SPIN(xb_ld(&bar[XB_TOPGEN]) == tg, bar);
            __builtin_amdgcn_fence(__ATOMIC_ACQUIRE, "agent"); xb_probe = xb_ld(&bar[XB_TMO]);
            xb_add(&bar[XB_XGEN(b.x)], 1u);
            asm volatile("s_waitcnt vmcnt(0)" ::: "memory");
        } else {
            XB_SPIN(xb_ld(&bar[XB_XGEN(b.x)]) == gen, bar);
            __builtin_amdgcn_fence(__ATOMIC_ACQUIRE, "agent"); xb_probe = xb_ld(&bar[XB_TMO]);
            asm volatile("s_waitcnt vmcnt(0)" ::: "memory");
        }
        asm volatile("" :: "v"(xb_probe));
        __builtin_amdgcn_s_sleep(80);
    }
    __syncthreads();
}


__device__ void phase_fake_mlp1(const Params& p) {
  const int tid = opaque_tid();
  const uint4* HB = (const uint4*)(p.ws + WS_HB);
  uint4* ACT = (uint4*)(p.ws + WS_ACT);
  for (size_t i = (size_t)blockIdx.x * NT + tid; i < (size_t)NTOK * DFF / 8; i += (size_t)gridDim.x * NT) {
    const size_t row = i >> 9, c8 = i & 511;
    uint4 v = HB[row * 128 + (c8 & 127)];
    unsigned w[4] = {v.x, v.y, v.z, v.w};
    for (int j = 0; j < 4; ++j) { float a = bflo(w[j]), b = bfhi(w[j]); w[j] = cvt_pk_bf16(a * a, b * b); }
    ACT[i] = make_uint4(w[0], w[1], w[2], w[3]);
  }
}
__global__ void __launch_bounds__(NT) fwd_megakernel(Params p) {
  cg::grid_group grid = cg::this_grid();
  unsigned char* ws = p.ws;
  const float* MOD = (const float*)(ws + WS_MOD);
  bf16_t* HB = (bf16_t*)(ws + WS_HB);
  bf16_t* AO = (bf16_t*)(ws + WS_AO);
  bf16_t* QK = (bf16_t*)(ws + WS_QK);
  bf16_t* VT = (bf16_t*)(ws + WS_VT);
  bf16_t* ACT = (bf16_t*)(ws + WS_ACT);
  int ph = 0;
#ifdef CHK_INPUT
  { float* chk = (float*)(ws + WS_END);
    const int t = opaque_tid();
    const float* sp = p.in[CHK_INPUT];
    const size_t per = (size_t)CHK_COUNT / gridDim.x;
    float s = 0.f;
    for (size_t i = t; i < per; i += NT) { float v = sp[(size_t)blockIdx.x * per + i]; s += v * (1.f + (float)(i & 15)); }
    float* red = (float*)smem; red[t] = s; __syncthreads();
    if (t == 0) { float a = 0.f; for (int i = 0; i < NT; ++i) a += red[i]; chk[blockIdx.x] = a; }
    __syncthreads(); }
#endif
#ifdef START_DELAY_TICKS
  { const unsigned long long t0 = __builtin_amdgcn_s_memrealtime(); while (__builtin_amdgcn_s_memrealtime() - t0 < START_DELAY_TICKS) __builtin_amdgcn_s_sleep(8); }
#endif
  volatile LAS unsigned* xb_st = (volatile LAS unsigned*)(smem + 131072);
  if (threadIdx.x < 2) xb_st[threadIdx.x] = 0u;
  __syncthreads();
  if (blockIdx.x == 0) { unsigned* bw = (unsigned*)(ws + WS_BAR); for (int i = threadIdx.x; i < XCD_BAR_WORDS; i += NT) bw[i] = 0u; }
  if (p.ph_hi - p.ph_lo > 1) grid.sync();
  XcdBarrier xbar = xcd_barrier_post((unsigned*)(ws + WS_BAR), xb_st);
#ifdef EXTRA_SYNCS
  for (int i_ = 0; i_ < EXTRA_SYNCS; ++i_) grid.sync();
#endif
#ifndef EN_GEMM
#define EN_GEMM 15
#endif
#ifndef EN_ATTN
#define EN_ATTN 1
#endif
#ifndef EN_S5
#define EN_S5 1
#endif
#ifndef EN_MISC
#define EN_MISC 1
#endif
#define RUN(body) do { if (p.ph_lo <= ph && ph < p.ph_hi) { body; if (ph + 1 < p.ph_hi) xcd_barrier(xbar); } ++ph; } while (0)

  RUN(if (EN_MISC) phase_prologue(p));
  for (int layer = 0; layer < 4; ++layer) {
    const int kind = layer % 3, slot = layer / 3;
    RUN(if (EN_MISC) phase_norm(p, layer, 0, layer == 0));
    if (kind == 0) {
      RUN(if (EN_S5) phase_s5_pass1(p, slot));
      RUN(if (EN_S5) phase_s5_pass2(p, slot));
      { GemmArgs ga{HB, D, (const bf16_t*)(ws + WS_GLUT) + (size_t)slot * 2048 * 1024, D, 32, 16, 1024, 0xffff};
        EpiGlu e{p.out, MOD + layer * 5 * 6144 + 2 * 1024, p.in[23] + slot * 2048};
        RUN(if (EN_GEMM & 1) gemm_phase<128>(ga, e)); }
    } else if (kind == 1) {
      { GemmArgs ga{HB, D, (const bf16_t*)(ws + WS_NAQKVT), D, 32, 24, 1024, 0xffff};
        EpiQkv e{QK, 2048, VT, 1024, p.out + OUT_NAV};
        RUN(if (EN_GEMM & 2) gemm_phase<128>(ga, e)); }
      RUN(if (EN_MISC) phase_post_na(p));
      RUN(if (EN_ATTN) phase_attn_na(p));
      { GemmArgs ga{AO, D, (const bf16_t*)(ws + WS_NAOT), D, 32, 8, 1024, 0xffff};
        EpiResid e{p.out, MOD + layer * 5 * 6144 + 2 * 1024};
        RUN(if (EN_GEMM & 4) gemm_phase<128>(ga, e)); }
    } else {
      { GemmArgs ga{HB, D, (const bf16_t*)(ws + WS_GQAQKVT), D, 32, 12, 1024, 0xffff};
        EpiQkv e{QK, 1280, VT, 256, p.out + OUT_GQAV};
        RUN(if (EN_GEMM & 2) gemm_phase<128>(ga, e)); }
      RUN(if (EN_MISC) phase_post_gqa(p));
      RUN(if (EN_ATTN) phase_attn_gqa(p));
      { GemmArgs ga{AO, D, (const bf16_t*)(ws + WS_GQAOT), D, 32, 8, 1024, 0xffff};
        EpiResid e{p.out, MOD + layer * 5 * 6144 + 2 * 1024};
        RUN(if (EN_GEMM & 4) gemm_phase<128>(ga, e)); }
    }
    RUN(if (EN_MISC) phase_norm(p, layer, 1, false));
    { GemmArgs ga{HB, D, (const bf16_t*)(ws + WS_W1T) + (size_t)layer * 4096 * 1024, D, 32, 16, 1024, 0xffff};
      EpiSqRelu e{ACT};
      RUN(if (EN_GEMM & 8) gemm_phase<256>(ga, e)); }
    { GemmArgs ga{ACT, DFF, (const bf16_t*)(ws + WS_W2T) + (size_t)layer * 1024 * 4096, DFF, 32, 8, 4096, 0xffff};
      EpiResid e{p.out, MOD + layer * 5 * 6144 + 5 * 1024};
      RUN(if (EN_GEMM & 4) gemm_phase<128>(ga, e)); }
  }
#ifdef FINAL_SYNC
  if (p.ph_hi - p.ph_lo > 1) { grid.sync(); { const unsigned long long t0 = __builtin_amdgcn_s_memrealtime(); while (__builtin_amdgcn_s_memrealtime() - t0 < 2000ull) __builtin_amdgcn_s_sleep(8); } grid.sync(); }
#endif
#ifdef DUMP_S5P
  if (p.ph_hi - p.ph_lo > 1) {
    grid.sync();
    const float* sa = (const float*)(ws + WS_S5A);
    const unsigned* sb = (const unsigned*)(ws + WS_S5BB);
    const unsigned* sc = (const unsigned*)(ws + WS_S5CM);
    for (size_t i = (size_t)blockIdx.x * NT + opaque_tid(); i < 524288; i += (size_t)gridDim.x * NT) {
      if (i < 32768) p.out[i] = sa[i];
      unsigned w = sb[i]; p.out[65536 + 2 * i] = bflo(w); p.out[65536 + 2 * i + 1] = bfhi(w);
      unsigned w2 = sc[i]; p.out[2097152 + 2 * i] = bflo(w2); p.out[2097152 + 2 * i + 1] = bfhi(w2);
    }
  }
#endif
#ifdef DUMP_E
  if (p.ph_hi - p.ph_lo > 1) {
    grid.sync();
    const float* sp = (const float*)(ws + WS_S5E);
    for (size_t i = (size_t)blockIdx.x * NT + opaque_tid(); i < 2097152; i += (size_t)gridDim.x * NT) p.out[i] = sp[i];
  }
#endif
#ifdef DUMP_HB
  if (p.ph_hi - p.ph_lo > 1) {
    grid.sync();
    const unsigned* sp = (const unsigned*)(ws + WS_HB);
    for (size_t i = (size_t)blockIdx.x * NT + opaque_tid(); i < 4194304; i += (size_t)gridDim.x * NT) {
      unsigned w = sp[i]; p.out[2 * i] = bflo(w); p.out[2 * i + 1] = bfhi(w);
    }
  }
#endif
#ifdef DUMP_W2T
  if (p.ph_lo == 100) {
    const unsigned* sp = (const unsigned*)(ws + WS_W2T);
    for (size_t i = (size_t)blockIdx.x * NT + opaque_tid(); i < 19398656 / 2; i += (size_t)gridDim.x * NT) {
      float a = 0.f, b = 0.f;
      if (i < 2097152) { unsigned w = sp[i]; a = bflo(w); b = bfhi(w); }
      p.out[2 * i] = a; p.out[2 * i + 1] = b;
    }
  }
#endif
#undef RUN
#ifdef CHK_W2T
  grid.sync();
  { float* chk = (float*)(ws + WS_END);
    const int t = opaque_tid();
    const unsigned* sp = (const unsigned*)(ws + WS_W2T);
    const size_t per = (size_t)(33554432 / 4) / gridDim.x;
    float s = 0.f;
    for (size_t i = t; i < per; i += NT) { unsigned w = sp[(size_t)blockIdx.x * per + i]; s += (bflo(w) + 2.f * bfhi(w)) * (1.f + (float)(i & 15)); }
    float* red = (float*)smem; red[t] = s; __syncthreads();
    if (t == 0) { float a = 0.f; for (int i = 0; i < NT; ++i) a += red[i]; chk[blockIdx.x] = a; }
    __syncthreads(); }
  grid.sync();
  { const float* chk = (const float*)(ws + WS_END);
    for (size_t i = (size_t)blockIdx.x * NT + opaque_tid(); i < 19398656; i += (size_t)gridDim.x * NT) p.out[i] = chk[(i >> 10) & 255]; }
#endif
#ifdef CHK_INPUT
  grid.sync();
  { const float* chk = (const float*)(ws + WS_END);
    for (size_t i = (size_t)blockIdx.x * NT + opaque_tid(); i < 19398656; i += (size_t)gridDim.x * NT) p.out[i] = chk[(i >> 10) & 255]; }
#endif
}

extern "C" void kernel_launch(void* const* d_in, const int* in_sizes, int n_in, void* d_out, int out_size, void* d_ws, size_t ws_size, hipStream_t stream) {
  static int grid_blocks = 0;
  if (grid_blocks == 0) {
    if (n_in != 33 || ws_size < WS_END) { fprintf(stderr, "kernel_launch: unexpected n_in %d or ws_size %zu (< %zu)\n", n_in, ws_size, (size_t)WS_END); grid_blocks = -1; return; }
    int dev = 0, cus = 0, per_cu = 0;
    (void)hipGetDevice(&dev);
    (void)hipDeviceGetAttribute(&cus, hipDeviceAttributeMultiprocessorCount, dev);
    if (hipFuncSetAttribute((const void*)fwd_megakernel, hipFuncAttributeMaxDynamicSharedMemorySize, LDS_BYTES) != hipSuccess) { fprintf(stderr, "hipFuncSetAttribute failed\n"); grid_blocks = -1; return; }
    if (hipOccupancyMaxActiveBlocksPerMultiprocessor(&per_cu, (const void*)fwd_megakernel, NT, LDS_BYTES) != hipSuccess || per_cu < 1) { fprintf(stderr, "occupancy query failed (%d)\n", per_cu); (void)hipGetLastError(); per_cu = 1; }
    grid_blocks = cus * 1;
    fprintf(stderr, "kernel_launch: cus %d per_cu %d grid %d\n", cus, per_cu, grid_blocks);
  }
  if (grid_blocks < 0) return;
  Params p{};
  for (int i = 0; i < 33; ++i) p.in[i] = (const float*)d_in[i];
  p.out = (float*)d_out; p.ws = (unsigned char*)d_ws;
#if N_LAUNCH_MODE == 1
  #ifndef PH_HI
#define PH_HI NPHASE
#endif
  p.ph_lo = 0; p.ph_hi = PH_HI;
  void* args[] = {&p};
  hipError_t e = hipLaunchCooperativeKernel((void*)fwd_megakernel, dim3(grid_blocks), dim3(NT), args, LDS_BYTES, stream);
  if (e != hipSuccess) fprintf(stderr, "cooperative launch failed: %s (grid %d)\n", hipGetErrorString(e), grid_blocks);
#else
#ifndef PH_HI
#define PH_HI NPHASE
#endif
  for (int ph = 0; ph < PH_HI; ++ph) {
    p.ph_lo = ph; p.ph_hi = ph + 1;
    hipLaunchKernelGGL(fwd_megakernel, dim3(grid_blocks), dim3(NT), LDS_BYTES, stream, p);
  }
#ifdef DUMP_W2T
  p.ph_lo = 100; p.ph_hi = 101;
  hipLaunchKernelGGL(fwd_megakernel, dim3(grid_blocks), dim3(NT), LDS_BYTES, stream, p);
#endif
#endif
}
```
